# Optimizing an MI355X kernel written in HIP

```python
import jax, jax.numpy as jnp
from jax import lax
import numpy as np

D_MODEL = 1024
BATCH = 2
SEQ = 8192
DEPTH = 4

GRID_W = 64
CTX_LEN = 256
HEAD_DIM = 64
A_HEADS = 8
A_KV_HEADS = 2
A_GROUP = A_HEADS // A_KV_HEADS
B_HEADS = 4
C_GROUPS = 4
C_GROUP_DIM = 64
C_WIDTH = C_GROUPS * C_GROUP_DIM
POOL_WINDOWS = (2, 4, 8, 16)
NA_WIN_ROWS = 8
NA_WIN_COLS = 16
Q_BLOCK = 128
ROPE_THETA = 10000.0
AXIS_ROPE_DIM = HEAD_DIM // 2
N_BRANCHES = 3
D_FF = 2816
N_EXPERTS = 8
TOP_K = 2
D_FF_EXPERT = 3584
N_DENSE_LAYERS = (DEPTH + 1) // 2
N_MOE_LAYERS = DEPTH // 2
EPS = 1e-6

A_Q = A_HEADS * HEAD_DIM
A_KV = A_KV_HEADS * HEAD_DIM
B_W = B_HEADS * HEAD_DIM
IN_SPLITS = (A_Q, A_KV, A_KV, B_W, B_W, B_W, C_WIDTH, N_BRANCHES * D_MODEL)
IN_COLS = sum(IN_SPLITS)

kernel_name = "hybrid_parallel_gqa_natten_pool_moe_diffusion"


def rms_norm(x, g):
    xf = x.astype(jnp.float32)
    y = xf * lax.rsqrt(jnp.mean(xf * xf, axis=-1, keepdims=True) + EPS)
    return (y * g.astype(jnp.float32)).astype(x.dtype)


def modulate(h, shift, scale):
    return h * (1 + scale) + shift


def axial_rope_tables(n_tok):
    t = jnp.arange(n_tok, dtype=jnp.int32)
    pos = jnp.stack([t // GRID_W, t % GRID_W], axis=-1).astype(jnp.float32)
    inv_freq = ROPE_THETA ** (-jnp.arange(0, AXIS_ROPE_DIM, 2, dtype=jnp.float32) / AXIS_ROPE_DIM)
    ang = pos[:, :, None] * inv_freq[None, None, :]
    return jnp.cos(ang), jnp.sin(ang)


def apply_axial_rope(x, cos, sin):
    B, S, H, _ = x.shape
    xr = x.reshape(B, S, H, 2, 2, AXIS_ROPE_DIM // 2).astype(jnp.float32)
    x1, x2 = xr[..., 0, :], xr[..., 1, :]
    cs = cos[None, :, None]
    sn = sin[None, :, None]
    out = jnp.stack([x1 * cs - x2 * sn, x2 * cs + x1 * sn], axis=-2)
    return out.reshape(x.shape).astype(x.dtype)


def gqa_core(q, k, v):
    s = jnp.einsum('bqkgd,bnkd->bkgqn', q, k).astype(jnp.float32) * (HEAD_DIM ** -0.5)
    p = jax.nn.softmax(s, axis=-1).astype(v.dtype)
    return jnp.einsum('bkgqn,bnkd->bqkgd', p, v)


def gqa_axial_attention(q_x, k_x, v_x, q_c, k_c, v_c, cos, sin):
    B, S = q_x.shape[:2]
    q_x = apply_axial_rope(q_x, cos, sin)
    k_x = apply_axial_rope(k_x, cos, sin)
    k_all = jnp.concatenate([k_c, k_x], axis=1)
    v_all = jnp.concatenate([v_c, v_x], axis=1)
    qb = q_x.reshape(B, S // Q_BLOCK, Q_BLOCK, A_KV_HEADS, A_GROUP, HEAD_DIM).transpose(1, 0, 2, 3, 4, 5)
    o = lax.map(lambda qblk: gqa_core(qblk, k_all, v_all), qb)
    o_x = o.transpose(1, 0, 2, 3, 4, 5).reshape(B, S, A_Q)
    o_c = None
    if q_c is not None:
        L = q_c.shape[1]
        o_c = gqa_core(q_c.reshape(B, L, A_KV_HEADS, A_GROUP, HEAD_DIM), k_c, v_c).reshape(B, L, A_Q)
    return o_x, o_c


def neighbourhood_attention(q_x, k_x, v_x, q_c, k_c, v_c, rel_bias):
    B, S = q_x.shape[:2]
    rows = S // GRID_W
    wr = min(NA_WIN_ROWS, rows)
    n_win = wr * NA_WIN_COLS
    qg = q_x.reshape(B, rows, GRID_W, B_HEADS, HEAD_DIM)
    kg = k_x.reshape(B, rows, GRID_W, B_HEADS, HEAD_DIM)
    vg = v_x.reshape(B, rows, GRID_W, B_HEADS, HEAD_DIM)
    col = np.arange(GRID_W)
    col_start = np.clip(col - NA_WIN_COLS // 2, 0, GRID_W - NA_WIN_COLS)
    col_idx = col_start[:, None] + np.arange(NA_WIN_COLS)[None, :]
    dc_idx = col_idx - col[:, None] + (NA_WIN_COLS - 1)
    bias_c = rel_bias[:, :, dc_idx]
    scale = HEAD_DIM ** -0.5

    def one_row(r):
        rs = jnp.clip(r - wr // 2, 0, rows - wr)
        k_rows = lax.dynamic_slice_in_dim(kg, rs, wr, axis=1)
        v_rows = lax.dynamic_slice_in_dim(vg, rs, wr, axis=1)
        k_win = k_rows[:, :, col_idx]
        v_win = v_rows[:, :, col_idx]
        q_row = lax.dynamic_index_in_dim(qg, r, axis=1, keepdims=False)
        dr_idx = rs + jnp.arange(wr) - r + (NA_WIN_ROWS - 1)
        bias = jnp.take(bias_c, dr_idx, axis=1).transpose(0, 2, 1, 3)
        s_win = jnp.einsum('bjhd,brjchd->bhjrc', q_row, k_win).astype(jnp.float32) * scale
        s_win = (s_win + bias[None].astype(jnp.float32)).reshape(B, B_HEADS, GRID_W, n_win)
        s_ctx = jnp.einsum('bjhd,blhd->bhjl', q_row, k_c).astype(jnp.float32) * scale
        p = jax.nn.softmax(jnp.concatenate([s_win, s_ctx], axis=-1), axis=-1).astype(v_x.dtype)
        p_win = p[..., :n_win].reshape(B, B_HEADS, GRID_W, wr, NA_WIN_COLS)
        p_ctx = p[..., n_win:]
        o = jnp.einsum('bhjrc,brjchd->bjhd', p_win, v_win) + jnp.einsum('bhjl,blhd->bjhd', p_ctx, v_c)
        return o.reshape(B, GRID_W, B_W)

    o = lax.map(one_row, jnp.arange(rows))
    o_x = o.transpose(1, 0, 2, 3).reshape(B, S, B_W)
    o_c = None
    if q_c is not None:
        L = q_c.shape[1]
        o_c = gqa_core(q_c[:, :, :, None, :], k_c, v_c).reshape(B, L, B_W)
    return o_x, o_c


def pool_mixer(u, w, scale):
    B, N, _ = u.shape
    ug = u.reshape(B, N, C_GROUPS, C_GROUP_DIM)
    csum = jnp.cumsum(ug.astype(jnp.float32), axis=1)
    csum = jnp.concatenate([jnp.zeros((B, 1, C_GROUPS, C_GROUP_DIM), jnp.float32), csum], axis=1)
    t = np.arange(N)[:, None]
    win = np.array(POOL_WINDOWS)[None, :]
    lo = np.clip(t - win // 2, 0, N)
    hi = np.clip(t - win // 2 + win, 0, N)
    g = np.arange(C_GROUPS)[None, :]
    cnt = (hi - lo).astype(np.float32)[None, :, :, None]
    mean = (csum[:, hi, g] - csum[:, lo, g]) / cnt
    d = (mean - ug.astype(jnp.float32)).astype(u.dtype)
    y = jnp.einsum('bngc,gcd->bngd', d, w)
    return y.reshape(B, N, C_WIDTH) * scale


def branch_merge(y_a, y_b, y_c, gates, w_pa, w_pb, w_pc, w_out):
    g_a, g_b, g_c = jnp.split(gates, N_BRANCHES, axis=-1)
    m = (jax.nn.sigmoid(g_a) * (y_a @ w_pa) + jax.nn.sigmoid(g_b) * (y_b @ w_pb)
         + jax.nn.sigmoid(g_c) * (y_c @ w_pc))
    return m @ w_out


def token_mixers(px, pc, q_g, k_g, rel_bias, pool_w, pool_scale, w_pa, w_pb, w_pc, w_out, cos, sin, want_ctx):
    offs = np.cumsum(IN_SPLITS)[:-1].tolist()
    aq, ak, av, bq, bk, bv, cu, gates = jnp.split(px, offs, axis=-1)
    caq, cak, cav, cbq, cbk, cbv, ccu, cgates = jnp.split(pc, offs, axis=-1)

    def heads(t, h):
        return t.reshape(t.shape[0], t.shape[1], h, HEAD_DIM)

    qa = rms_norm(heads(aq, A_HEADS), q_g)
    ka = rms_norm(heads(ak, A_KV_HEADS), k_g)
    cka = rms_norm(heads(cak, A_KV_HEADS), k_g)
    cqa = rms_norm(heads(caq, A_HEADS), q_g) if want_ctx else None
    y_a, cy_a = gqa_axial_attention(qa, ka, heads(av, A_KV_HEADS), cqa, cka, heads(cav, A_KV_HEADS), cos, sin)
    cqb = heads(cbq, B_HEADS) if want_ctx else None
    y_b, cy_b = neighbourhood_attention(heads(bq, B_HEADS), heads(bk, B_HEADS), heads(bv, B_HEADS),
                                        cqb, heads(cbk, B_HEADS), heads(cbv, B_HEADS), rel_bias)
    y_c = pool_mixer(cu, pool_w, pool_scale)
    out_x = branch_merge(y_a, y_b, y_c, gates, w_pa, w_pb, w_pc, w_out)
    out_c = None
    if want_ctx:
        cy_c = pool_mixer(ccu, pool_w, pool_scale)
        out_c = branch_merge(cy_a, cy_b, cy_c, cgates, w_pa, w_pb, w_pc, w_out)
    return out_x, out_c


def swiglu(h, w1, w3, w2):
    return (jax.nn.silu(h @ w1) * (h @ w3)) @ w2


def moe_swiglu(h, router_w, router_b, w1, w3, w2):
    logits = (h @ router_w).astype(jnp.float32) + router_b.astype(jnp.float32)
    top_val, top_idx = lax.top_k(logits, TOP_K)
    top_p = jax.nn.softmax(top_val, axis=-1)
    combine = jnp.sum(jax.nn.one_hot(top_idx, N_EXPERTS, dtype=jnp.float32) * top_p[..., None], axis=-2)
    out = jnp.zeros_like(h)
    for e in range(N_EXPERTS):
        out = out + combine[..., e:e + 1].astype(h.dtype) * swiglu(h, w1[e], w3[e], w2[e])
    return out


def setup_inputs(seed: int = 0) -> dict:
    key = jax.random.key(seed)
    ks = jax.random.split(key, 32)
    f32 = jnp.float32
    D = D_MODEL

    def nrm(k, shape, scale):
        return jax.random.normal(k, shape, f32) * scale

    return {
        "x": nrm(ks[0], (BATCH, SEQ, D), 1.0),
        "c": nrm(ks[1], (BATCH, D), 1.0),
        "ctx": nrm(ks[2], (BATCH, CTX_LEN, D), 1.0),
        "c_ctx": nrm(ks[3], (D,), 1.0),
        "w_mod": nrm(ks[4], (DEPTH, D, 6 * D), 0.5 * D ** -0.5),
        "b_mod": nrm(ks[5], (DEPTH, 6 * D), 0.02),
        "norm1_g": 1.0 + nrm(ks[6], (DEPTH, D), 0.02),
        "norm2_g": 1.0 + nrm(ks[7], (DEPTH, D), 0.02),
        "w_in": nrm(ks[8], (DEPTH, D, IN_COLS), D ** -0.5),
        "q_norm_g": 1.0 + nrm(ks[9], (DEPTH, HEAD_DIM), 0.02),
        "k_norm_g": 1.0 + nrm(ks[10], (DEPTH, HEAD_DIM), 0.02),
        "na_rel_bias": nrm(ks[11], (DEPTH, B_HEADS, 2 * NA_WIN_ROWS - 1, 2 * NA_WIN_COLS - 1), 0.5),
        "pool_w": nrm(ks[12], (DEPTH, C_GROUPS, C_GROUP_DIM, C_GROUP_DIM), C_GROUP_DIM ** -0.5),
        "pool_scale": 1.0 + nrm(ks[13], (DEPTH, C_WIDTH), 0.1),
        "w_branch_a": nrm(ks[14], (DEPTH, A_Q, D), A_Q ** -0.5),
        "w_branch_b": nrm(ks[15], (DEPTH, B_W, D), B_W ** -0.5),
        "w_branch_c": nrm(ks[16], (DEPTH, C_WIDTH, D), C_WIDTH ** -0.5),
        "w_out": nrm(ks[17], (DEPTH, D, D), D ** -0.5),
        "ffn_w1": nrm(ks[18], (N_DENSE_LAYERS, D, D_FF), D ** -0.5),
        "ffn_w3": nrm(ks[19], (N_DENSE_LAYERS, D, D_FF), D ** -0.5),
        "ffn_w2": nrm(ks[20], (N_DENSE_LAYERS, D_FF, D), D_FF ** -0.5),
        "router_w": nrm(ks[21], (N_MOE_LAYERS, D, N_EXPERTS), D ** -0.5),
        "router_b": nrm(ks[22], (N_MOE_LAYERS, N_EXPERTS), 0.01),
        "moe_w1": nrm(ks[23], (N_MOE_LAYERS, N_EXPERTS, D, D_FF_EXPERT), D ** -0.5),
        "moe_w3": nrm(ks[24], (N_MOE_LAYERS, N_EXPERTS, D, D_FF_EXPERT), D ** -0.5),
        "moe_w2": nrm(ks[25], (N_MOE_LAYERS, N_EXPERTS, D_FF_EXPERT, D), D_FF_EXPERT ** -0.5),
        "final_g": 1.0 + nrm(ks[26], (D,), 0.02),
    }


def reference(x, c, ctx, c_ctx, w_mod, b_mod, norm1_g, norm2_g, w_in, q_norm_g, k_norm_g, na_rel_bias,
              pool_w, pool_scale, w_branch_a, w_branch_b, w_branch_c, w_out, ffn_w1, ffn_w3, ffn_w2,
              router_w, router_b, moe_w1, moe_w3, moe_w2, final_g):
    S = x.shape[1]
    L = ctx.shape[1]
    cos, sin = axial_rope_tables(S)
    xc = ctx
    silu_c = jax.nn.silu(c)
    silu_cc = jax.nn.silu(c_ctx)
    for layer in range(DEPTH):
        want_ctx = layer < DEPTH - 1
        mod = silu_c @ w_mod[layer] + b_mod[layer]
        cmod = silu_cc @ w_mod[layer] + b_mod[layer]
        sh1, sc1, g1, sh2, sc2, g2 = jnp.split(mod[:, None, :], 6, axis=-1)
        csh1, csc1, cg1, csh2, csc2, cg2 = jnp.split(cmod, 6, axis=-1)

        hx = modulate(rms_norm(x, norm1_g[layer]), sh1, sc1)
        hc = modulate(rms_norm(xc, norm1_g[layer]), csh1, csc1)
        mx, mc = token_mixers(hx @ w_in[layer], hc @ w_in[layer], q_norm_g[layer], k_norm_g[layer],
                              na_rel_bias[layer], pool_w[layer], pool_scale[layer], w_branch_a[layer],
                              w_branch_b[layer], w_branch_c[layer], w_out[layer], cos, sin, want_ctx)
        x = x + g1 * mx
        hx = modulate(rms_norm(x, norm2_g[layer]), sh2, sc2)
        if want_ctx:
            xc = xc + cg1 * mc
            hc = modulate(rms_norm(xc, norm2_g[layer]), csh2, csc2)
            h_all = jnp.concatenate([hc, hx], axis=1)
        else:
            h_all = hx
        if layer % 2 == 0:
            i = layer // 2
            f = swiglu(h_all, ffn_w1[i], ffn_w3[i], ffn_w2[i])
        else:
            i = layer // 2
            f = moe_swiglu(h_all, router_w[i], router_b[i], moe_w1[i], moe_w3[i], moe_w2[i])
        if want_ctx:
            xc = xc + cg2 * f[:, :L]
            fx = f[:, L:]
        else:
            fx = f
        x = x + g2 * fx
    return rms_norm(x, final_g)
```

```cpp
#include <hip/hip_runtime.h>
#include <hip/hip_bf16.h>
#include <cstdio>
#include <cstdint>
#include <cmath>
#define NAIVE_ATTN 0
#define SINGLE_LAUNCH 1
namespace pg8 {
#define PG8_LAS __attribute__((address_space(3)))
typedef unsigned short bf16_t;
typedef short bf16x8 __attribute__((ext_vector_type(8)));
typedef float f32x4 __attribute__((ext_vector_type(4)));
typedef unsigned u32x4 __attribute__((ext_vector_type(4)));
constexpr int BM = 256, BK = 64, HALF = 128, HTB = HALF * BK * 2  , STAGE_BYTES = 8 * HTB, NXCD = 8, WGM = 8;

__host__ __device__ __forceinline__ int lds_byte(int r, int c) { const int st = (r >> 4) * 2 + (c >> 5), rr = r & 15, cc = c & 31, ob = rr * 64 + cc * 2; return st * 1024 + (ob ^ (((ob >> 9) & 1) << 5)); }
__host__ __device__ __forceinline__ void stage_rc(int b, int& R, int& C) { const int st = b / 1024, sb = b % 1024, swz = sb ^ (((sb >> 9) & 1) << 5); R = (st >> 1) * 16 + swz / 64; C = (st & 1) * 32 + (swz % 64) / 2; }
__host__ __device__ __forceinline__ int perm32(int rho) { const int n = rho >> 4, i = rho & 15; return 8 * (i >> 2) + 4 * n + (i & 3); }


struct Unit { int pm, pn; long bofs; };
struct Gemm { const bf16_t* A; const bf16_t* Bt; int K, lda, ldb; };

struct StaticOrder {
    int nM, nN, nwg, G, c;
    __device__ __forceinline__ void init(int nM_, int nN_, int G_, int c_) { nM = nM_; nN = nN_; nwg = nM * nN; G = G_; c = c_; }
    __device__ __forceinline__ bool next(int i, Unit& u) const {
        const long L = (long)i * G + c; if (L >= nwg) return false;
        int wgid = (int)L; { const int q = nwg / NXCD, r = nwg % NXCD, xcd = wgid % NXCD, off = wgid / NXCD; wgid = (xcd < r ? xcd * (q + 1) : r * (q + 1) + (xcd - r) * q) + off; }
        const int nig = WGM * nN, gid = wgid / nig, fm = gid * WGM, gsz = (nM - fm) < WGM ? (nM - fm) : WGM;
        u.pm = fm + ((wgid % nig) % gsz); u.pn = (wgid % nig) / gsz; u.bofs = 0; return true;
    }
    __device__ __forceinline__ void a_ready(const Unit&) const {}
    __device__ __forceinline__ void done(const Unit&) const {}
};
struct GroupedOrder {
    StaticOrder so; int seg[8]; long estride;
    __device__ __forceinline__ bool next(int i, Unit& u) const {
        if (!so.next(i, u)) return false;
        int e = 0;
#pragma unroll
        for (int j = 0; j < 7; ++j) e += (u.pm >= seg[j]) ? 1 : 0;
        u.bofs = (long)e * estride; return true;
    }
    __device__ __forceinline__ void a_ready(const Unit&) const {}
    __device__ __forceinline__ void done(const Unit&) const {}
};

__device__ __forceinline__ unsigned cvt_pk_bf16(float lo, float hi) { unsigned r; asm volatile("v_cvt_pk_bf16_f32 %0, %1, %2" : "=v"(r) : "v"(lo), "v"(hi)); return r; }
typedef unsigned u32x2 __attribute__((ext_vector_type(2)));
__device__ __forceinline__ float bf_lo(unsigned w) { return __uint_as_float(w << 16); }
__device__ __forceinline__ float bf_hi(unsigned w) { return __uint_as_float(w & 0xffff0000u); }
__device__ __forceinline__ float sigmoidf_(float v) { return __builtin_amdgcn_rcpf(1.0f + __builtin_amdgcn_exp2f(-1.4426950408889634f * v)); }

struct EpiBf16 {
    static constexpr bool PERM = true, AFTER_DRAIN = false;
    bf16_t* O; int ldc;
    __device__ __forceinline__ void operator()(const f32x4 (&acc)[2][2][4][2], const Unit& u, int wr, int wc, int fr, int fq) const {
        const int row0 = u.pm * BM + wr * 64 + fr; const int col0 = u.pn * BM + wc * 32 + 8 * fq;
#pragma unroll
        for (int ai = 0; ai < 2; ++ai)
#pragma unroll
            for (int m = 0; m < 4; ++m) { bf16_t* rowp = O + (size_t)(row0 + ai * HALF + m * 16) * ldc + col0;
#pragma unroll
                for (int bj = 0; bj < 2; ++bj) { const f32x4 v0 = acc[ai][bj][m][0], v1 = acc[ai][bj][m][1];
                    u32x4 w; w.x = cvt_pk_bf16(v0[0], v0[1]); w.y = cvt_pk_bf16(v0[2], v0[3]); w.z = cvt_pk_bf16(v1[0], v1[1]); w.w = cvt_pk_bf16(v1[2], v1[3]);
                    *(u32x4*)(rowp + bj * HALF) = w; } }
    }
};
struct EpiSwiGLU {
    static constexpr bool PERM = true, AFTER_DRAIN = false;
    bf16_t* H; int ldc;
    __device__ __forceinline__ void operator()(const f32x4 (&acc)[2][2][4][2], const Unit& u, int wr, int wc, int fr, int fq) const {
        const int row0 = u.pm * BM + wr * 64 + fr; const int col0 = u.pn * (BM / 2) + wc * 16 + 4 * fq;
#pragma unroll
        for (int ai = 0; ai < 2; ++ai)
#pragma unroll
            for (int m = 0; m < 4; ++m) { bf16_t* rowp = H + (size_t)(row0 + ai * HALF + m * 16) * ldc + col0;
#pragma unroll
                for (int bj = 0; bj < 2; ++bj) { const f32x4 a = acc[ai][bj][m][0], b = acc[ai][bj][m][1]; f32x4 o;
#pragma unroll
                    for (int j = 0; j < 4; ++j) o[j] = a[j] * sigmoidf_(a[j]) * b[j];
                    u32x2 w; w.x = cvt_pk_bf16(o[0], o[1]); w.y = cvt_pk_bf16(o[2], o[3]);
                    *(u32x2*)(rowp + bj * (HALF / 2)) = w; }
                asm volatile("" ::: "memory"); }
    }
};
struct EpiResid {
    static constexpr bool PERM = false, AFTER_DRAIN = false;
    const float* base_lat; const float* base_ctx; float* out_lat; float* out_ctx; const float* gate;
    __device__ __forceinline__ void operator()(const f32x4 (&acc)[2][2][4][2], const Unit& u, int wr, int wc, int fr, int fq) const {
        const bool lat = u.pm < 64; const int mrow = lat ? (u.pm >> 5) : 2;
        const float* bs = lat ? base_lat + (size_t)u.pm * BM * 1024 : base_ctx + (size_t)(u.pm - 64) * BM * 1024;
        float* os = lat ? out_lat + (size_t)u.pm * BM * 1024 : out_ctx + (size_t)(u.pm - 64) * BM * 1024;
        const int col0 = u.pn * BM + wc * 32 + 4 * fq; const float* gp = gate + mrow * 6144 + col0;
        f32x4 gv[2][2];
#pragma unroll
        for (int bj = 0; bj < 2; ++bj)
#pragma unroll
            for (int n = 0; n < 2; ++n) gv[bj][n] = *(const f32x4*)(gp + bj * HALF + n * 16);
#pragma unroll
        for (int ai = 0; ai < 2; ++ai)
#pragma unroll
            for (int m = 0; m < 4; ++m) { const size_t off = (size_t)(wr * 64 + fr + ai * HALF + m * 16) * 1024 + col0;
#pragma unroll
                for (int bj = 0; bj < 2; ++bj)
#pragma unroll
                    for (int n = 0; n < 2; ++n) { const f32x4 b = *(const f32x4*)(bs + off + bj * HALF + n * 16);
                        *(f32x4*)(os + off + bj * HALF + n * 16) = b + gv[bj][n] * acc[ai][bj][m][n]; }
                if (m & 1) asm volatile("" ::: "memory"); }
    }
};
template <int MODE> struct EpiMerge {
    static constexpr bool PERM = false, AFTER_DRAIN = false;
    const bf16_t* G; int ldg; float* m32; bf16_t* mb;
    __device__ __forceinline__ void operator()(const f32x4 (&acc)[2][2][4][2], const Unit& u, int wr, int wc, int fr, int fq) const {
        const int row0 = u.pm * BM + wr * 64 + fr; const int col0 = u.pn * BM + wc * 32 + 4 * fq;
#pragma unroll
        for (int ai = 0; ai < 2; ++ai)
#pragma unroll
            for (int m = 0; m < 4; ++m) { const size_t row = (size_t)(row0 + ai * HALF + m * 16);
#pragma unroll
                for (int bj = 0; bj < 2; ++bj)
#pragma unroll
                    for (int n = 0; n < 2; ++n) { const int c = col0 + bj * HALF + n * 16;
                        const u32x2 gw = *(const u32x2*)(G + row * ldg + c);
                        f32x4 s; s[0] = sigmoidf_(bf_lo(gw.x)); s[1] = sigmoidf_(bf_hi(gw.x)); s[2] = sigmoidf_(bf_lo(gw.y)); s[3] = sigmoidf_(bf_hi(gw.y));
                        f32x4 v = s * acc[ai][bj][m][n];
                        if (MODE >= 1) v = v + *(const f32x4*)(m32 + row * 1024 + c);
                        if (MODE <= 1) *(f32x4*)(m32 + row * 1024 + c) = v;
                        else { u32x2 w; w.x = cvt_pk_bf16(v[0], v[1]); w.y = cvt_pk_bf16(v[2], v[3]); *(u32x2*)(mb + row * 1024 + c) = w; } }
                if (m & 1) asm volatile("" ::: "memory"); }
    }
};

template <class Epi, class Sched, bool ALIGN_EPI = false, bool SP2 = false>
__device__ __forceinline__ void gemm_phase(PG8_LAS unsigned char* lds, const Gemm g, const Sched& S, const Epi& E, const int wave_id) {
    int tid_; asm volatile("v_mbcnt_lo_u32_b32 %0, -1, 0\n\tv_mbcnt_hi_u32_b32 %0, -1, %0" : "=v"(tid_)); tid_ += wave_id * 64;
    const int tid = tid_, wid = __builtin_amdgcn_readfirstlane(tid >> 6), lane = tid & 63, wr = wid >> 2, wc = wid & 3, fr = lane & 15, fq = lane >> 4;
    const int K = g.K, nt = K / BK;
    unsigned voffA[2], voffB[2];
#pragma unroll
    for (int i = 0; i < 2; ++i) { int R, C; stage_rc(tid * 16 + i * 8192, R, C); const int Rb = Epi::PERM ? ((R & ~31) + perm32(R & 31)) : R;
        voffA[i] = (unsigned)(R * g.lda + C) * 2u; voffB[i] = (unsigned)(Rb * g.ldb + C) * 2u; }
    const size_t kstep = (size_t)(BK * 2);
    const size_t hstepA = (size_t)HALF * g.lda * 2, hstepB = (size_t)HALF * g.ldb * 2;
    const size_t tstepA = 2 * hstepA, tstepB = 2 * hstepB;
    const unsigned ldsw = (unsigned)wid * 1024u;
    const int aoff = lds_byte(wr * 64 + fr, fq * 8), boff = lds_byte(wc * 32 + fr, fq * 8);
#define PG8_SA(b, h) (((b) * 2 + (h)) * HTB)
#define PG8_SB(b, h) ((4 + (b) * 2 + (h)) * HTB)
#define PG8_STAGE(bufoff, gbase, voff) do { _Pragma("unroll") for (int _i = 0; _i < 2; ++_i) \
        __builtin_amdgcn_global_load_lds((const unsigned*)((const char*)(gbase) + (voff)[_i]), (PG8_LAS unsigned*)(lds + (bufoff) + ldsw + _i * 8192), 16, 0, 0); } while (0)
#define PG8_LDA(dst, b, h) do { _Pragma("unroll") for (int m = 0; m < 4; ++m) _Pragma("unroll") for (int k = 0; k < 2; ++k) dst[m][k] = *(const PG8_LAS bf16x8*)(lds + PG8_SA(b, h) + aoff + m * 2048 + k * 1024); } while (0)
#define PG8_LDB(dst, b, h) do { _Pragma("unroll") for (int n = 0; n < 2; ++n) _Pragma("unroll") for (int k = 0; k < 2; ++k) dst[n][k] = *(const PG8_LAS bf16x8*)(lds + PG8_SB(b, h) + boff + n * 2048 + k * 1024); } while (0)
#define PG8_MMA(ai, bj, At, Bt) do { __builtin_amdgcn_s_setprio(1); _Pragma("unroll") for (int m = 0; m < 4; ++m) _Pragma("unroll") for (int n = 0; n < 2; ++n) _Pragma("unroll") for (int k = 0; k < 2; ++k) \
        acc[ai][bj][m][n] = __builtin_amdgcn_mfma_f32_16x16x32_bf16(Bt[n][k], At[m][k], acc[ai][bj][m][n], 0, 0, 0); __builtin_amdgcn_s_setprio(0); } while (0)
#define PG8_WAIT_V(n) asm volatile("s_waitcnt vmcnt(" #n ")" ::: "memory")
#define PG8_WAIT_L(n) asm volatile("s_waitcnt lgkmcnt(" #n ")" ::: "memory")
#define PG8_BAR __builtin_amdgcn_s_barrier()
#define PG8_SCHED __builtin_amdgcn_sched_barrier(0)
    Unit cur, nxt; int ui = 0;
    if (!S.next(0, cur)) return;
    f32x4 acc[2][2][4][2];
#pragma unroll
    for (int a = 0; a < 2; ++a)
#pragma unroll
        for (int b = 0; b < 2; ++b)
#pragma unroll
            for (int m = 0; m < 4; ++m)
#pragma unroll
                for (int n = 0; n < 2; ++n) acc[a][b][m][n] = (f32x4){0.f, 0.f, 0.f, 0.f};
    bf16x8 At[4][2], B0[2][2], B1[2][2];
    const char* cA = (const char*)g.A + (size_t)cur.pm * tstepA; const char* cB = (const char*)g.Bt + cur.bofs + (size_t)cur.pn * tstepB;
    S.a_ready(cur);
    if constexpr (SP2) {
        PG8_STAGE(PG8_SB(0, 0), cB, voffB); PG8_STAGE(PG8_SB(0, 1), cB + hstepB, voffB); PG8_STAGE(PG8_SA(0, 0), cA, voffA); PG8_STAGE(PG8_SA(0, 1), cA + hstepA, voffA);
        if (wr == 1) PG8_BAR;
        PG8_WAIT_V(2); PG8_BAR;
        PG8_STAGE(PG8_SB(1, 0), cB + kstep, voffB); PG8_STAGE(PG8_SA(1, 0), cA + kstep, voffA); PG8_STAGE(PG8_SB(1, 1), cB + hstepB + kstep, voffB);
        PG8_WAIT_V(6); PG8_BAR;
    } else {
        PG8_STAGE(PG8_SB(0, 0), cB, voffB); PG8_STAGE(PG8_SA(0, 0), cA, voffA); PG8_STAGE(PG8_SB(0, 1), cB + hstepB, voffB); PG8_STAGE(PG8_SA(0, 1), cA + hstepA, voffA);
        if (wr == 1) PG8_BAR;
        PG8_WAIT_V(4); PG8_BAR;
        PG8_STAGE(PG8_SB(1, 0), cB + kstep, voffB); PG8_STAGE(PG8_SA(1, 0), cA + kstep, voffA); PG8_STAGE(PG8_SB(1, 1), cB + hstepB + kstep, voffB);
        PG8_WAIT_V(6); PG8_BAR;
    }
    for (;;) {
        const bool has_next = S.next(ui + 1, nxt);
        const char* nA = has_next ? (const char*)g.A + (size_t)nxt.pm * tstepA : cA; const char* nB = has_next ? (const char*)g.Bt + nxt.bofs + (size_t)nxt.pn * tstepB : cB;
        for (int t = 0; t < nt; t += 2) {
            const bool last = (t == nt - 2);
            const char* a1 = cA + (size_t)(t + 1) * kstep;
            const char* a2 = last ? nA : cA + (size_t)(t + 2) * kstep; const char* b2 = last ? nB : cB + (size_t)(t + 2) * kstep;
            const char* a3 = a2 + kstep; const char* b3 = b2 + kstep;
            if (last && has_next) S.a_ready(nxt);
            if constexpr (SP2) {
            PG8_LDB(B0, 0, 0); PG8_LDB(B1, 0, 1); PG8_SCHED; PG8_LDA(At, 0, 0); PG8_STAGE(PG8_SA(1, 1), a1 + hstepA, voffA);
            PG8_WAIT_V(8); PG8_WAIT_L(0); PG8_BAR; PG8_MMA(0, 0, At, B0); PG8_MMA(0, 1, At, B1); PG8_BAR; PG8_SCHED;
            PG8_LDA(At, 0, 1); PG8_STAGE(PG8_SB(0, 0), b2, voffB); PG8_STAGE(PG8_SB(0, 1), b2 + hstepB, voffB); PG8_STAGE(PG8_SA(0, 0), a2, voffA);
            PG8_WAIT_V(8); PG8_WAIT_L(0); PG8_BAR; PG8_MMA(1, 0, At, B0); PG8_MMA(1, 1, At, B1); PG8_BAR; PG8_SCHED;
            PG8_LDB(B0, 1, 0); PG8_LDB(B1, 1, 1); PG8_SCHED; PG8_LDA(At, 1, 0); PG8_STAGE(PG8_SA(0, 1), a2 + hstepA, voffA);
            PG8_WAIT_V(8); PG8_WAIT_L(0); PG8_BAR; PG8_MMA(0, 0, At, B0); PG8_MMA(0, 1, At, B1); PG8_BAR; PG8_SCHED;
            PG8_LDA(At, 1, 1); PG8_STAGE(PG8_SB(1, 0), b3, voffB); PG8_STAGE(PG8_SB(1, 1), b3 + hstepB, voffB); PG8_STAGE(PG8_SA(1, 0), a3, voffA);
            PG8_WAIT_V(8); PG8_WAIT_L(0); PG8_BAR; PG8_MMA(1, 0, At, B0); PG8_MMA(1, 1, At, B1); PG8_BAR; PG8_SCHED;
            } else {
            PG8_LDB(B0, 0, 0); PG8_SCHED; PG8_LDA(At, 0, 0); PG8_STAGE(PG8_SA(1, 1), a1 + hstepA, voffA);
            PG8_WAIT_L(8); PG8_BAR; PG8_WAIT_L(0); PG8_MMA(0, 0, At, B0); PG8_BAR; PG8_SCHED;
            PG8_LDB(B1, 0, 1); PG8_STAGE(PG8_SB(0, 0), b2, voffB);
            PG8_BAR; PG8_WAIT_L(0); PG8_MMA(0, 1, At, B1); PG8_BAR;
            PG8_LDA(At, 0, 1); PG8_STAGE(PG8_SA(0, 0), a2, voffA);
            PG8_BAR; PG8_WAIT_L(0); PG8_MMA(1, 0, At, B0); PG8_BAR; PG8_SCHED;
            PG8_STAGE(PG8_SB(0, 1), b2 + hstepB, voffB);
            PG8_WAIT_V(6); PG8_BAR; PG8_MMA(1, 1, At, B1); PG8_BAR;
            PG8_LDB(B0, 1, 0); PG8_SCHED; PG8_LDA(At, 1, 0); PG8_STAGE(PG8_SA(0, 1), a2 + hstepA, voffA);
            PG8_WAIT_L(8); PG8_BAR; PG8_WAIT_L(0); PG8_MMA(0, 0, At, B0); PG8_BAR; PG8_SCHED;
            PG8_LDB(B1, 1, 1); PG8_STAGE(PG8_SB(1, 0), b3, voffB);
            PG8_BAR; PG8_WAIT_L(0); PG8_MMA(0, 1, At, B1); PG8_BAR;
            PG8_LDA(At, 1, 1); PG8_STAGE(PG8_SA(1, 0), a3, voffA);
            PG8_BAR; PG8_WAIT_L(0); PG8_MMA(1, 0, At, B0); PG8_BAR; PG8_SCHED;
            PG8_STAGE(PG8_SB(1, 1), b3 + hstepB, voffB);
            PG8_WAIT_V(6); PG8_BAR; PG8_MMA(1, 1, At, B1); PG8_BAR;
            }
        }
        if constexpr (ALIGN_EPI) { if (wr == 0) PG8_BAR; }
        if constexpr (!Epi::AFTER_DRAIN) { E(acc, cur, wr, wc, fr, fq); S.done(cur); }
        if (!has_next) break;
#pragma unroll
        for (int a = 0; a < 2; ++a)
#pragma unroll
            for (int b = 0; b < 2; ++b)
#pragma unroll
                for (int m = 0; m < 4; ++m)
#pragma unroll
                    for (int n = 0; n < 2; ++n) acc[a][b][m][n] = (f32x4){0.f, 0.f, 0.f, 0.f};
        cur = nxt; cA = nA; cB = nB; ++ui;
        if constexpr (ALIGN_EPI) { if (wr == 1) PG8_BAR; }
    }
    PG8_WAIT_V(0);
    if constexpr (!ALIGN_EPI) { if (wr == 0) PG8_BAR; }
    PG8_BAR;
    if constexpr (Epi::AFTER_DRAIN) { E.fused(acc, cur, wr, wc, fr, fq, lds, wid, lane); S.done(cur); }
#undef PG8_SA
#undef PG8_SB
#undef PG8_STAGE
#undef PG8_LDA
#undef PG8_LDB
#undef PG8_MMA
#undef PG8_WAIT_V
#undef PG8_WAIT_L
#undef PG8_BAR
#undef PG8_SCHED
}
}
namespace attn_body {
using bf16=__hip_bfloat16;
using bf16x8=__attribute__((ext_vector_type(8)))short;
using s16x4=__attribute__((ext_vector_type(4)))short;
using f32x16=__attribute__((ext_vector_type(16)))float;
using u32x4=__attribute__((ext_vector_type(4)))unsigned;
constexpr int D=64;
constexpr int NW=8,QBLK=32,QB=QBLK*NW,KVBLK=64;
constexpr int ATTN_UNIT_ROWS=QB;
__device__ __forceinline__ int crow(int r,int hi){return (r&3)+8*(r>>2)+4*hi;}
#define SBAR() __builtin_amdgcn_sched_barrier(0)
constexpr int NSLOT=3, SLOTB=8192;
constexpr int LDS_K=0, LDS_V=NSLOT*SLOTB, LDS_WS=2*NSLOT*SLOTB, LDS_OST=LDS_WS+NW*64*4, LDS_BYTES=LDS_OST+NW*4096;
constexpr float C2=0.125f*1.4426950408889634f;
__device__ __forceinline__ void glds16(const void*gsrc,unsigned lds_dst){unsigned keep;
  asm volatile("s_mov_b32 %0, m0\n\ts_mov_b32 m0, %2\n\ts_nop 0\n\tglobal_load_lds_dwordx4 %1, off\n\ts_mov_b32 m0, %0":"=&s"(keep):"v"(gsrc),"s"(lds_dst):"memory");}
__device__ __forceinline__ float max3f(float a,float b,float c){float r;asm("v_max3_f32 %0, %1, %2, %3":"=v"(r):"v"(a),"v"(b),"v"(c));return r;}
__device__ __forceinline__ float max2f(float a,float b){float r;asm("v_max_f32_e32 %0, %1, %2":"=v"(r):"v"(a),"v"(b));return r;}
__device__ __forceinline__ float fadd_s(float a,float b){float r;asm("v_add_f32_e32 %0, %1, %2":"=v"(r):"v"(a),"v"(b));return r;}
__device__ __forceinline__ float fsub_s(float a,float b){float r;asm("v_sub_f32_e32 %0, %1, %2":"=v"(r):"v"(a),"v"(b));return r;}
typedef float f32x2_t __attribute__((ext_vector_type(2))); typedef __bf16 bf16x2_t __attribute__((ext_vector_type(2)));
__device__ __forceinline__ unsigned cvtpk_s(float lo,float hi){f32x2_t v={lo,hi};bf16x2_t b=__builtin_convertvector(v,bf16x2_t);return __builtin_bit_cast(unsigned,b);}
#define WAIT_BAR(N) asm volatile("s_waitcnt vmcnt(" #N ") lgkmcnt(0)\n\ts_barrier":::"memory")

__device__ __forceinline__ void qkt(f32x16&p0,f32x16&p1,const char*Kslot,const bf16x8*qr,const f32x16&negm,int r32,int hi){
  const char*kb=Kslot+hi*1024+r32*16;
  #pragma unroll
  for(int d0=0;d0<4;++d0){
    const bf16x8 b0=*reinterpret_cast<const bf16x8*>(kb+d0*2048);
    const bf16x8 b1=*reinterpret_cast<const bf16x8*>(kb+d0*2048+512);
    if(d0==0){p0=__builtin_amdgcn_mfma_f32_32x32x16_bf16(b0,qr[0],negm,0,0,0);p1=__builtin_amdgcn_mfma_f32_32x32x16_bf16(b1,qr[0],negm,0,0,0);}
    else{p0=__builtin_amdgcn_mfma_f32_32x32x16_bf16(b0,qr[d0],p0,0,0,0);p1=__builtin_amdgcn_mfma_f32_32x32x16_bf16(b1,qr[d0],p1,0,0,0);}}
}
typedef __attribute__((address_space(3))) const char* lds_cptr;
typedef short v4i16_t __attribute__((ext_vector_type(4)));
__device__ __forceinline__ void kload8(bf16x8*kf,lds_cptr kp){
  kf[0]=*(const __attribute__((address_space(3))) bf16x8*)(kp);      kf[1]=*(const __attribute__((address_space(3))) bf16x8*)(kp+512);
  kf[2]=*(const __attribute__((address_space(3))) bf16x8*)(kp+2048); kf[3]=*(const __attribute__((address_space(3))) bf16x8*)(kp+2560);
  kf[4]=*(const __attribute__((address_space(3))) bf16x8*)(kp+4096); kf[5]=*(const __attribute__((address_space(3))) bf16x8*)(kp+4608);
  kf[6]=*(const __attribute__((address_space(3))) bf16x8*)(kp+6144); kf[7]=*(const __attribute__((address_space(3))) bf16x8*)(kp+6656);
}
__device__ __forceinline__ void kload2(bf16x8*kf,lds_cptr kp,int j){ kf[2*j]=*(const __attribute__((address_space(3))) bf16x8*)(kp+j*2048); kf[2*j+1]=*(const __attribute__((address_space(3))) bf16x8*)(kp+j*2048+512); }
__device__ __forceinline__ s16x4 vtr(lds_cptr p){ return __builtin_bit_cast(s16x4,__builtin_amdgcn_ds_read_tr16_b64_v4i16((__attribute__((address_space(3))) v4i16_t*)p)); }
__device__ __forceinline__ float rowmax(const f32x16&p0,const f32x16&p1){
  float a=max3f(p0[0],p0[1],p1[0]),b=max3f(p0[2],p0[3],p1[1]);a=max3f(a,p1[2],p1[3]);
  #pragma unroll
  for(int r=4;r<16;r+=4){a=max3f(a,p0[r],p0[r+1]);b=max3f(b,p0[r+2],p0[r+3]);a=max3f(a,p1[r],p1[r+1]);b=max3f(b,p1[r+2],p1[r+3]);}
  const float m=max2f(a,b);
  auto rr=__builtin_amdgcn_permlane32_swap(__float_as_uint(m),__float_as_uint(m),false,false);
  return max2f(__uint_as_float(rr[0]),__uint_as_float(rr[1]));
}
__device__ __forceinline__ void pv(f32x16*o,int vb,bf16x8 pa0,bf16x8 pa1,bf16x8 pa2,bf16x8 pa3){
  #pragma unroll
  for(int d0=0;d0<2;++d0){s16x4 lo[4],hi[4];
    #pragma unroll
    for(int ks=0;ks<4;++ks){
      asm volatile("ds_read_b64_tr_b16 %0,%1 offset:%c2":"=&v"(lo[ks]):"v"(vb),"i"(d0*4096+ks*1024):"memory");
      asm volatile("ds_read_b64_tr_b16 %0,%1 offset:%c2":"=&v"(hi[ks]):"v"(vb),"i"(d0*4096+ks*1024+512):"memory");}
    asm volatile("s_waitcnt lgkmcnt(0)":::"memory");SBAR();
    #define PK(k) (bf16x8){lo[k][0],lo[k][1],lo[k][2],lo[k][3],hi[k][0],hi[k][1],hi[k][2],hi[k][3]}
    o[d0]=__builtin_amdgcn_mfma_f32_32x32x16_bf16(pa0,PK(0),o[d0],0,0,0);
    o[d0]=__builtin_amdgcn_mfma_f32_32x32x16_bf16(pa1,PK(1),o[d0],0,0,0);
    o[d0]=__builtin_amdgcn_mfma_f32_32x32x16_bf16(pa2,PK(2),o[d0],0,0,0);
    o[d0]=__builtin_amdgcn_mfma_f32_32x32x16_bf16(pa3,PK(3),o[d0],0,0,0);
    #undef PK
  }
}


struct AttnJob { const bf16* Q; const bf16* K; const bf16* V; bf16* O; int qp, kp, op; int NT, n0, base0, base1; int bm, r0, rlo; const float* bias; };
constexpr int LDS_BTAB=LDS_BYTES, BTAB_BYTES=15*128*4, LDS_BYTES_ALL=LDS_BTAB+BTAB_BYTES;
typedef __attribute__((address_space(3))) const float* lds_fptr;
__device__ __forceinline__ void bmask(f32x16&p0,f32x16&p1,int w,int rlo,int qr,int rs,int cs,int hi,lds_fptr tp0){
  const float NEG=-INFINITY; const int kr=rlo+w;
  if(kr<rs||kr>rs+7){
    #pragma unroll
    for(int r=0;r<16;++r){p0[r]=NEG;p1[r]=NEG;}
  } else {
    const lds_fptr tp=tp0+(kr-qr+7)*128;
    #pragma unroll
    for(int r=0;r<16;++r){ const int kc0=(r&3)+8*(r>>2); const int kc=kc0+4*hi; const float b0=tp[kc0],b1=tp[kc0+32];
      p0[r]=((unsigned)(kc-cs)<16u)?p0[r]+b0:NEG; p1[r]=((unsigned)(kc+32-cs)<16u)?p1[r]+b1:NEG; }
  }
}
#ifndef ATTN_STORE16
#define ATTN_STORE16(p,v) (*(u32x4*)(p)=(v))
#endif
template<int THRL> __device__ __forceinline__ void attn_unit(const AttnJob&J,char*shm,const int wave_id){
  int tid_; asm volatile("v_mbcnt_lo_u32_b32 %0, -1, 0\n\tv_mbcnt_hi_u32_b32 %0, -1, %0":"=v"(tid_)); tid_+=wave_id*64; const int tid=tid_,lane=tid&63,r32=lane&31,hi=lane>>5; const int wid=__builtin_amdgcn_readfirstlane(tid>>6);
  const int qp=J.qp,kp=J.kp,op=J.op,n0=J.n0,base0=J.base0,base1=J.base1;
  const bf16*Qw=J.Q+(long)(wid*QBLK)*qp;
  const bf16*Kh=J.K,*Vh=J.V;
  const unsigned lds0=(unsigned)(uintptr_t)shm;
  float*wsf=(float*)(shm+LDS_WS)+wid*64;
  const bf16*ksrc=Kh+(long)lane*kp+wid*8;
  const bf16*vsrc=Vh+(long)(16*(wid&3)+(lane>>2))*kp+(wid>>2)*32+(lane&3)*8;
  const unsigned kdst=lds0+LDS_K+wid*1024, vdst=lds0+LDS_V+wid*1024;
  #define KROW(t) (((t)<n0)?(base0+KVBLK*(t)):(base1+KVBLK*((t)-n0)))
  #define DMA_K(t,slot) glds16(ksrc+(long)KROW(t)*kp,(unsigned)__builtin_amdgcn_readfirstlane(kdst+(slot)))
  #define DMA_V(t,slot) glds16(vsrc+(long)KROW(t)*kp,(unsigned)__builtin_amdgcn_readfirstlane(vdst+(slot)))
  const int vb0=(int)(lds0+LDS_V)+((lane>>4)&1)*32+(lane&3)*8+(4*hi+((lane&15)>>2))*64;
  const char*Kbase=shm+LDS_K; bf16x8 kf[8];
  const lds_cptr shm3=(lds_cptr)shm; const lds_cptr kp0=shm3+LDS_K+hi*1024+r32*16; const lds_cptr vp0=shm3+LDS_V+((lane>>4)&1)*32+(lane&3)*8+(4*hi+((lane&15)>>2))*64;
  const int NT=J.NT;
  const int NTs=J.bm?0:NT;
  const int qr_=J.r0+(wid>>1), qc_=32*(wid&1)+r32; const int rs_=min(max(qr_-4,0),120), cs_=min(max(qc_-8,0),48), rlo_=J.rlo; const bool bm_=J.bm!=0;
  const lds_fptr btp_=(lds_fptr)((lds_cptr)shm+LDS_BTAB)+(63-qc_+4*hi);
  if(bm_){ __attribute__((address_space(3))) float*bt=(__attribute__((address_space(3))) float*)((__attribute__((address_space(3))) char*)shm+LDS_BTAB);
    for(int i=tid;i<15*128;i+=NW*64){const int dr=i>>7,dc=(i&127)-63; bt[i]=(dc>=-15&&dc<=15)?J.bias[dr*31+dc+15]*1.4426950408889634f:0.f;} }
  DMA_K(0,0);DMA_V(0,0);DMA_K(1,SLOTB);
  bf16x8 qr[4];
  #pragma unroll
  for(int d0=0;d0<4;++d0)qr[d0]=*reinterpret_cast<const bf16x8*>(&Qw[(long)r32*qp+d0*16+hi*8]);
  float mhat=0.f,l_reg=0.f;f32x16 o[2];o[0]=f32x16{};o[1]=f32x16{};f32x16 negm=f32x16{};asm volatile("":"+v"(negm));
  #define CMASK(P0,P1,t) do{ if(bm_&&(t)>=4)bmask(P0,P1,(t)-4,rlo_,qr_,rs_,cs_,hi,btp_); }while(0)
  bool resc=false;
  #define START(P0,P1) do{ const float rm=rowmax(P0,P1); resc=false; \
    { const float dl=rm; mhat=fadd_s(mhat,dl); \
      _Pragma("unroll") for(int r=0;r<16;++r){P0[r]=fsub_s(P0[r],dl);P1[r]=fsub_s(P1[r],dl);} \
      _Pragma("unroll") for(int r=0;r<16;++r)negm[r]=-mhat; asm volatile("":"+v"(negm)); } \
    _Pragma("unroll") for(int r=0;r<16;++r)P0[r]=__builtin_amdgcn_exp2f(P0[r]); }while(0)
  #define RESC() do{ if(resc){ asm volatile("s_waitcnt lgkmcnt(0)":::"memory"); \
      _Pragma("unroll") for(int d_=0;d_<2;++d_) _Pragma("unroll") for(int r=0;r<16;++r)o[d_][r]*=wsf[crow(r,hi)]; } }while(0)
  f32x16 pA0,pA1,pB0,pB1;
  int sl_prev=0,sl_cur=0,sl_next=SLOTB;
  #define ROT() do{sl_prev=sl_cur;sl_cur=sl_next;sl_next=(sl_next==(NSLOT-1)*SLOTB)?0:sl_next+SLOTB;}while(0)
  DMA_K(2,2*SLOTB);
  WAIT_BAR(3);
  qkt(pA0,pA1,Kbase,qr,negm,r32,hi);asm volatile("s_nop 15\n\ts_nop 7":"+v"(pA0),"+v"(pA1));CMASK(pA0,pA1,0);
  START(pA0,pA1);
  _Pragma("unroll") for(int r=0;r<16;++r)pA1[r]=__builtin_amdgcn_exp2f(pA1[r]);
  WAIT_BAR(0);
  DMA_K(3,0);DMA_V(1,SLOTB);
  ROT();
  kload8(kf,kp0+sl_cur);
  WAIT_BAR(2);
  s16x4 vlo[8],vhi[8]; u32x4 pw0,pw1,pw2,pw3;
  #define PKW(P,B) cvtpk_s(P[B],P[B+1])
  #define PAF(k) __builtin_bit_cast(bf16x8,pw##k)
  #define VFR(i) (bf16x8){vlo[i][0],vlo[i][1],vlo[i][2],vlo[i][3],vhi[i][0],vhi[i][1],vhi[i][2],vhi[i][3]}
  #define PIN(x) asm volatile("":"+v"(x))
  #define MX3(a,b,c) __builtin_fmaxf(__builtin_fmaxf((a),(b)),(c))
  #define GAPA(MF,A0,A1,A2,A3,W0,W1,PW) do{ MF; sacc+=A0; sacc+=A1; sacc+=A2; sacc+=A3; PIN(sacc); W0; W1; PIN(PW); SBAR(); }while(0)
  #define EX(v) __builtin_amdgcn_exp2f(v)
  #define GAPB(MF,X,B) do{ MF; X[B]=EX(X[B]); X[B+1]=EX(X[B+1]); X[B+2]=EX(X[B+2]); X[B+3]=EX(X[B+3]); PIN(X); SBAR(); }while(0)
  #define VRD(i) do{ vlo[i]=vtr(vp_+(((i)>>2)*4096+((i)&3)*1024)); vhi[i]=vtr(vp_+(((i)>>2)*4096+((i)&3)*1024+512)); }while(0)
  #define KRD(G,j) do{ if(G){ kload2(kf,kp0+sl_next,j); SBAR(); } }while(0)
  #define STEP(C0,C1,P0,P1,t,GK,GV,GL) do{ SBAR(); \
    const lds_cptr vp_=vp0+sl_prev; \
    VRD(0); SBAR(); float sacc=(P0[0]+P0[1]); \
    GAPA(C0=__builtin_amdgcn_mfma_f32_32x32x16_bf16(kf[0],qr[0],negm,0,0,0), P0[2],P0[3],P0[4],P0[5],     pw0[0]=PKW(P0,0), pw0[1]=PKW(P0,2), pw0); \
    VRD(4); SBAR(); GAPA(C1=__builtin_amdgcn_mfma_f32_32x32x16_bf16(kf[1],qr[0],negm,0,0,0), P0[6],P0[7],P0[8],P0[9],     pw0[2]=PKW(P0,4), pw0[3]=PKW(P0,6), pw0); \
    VRD(1); SBAR(); GAPA(C0=__builtin_amdgcn_mfma_f32_32x32x16_bf16(kf[2],qr[1],C0,0,0,0),   P0[10],P0[11],P0[12],P0[13], pw1[0]=PKW(P0,8), pw1[1]=PKW(P0,10), pw1); \
    VRD(5); SBAR(); GAPA(C1=__builtin_amdgcn_mfma_f32_32x32x16_bf16(kf[3],qr[1],C1,0,0,0),   P0[14],P0[15],P1[0],P1[1],   pw1[2]=PKW(P0,12),pw1[3]=PKW(P0,14), pw1); \
    VRD(2); SBAR(); GAPA(C0=__builtin_amdgcn_mfma_f32_32x32x16_bf16(kf[4],qr[2],C0,0,0,0),   P1[2],P1[3],P1[4],P1[5],     pw2[0]=PKW(P1,0), pw2[1]=PKW(P1,2), pw2); \
    VRD(6); SBAR(); GAPA(C1=__builtin_amdgcn_mfma_f32_32x32x16_bf16(kf[5],qr[2],C1,0,0,0),   P1[6],P1[7],P1[8],P1[9],     pw2[2]=PKW(P1,4), pw2[3]=PKW(P1,6), pw2); \
    VRD(3); SBAR(); GAPA(C0=__builtin_amdgcn_mfma_f32_32x32x16_bf16(kf[6],qr[3],C0,0,0,0),   P1[10],P1[11],P1[12],P1[13], pw3[0]=PKW(P1,8), pw3[1]=PKW(P1,10), pw3); \
    VRD(7); SBAR(); GAPA(C1=__builtin_amdgcn_mfma_f32_32x32x16_bf16(kf[7],qr[3],C1,0,0,0),   P1[14],P1[15],0.f,0.f,       pw3[2]=PKW(P1,12),pw3[3]=PKW(P1,14), pw3); \
    l_reg+=sacc; \
    if(GK){DMA_K((t)+3,sl_cur);} if(GV){DMA_V((t)+1,sl_next);} \
    CMASK(C0,C1,t); \
    { float a=MX3(C0[0],C0[1],C1[0]),b=MX3(C0[2],C0[3],C1[1]); a=MX3(a,C1[2],C1[3]); \
      _Pragma("unroll") for(int r=4;r<16;r+=4){a=MX3(a,C0[r],C0[r+1]);b=MX3(b,C0[r+2],C0[r+3]);a=MX3(a,C1[r],C1[r+1]);b=MX3(b,C1[r+2],C1[r+3]);} \
      float rm=__builtin_fmaxf(a,b); { auto rr=__builtin_amdgcn_permlane32_swap(__float_as_uint(rm),__float_as_uint(rm),false,false); rm=__builtin_fmaxf(__uint_as_float(rr[0]),__uint_as_float(rr[1])); } \
      resc=false; \
      if(__builtin_expect(__any(rm>(float)THRL),0)){ const float dl=__builtin_fmaxf(rm,0.f); mhat+=dl; \
        _Pragma("unroll") for(int r=0;r<16;++r){C0[r]-=dl;C1[r]-=dl;} \
        _Pragma("unroll") for(int r=0;r<16;++r)negm[r]=-mhat; asm volatile("":"+v"(negm)); \
        const float f=__builtin_amdgcn_exp2f(-dl); l_reg*=f; if(hi==0)wsf[r32]=f; resc=true; } } \
    SBAR(); \
    GAPB(o[0]=__builtin_amdgcn_mfma_f32_32x32x16_bf16(PAF(0),VFR(0),o[0],0,0,0), C0,0); \
    GAPB(o[1]=__builtin_amdgcn_mfma_f32_32x32x16_bf16(PAF(0),VFR(4),o[1],0,0,0), C0,4); \
    KRD(GL,0); GAPB(o[0]=__builtin_amdgcn_mfma_f32_32x32x16_bf16(PAF(1),VFR(1),o[0],0,0,0), C0,8); \
    KRD(GL,1); GAPB(o[1]=__builtin_amdgcn_mfma_f32_32x32x16_bf16(PAF(1),VFR(5),o[1],0,0,0), C0,12); \
    KRD(GL,2); GAPB(o[0]=__builtin_amdgcn_mfma_f32_32x32x16_bf16(PAF(2),VFR(2),o[0],0,0,0), C1,0); \
    KRD(GL,3); GAPB(o[1]=__builtin_amdgcn_mfma_f32_32x32x16_bf16(PAF(2),VFR(6),o[1],0,0,0), C1,4); \
    GAPB(o[0]=__builtin_amdgcn_mfma_f32_32x32x16_bf16(PAF(3),VFR(3),o[0],0,0,0), C1,8); \
    GAPB(o[1]=__builtin_amdgcn_mfma_f32_32x32x16_bf16(PAF(3),VFR(7),o[1],0,0,0), C1,12); \
    }while(0)
  int t=1;
  #undef CMASK
  #define CMASK(P0,P1,t) do{}while(0)
  for(;t+5<NTs;t+=2){
    STEP(pB0,pB1,pA0,pA1,t,true,true,true);     WAIT_BAR(2); RESC(); ROT();
    STEP(pA0,pA1,pB0,pB1,t+1,true,true,true);   WAIT_BAR(2); RESC(); ROT();
  }
  #undef CMASK
  #define CMASK(P0,P1,t) do{ if(bm_&&(t)>=4)bmask(P0,P1,(t)-4,rlo_,qr_,rs_,cs_,hi,btp_); }while(0)
  #define ENDW(tt) do{ if((tt)+3<NT){WAIT_BAR(2);} else if((tt)+2<NT){WAIT_BAR(1);} else {WAIT_BAR(0);} }while(0)
  for(;t+1<NT;t+=2){
    STEP(pB0,pB1,pA0,pA1,t,(t+3<NT),(t+1<NT),(t+1<NT));       ENDW(t);   RESC(); ROT();
    STEP(pA0,pA1,pB0,pB1,t+1,(t+4<NT),(t+2<NT),(t+2<NT));     ENDW(t+1); RESC(); ROT();
  }
  STEP(pB0,pB1,pA0,pA1,NT-1,false,false,false); RESC();
  { float sacc=pB0[0]+pB0[1]; _Pragma("unroll") for(int r=2;r<16;++r)sacc+=pB0[r]; _Pragma("unroll") for(int r=0;r<16;++r)sacc+=pB1[r]; l_reg+=sacc;
    pw0=(u32x4){PKW(pB0,0),PKW(pB0,2),PKW(pB0,4),PKW(pB0,6)};pw1=(u32x4){PKW(pB0,8),PKW(pB0,10),PKW(pB0,12),PKW(pB0,14)};pw2=(u32x4){PKW(pB1,0),PKW(pB1,2),PKW(pB1,4),PKW(pB1,6)};pw3=(u32x4){PKW(pB1,8),PKW(pB1,10),PKW(pB1,12),PKW(pB1,14)};
    SBAR(); pv(o,vb0+sl_cur,PAF(0),PAF(1),PAF(2),PAF(3)); }
  #undef PKW
  #undef PAF
  #undef VFR
  #undef PIN
  #undef MX3
  #undef GAPA
  #undef GAPB
  #undef EX
  #undef VRD
  #undef KRD
  #undef STEP
  #undef ENDW
  {auto rr=__builtin_amdgcn_permlane32_swap(__float_as_uint(l_reg),__float_as_uint(l_reg),false,false);l_reg=__uint_as_float(rr[0])+__uint_as_float(rr[1]);}
  if(hi==0)wsf[32+r32]=l_reg;asm volatile("s_waitcnt lgkmcnt(0)":::"memory");
  float rli[16];
  #pragma unroll
  for(int r=0;r<16;++r)rli[r]=__builtin_amdgcn_rcpf(wsf[32+crow(r,hi)]);
  bf16*Ow=J.O+(long)(wid*QBLK)*op;
  { bf16*stg=(bf16*)(shm+LDS_OST)+wid*2048;
    #pragma unroll
    for(int r=0;r<16;++r){const int orow=crow(r,hi);
      #pragma unroll
      for(int d0=0;d0<2;++d0)stg[orow*64+d0*32+r32]=__float2bfloat16(o[d0][r]*rli[r]);}
    asm volatile("s_waitcnt lgkmcnt(0)":::"memory");
    #pragma unroll
    for(int i=0;i<4;++i){const int row=i*8+(lane>>3),ch=lane&7; const u32x4 v=*(const u32x4*)(stg+row*64+ch*8); ATTN_STORE16(Ow+(long)row*op+ch*8,v);} }
  asm volatile("s_waitcnt lgkmcnt(0)\n\ts_barrier":::"memory");
  #undef DMA_K
  #undef KROW
  #undef DMA_V
  #undef CMASK
  #undef START
  #undef RESC
  #undef ROT
}
constexpr int ATTN_LDS_BYTES=LDS_BYTES_ALL;
#undef SBAR
#undef WAIT_BAR
}

constexpr int NWAVES = 8;
constexpr int DM = 1024, NB = 2, SEQ = 8192, DEPTH = 4, CTXL = 256;
constexpr int M_LAT = NB * SEQ, M_CTX = NB * CTXL, M_ALL = M_LAT + M_CTX;
constexpr int INC = 4864;
constexpr int C_AQ = 0, C_AK = 512, C_AV = 640, C_BQ = 768, C_BK = 1024, C_BV = 1280, C_CU = 1536, C_G = 1792;
constexpr int DFF = 2816, DFFE = 3584, NE = 8;
constexpr int KVR = SEQ + CTXL;
constexpr int XG_ROWS = 36352;
constexpr float EPS = 1e-6f;
constexpr float C2F = 0.125f * 1.4426950408889634f;
constexpr float LOG2E = 1.4426950408889634f;

constexpr size_t MiB = 1u << 20;
constexpr size_t WS_CTL = 0, CTL_ZERO_BYTES = 1 * MiB;
constexpr size_t WS_MOD = 1 * MiB;
constexpr size_t WS_ROPE = WS_MOD + 512 * 1024;
constexpr size_t WS_CNT = WS_ROPE + 64 * 1024;
constexpr size_t WS_SEG = WS_CNT + 16 * 1024;
constexpr size_t WS_ROUTE = 2 * MiB;
constexpr size_t WS_SLOT = WS_ROUTE + 512 * 1024;
constexpr size_t WS_XC = 4 * MiB;
constexpr size_t WS_WIN = 6 * MiB;
constexpr size_t WS_WCAT = WS_WIN + (size_t)4 * INC * DM * 2;
constexpr size_t WS_WOUT = WS_WCAT + (size_t)4 * DM * DM * 2;
constexpr size_t WS_W13 = WS_WOUT + (size_t)4 * DM * DM * 2;
constexpr size_t WS_W2 = WS_W13 + (size_t)2 * 2 * DFF * DM * 2;
constexpr size_t WS_MW13 = WS_W2 + (size_t)2 * DM * DFF * 2;
constexpr size_t WS_MW2 = WS_MW13 + (size_t)2 * NE * 2 * DFFE * DM * 2;
constexpr size_t WS_XN = WS_MW2 + (size_t)2 * NE * DM * DFFE * 2;
constexpr size_t WS_XG = WS_XN + (size_t)M_ALL * DM * 2;
constexpr size_t WS_Y = WS_XG + (size_t)XG_ROWS * DM * 2;
constexpr size_t WS_R = WS_Y + (size_t)XG_ROWS * DM * 2;
constexpr size_t WS_PX = WS_R;
constexpr size_t WS_QA = WS_PX + (size_t)M_ALL * INC * 2;
constexpr size_t WS_KA = WS_QA + (size_t)M_ALL * 512 * 2;
constexpr size_t WS_VA = WS_KA + (size_t)NB * KVR * 128 * 2;
constexpr size_t WS_QB = WS_VA + (size_t)NB * KVR * 128 * 2;
constexpr size_t WS_KB = WS_QB + (size_t)M_ALL * 256 * 2;
constexpr size_t WS_VB = WS_KB + (size_t)NB * KVR * 256 * 2;
constexpr size_t WS_YCAT = WS_VB + (size_t)NB * KVR * 256 * 2;
constexpr size_t WS_MB = WS_YCAT + (size_t)M_ALL * DM * 2;
constexpr size_t WS_M32 = WS_MB + (size_t)M_ALL * DM * 2;
constexpr size_t WS_END = WS_M32 + (size_t)M_ALL * DM * 4;
constexpr size_t WS_H = WS_R;
static_assert(WS_H + (size_t)XG_ROWS * DFFE * 2 <= WS_M32, "H overlay fits below M32");
static_assert(WS_SEG + 64 <= WS_ROUTE && WS_SLOT + (size_t)M_ALL * 8 <= WS_XC && WS_XC + (size_t)M_CTX * DM * 4 <= WS_WIN, "small tables");
constexpr int CW_BAR = 4096;

constexpr int RING_OFF = 0, RING_BYTES = 131072;
constexpr int LDSCTL_OFF = RING_BYTES, MISC_OFF = LDSCTL_OFF + 320;
constexpr int LDS_BYTES = 147456;
static_assert(attn_body::ATTN_LDS_BYTES <= RING_BYTES, "attention LDS");

#define GAS __attribute__((address_space(1)))
#define LAS __attribute__((address_space(3)))
typedef unsigned short bf16;
typedef unsigned v4u __attribute__((ext_vector_type(4)));
typedef unsigned v2u __attribute__((ext_vector_type(2)));
typedef float f32x4 __attribute__((ext_vector_type(4)));
typedef GAS unsigned gu32;
#define RLX_AGENT __ATOMIC_RELAXED, __HIP_MEMORY_SCOPE_AGENT
#define LDS_WAIT() asm volatile("s_waitcnt lgkmcnt(0)" ::: "memory")
#define VM_WAIT() asm volatile("s_waitcnt vmcnt(0)" ::: "memory")
__device__ __forceinline__ unsigned f2bf(float f) { unsigned u = __builtin_bit_cast(unsigned, f); return (u + 0x7fffu + ((u >> 16) & 1u)) >> 16; }
__device__ __forceinline__ unsigned pk2(float lo, float hi) { return f2bf(lo) | (f2bf(hi) << 16); }
__device__ __forceinline__ float bflo(unsigned w) { return __uint_as_float(w << 16); }
__device__ __forceinline__ float bfhi(unsigned w) { return __uint_as_float(w & 0xffff0000u); }
__device__ __forceinline__ unsigned ldu(const unsigned* p) { return __hip_atomic_load(p, RLX_AGENT); }
__device__ __forceinline__ float ldf(const float* p) { return __uint_as_float(__hip_atomic_load((const unsigned*)p, RLX_AGENT)); }
#define XB_TMO      128
#define XB_XCNT(j)  (256  + 64 * (j))
#define XB_XSUB(j)  (1280 + 64 * (j))
#define XB_XGEN(j)  (2304 + 64 * (j))
#define XB_TOP      3328
#define XB_TOPGEN   3392
#define XCD_BAR_WORDS 3456
#define XB_SPIN_CAP (1u << 18)

__device__ __forceinline__ unsigned xb_ld(unsigned* p)              { return __hip_atomic_load(p, __ATOMIC_RELAXED, __HIP_MEMORY_SCOPE_AGENT); }
__device__ __forceinline__ unsigned xb_add(unsigned* p, unsigned v) { return __hip_atomic_fetch_add(p, v, __ATOMIC_RELAXED, __HIP_MEMORY_SCOPE_AGENT); }
__device__ __forceinline__ unsigned xb_xcc_id() { return (unsigned)__builtin_amdgcn_s_getreg((3 << 11) | 20) & 0xFu; }
#define XB_SPIN(cond, bar) do { unsigned _sp = 0; while (cond) { __builtin_amdgcn_s_sleep(1); \
    if ((++_sp & 255u) == 0u) { if (xb_ld(&(bar)[XB_TMO])) break; if (_sp > XB_SPIN_CAP) { atomicAdd(&(bar)[XB_TMO], 1u); break; } } } } while (0)

struct XcdBarrier {
    int w;
    unsigned* bar; unsigned x;
    volatile LAS unsigned* st;
};

__device__ __forceinline__ XcdBarrier xcd_barrier_post(unsigned* bar, volatile LAS unsigned* st) {
    XcdBarrier b; b.bar = bar; b.x = xb_xcc_id(); b.st = st; b.w = 0;
    if (threadIdx.x == 0) (void)xb_add(&bar[XB_XCNT(b.x)], 1u);
    return b;
}
__device__ __forceinline__ void xcd_barrier_complete(unsigned* bar, unsigned x, unsigned& nloc, unsigned& nx) {
    const unsigned G = gridDim.x * gridDim.y * gridDim.z;
    unsigned sum, cnt, mine, sp = 0u;
    for (;;) {
        sum = 0u; cnt = 0u; mine = 0u;
#pragma unroll
        for (unsigned j = 0; j < 16; ++j) { const unsigned c = xb_ld(&bar[XB_XCNT(j)]); sum += c; cnt += (c > 0u) ? 1u : 0u; mine = (j == x) ? c : mine; }
        if (sum == G) break;
        __builtin_amdgcn_s_sleep(1);
        if ((++sp & 255u) == 0u) { if (xb_ld(&bar[XB_TMO])) break; if (sp > XB_SPIN_CAP) { atomicAdd(&bar[XB_TMO], 1u); break; } }
    }
    nloc = mine > 0u ? mine : 1u; nx = cnt > 0u ? cnt : 1u;
}

__device__ __forceinline__ void xcd_barrier(const XcdBarrier& b) {
    asm volatile("s_waitcnt vmcnt(0)" ::: "memory");
    __syncthreads();
    int lane0_; asm volatile("v_mbcnt_lo_u32_b32 %0, -1, 0\n\tv_mbcnt_hi_u32_b32 %0, -1, %0" : "=v"(lane0_));
    if (b.w == 0 && lane0_ == 0) {
        unsigned* bar = b.bar;
        __builtin_amdgcn_s_waitcnt(0);
        unsigned nloc = b.st[0], nx = b.st[1];
        if (nloc == 0u) { xcd_barrier_complete(bar, b.x, nloc, nx); b.st[0] = nloc; b.st[1] = nx; }
        const unsigned old = xb_add(&bar[XB_XSUB(b.x)], 1u);
        const unsigned gen = old / nloc;
        if (old + 1u == (gen + 1u) * nloc) {
            __builtin_amdgcn_fence(__ATOMIC_RELEASE, "agent");
            asm volatile("s_waitcnt vmcnt(0)" ::: "memory");
            const unsigned og = xb_add(&bar[XB_TOP], 1u);
            const unsigned tg = og / nx;
            if (og + 1u == (tg + 1u) * nx) xb_add(&bar[XB_TOPGEN], 1u);
            else XB_SPIN(xb_ld(&bar[XB_TOPGEN]) == tg, bar);
            __builtin_amdgcn_fence(__ATOMIC_ACQUIRE, "agent");
            xb_add(&bar[XB_XGEN(b.x)], 1u);
            asm volatile("s_waitcnt vmcnt(0)" ::: "memory");
        } else {
            XB_SPIN(xb_ld(&bar[XB_XGEN(b.x)]) == gen, bar);
            __builtin_amdgcn_fence(__ATOMIC_ACQUIRE, "agent");
            asm volatile("s_waitcnt vmcnt(0)" ::: "memory");
        }
    }
    __syncthreads();
}

struct Args { const float* in[27]; float* out; unsigned char* ws; int ph_lo, ph_hi, single, pad; };
enum { I_X = 0, I_C, I_CTX, I_CCTX, I_WMOD, I_BMOD, I_N1G, I_N2G, I_WIN, I_QG, I_KG, I_RELB, I_POOLW, I_POOLS, I_WPA, I_WPB, I_WPC, I_WOUT,
       I_FW1, I_FW3, I_FW2, I_RW, I_RB, I_MW1, I_MW3, I_MW2, I_FING };

typedef __attribute__((address_space(4))) const unsigned char* karg_t;
__device__ __forceinline__ unsigned long long karg_u64(int off) { karg_t kp = (karg_t)__builtin_amdgcn_kernarg_segment_ptr(); return *(volatile __attribute__((address_space(4))) const unsigned long long*)(kp + off); }
#define KIN(i) ((const float*)karg_u64(8 * (i)))
#define KOUT() ((float*)karg_u64(8 * 27))
#define KWS() ((unsigned char*)karg_u64(8 * 28))

struct Frame {
    LAS unsigned char* lds;
    volatile LAS unsigned* MISC;
    int wave, vcu, G;
};
__device__ __forceinline__ int lane_id_l() { int l; asm volatile("v_mbcnt_lo_u32_b32 %0, -1, 0\n\tv_mbcnt_hi_u32_b32 %0, -1, %0" : "=v"(l)); return l; }

__device__ __forceinline__ float wave_sum(float v) {
#pragma unroll
    for (int o = 1; o < 64; o <<= 1) v += __shfl_xor(v, o);
    return v;
}
__device__ __forceinline__ float silu_f(float v) { return v / (1.0f + __expf(-v)); }

__device__ __forceinline__ void p0_transpose_item(const float* W, int K, int N, bf16* WT, int ldt, int koff, int mode, LAS float* scr, int item, int lane) {
    const int nblk = N / 32, kb = item / nblk, nb = item % nblk, k0 = 64 * kb, n0 = 32 * nb;
#pragma unroll 8
    for (int i = 0; i < 32; ++i) { const int kk = 2 * i + (lane >> 5); scr[kk * 33 + (lane & 31)] = W[(size_t)(k0 + kk) * N + n0 + (lane & 31)]; }
    LDS_WAIT(); asm volatile("" ::: "memory");
    const int c = lane & 7;
#pragma unroll
    for (int j = 0; j < 4; ++j) { const int n = (lane >> 3) + 8 * j; const LAS float* s = scr + (8 * c) * 33 + n;
        v4u o; o.x = pk2(s[0 * 33], s[1 * 33]); o.y = pk2(s[2 * 33], s[3 * 33]); o.z = pk2(s[4 * 33], s[5 * 33]); o.w = pk2(s[6 * 33], s[7 * 33]);
        const int ng = n0 + n; const int drow = mode == 0 ? ng : ((ng >> 2) * 8 + (mode == 2 ? 4 : 0) + (ng & 3));
        *(GAS v4u*)(WT + (size_t)drow * ldt + koff + k0 + 8 * c) = o; }
    LDS_WAIT(); asm volatile("" ::: "memory");
}
__device__ __forceinline__ void p0_prologue(Frame& F, const Args& a) {
    unsigned char* ws = KWS(); const int lane = lane_id_l(), tid = F.wave * 64 + lane; (void)tid;
    LAS float* scr = (LAS float*)(F.lds + RING_OFF + F.wave * 16384);
    const int gw = F.vcu * NWAVES + F.wave, NGW = F.G * NWAVES;
    constexpr int I0 = (DM / 64) * (INC / 32), I1 = (512 / 64) * (DM / 32), I2 = (256 / 64) * (DM / 32), I3 = (DM / 64) * (DM / 32), I4 = (DM / 64) * (DFF / 32), I6 = (DFF / 64) * (DM / 32),
                  I7 = (DM / 64) * (DFFE / 32), I9 = (DFFE / 64) * (DM / 32);
    constexpr int NITEMS = 4 * (I0 + I1 + I2 + I3) + 2 * (2 * I4 + I6) + 16 * (2 * I7 + I9);
    for (int it = gw; it < NITEMS; it += NGW) {
        int r = it;
        if (r < 4 * I0) { const int l = r / I0; p0_transpose_item(KIN(I_WIN) + (size_t)l * DM * INC, DM, INC, (bf16*)(ws + WS_WIN) + (size_t)l * INC * DM, DM, 0, 0, scr, r % I0, lane); continue; } r -= 4 * I0;
        if (r < 4 * I1) { const int l = r / I1; p0_transpose_item(KIN(I_WPA) + (size_t)l * 512 * DM, 512, DM, (bf16*)(ws + WS_WCAT) + (size_t)l * DM * DM, DM, 0, 0, scr, r % I1, lane); continue; } r -= 4 * I1;
        if (r < 4 * I2) { const int l = r / I2; p0_transpose_item(KIN(I_WPB) + (size_t)l * 256 * DM, 256, DM, (bf16*)(ws + WS_WCAT) + (size_t)l * DM * DM, DM, 512, 0, scr, r % I2, lane); continue; } r -= 4 * I2;
        if (r < 4 * I3) { const int l = r / I3; p0_transpose_item(KIN(I_WOUT) + (size_t)l * DM * DM, DM, DM, (bf16*)(ws + WS_WOUT) + (size_t)l * DM * DM, DM, 0, 0, scr, r % I3, lane); continue; } r -= 4 * I3;
        if (r < 2 * I4) { const int l = r / I4; p0_transpose_item(KIN(I_FW1) + (size_t)l * DM * DFF, DM, DFF, (bf16*)(ws + WS_W13) + (size_t)l * 2 * DFF * DM, DM, 0, 1, scr, r % I4, lane); continue; } r -= 2 * I4;
        if (r < 2 * I4) { const int l = r / I4; p0_transpose_item(KIN(I_FW3) + (size_t)l * DM * DFF, DM, DFF, (bf16*)(ws + WS_W13) + (size_t)l * 2 * DFF * DM, DM, 0, 2, scr, r % I4, lane); continue; } r -= 2 * I4;
        if (r < 2 * I6) { const int l = r / I6; p0_transpose_item(KIN(I_FW2) + (size_t)l * DFF * DM, DFF, DM, (bf16*)(ws + WS_W2) + (size_t)l * DM * DFF, DFF, 0, 0, scr, r % I6, lane); continue; } r -= 2 * I6;
        if (r < 16 * I7) { const int l = r / I7; p0_transpose_item(KIN(I_MW1) + (size_t)l * DM * DFFE, DM, DFFE, (bf16*)(ws + WS_MW13) + (size_t)l * 2 * DFFE * DM, DM, 0, 1, scr, r % I7, lane); continue; } r -= 16 * I7;
        if (r < 16 * I7) { const int l = r / I7; p0_transpose_item(KIN(I_MW3) + (size_t)l * DM * DFFE, DM, DFFE, (bf16*)(ws + WS_MW13) + (size_t)l * 2 * DFFE * DM, DM, 0, 2, scr, r % I7, lane); continue; } r -= 16 * I7;
        { const int l = r / I9; p0_transpose_item(KIN(I_MW2) + (size_t)l * DFFE * DM, DFFE, DM, (bf16*)(ws + WS_MW2) + (size_t)l * DM * DFFE, DFFE, 0, 0, scr, r % I9, lane); }
    }
    for (int it = gw; it < 4 * 4 * 8 * 16; it += NGW) {
        const int nchunk = it & 15, c8 = (it >> 4) & 7, g = (it >> 7) & 3, l = it >> 9;
        const int n = nchunk * 64 + lane;
        const float* pw = KIN(I_POOLW) + ((size_t)(l * 4 + g) * 64 + c8 * 8) * 64;
        const float* ps = KIN(I_POOLS) + l * 256 + g * 64;
        const float* wc = KIN(I_WPC) + ((size_t)l * 256 + g * 64) * DM + n;
        float acc[8];
#pragma unroll
        for (int cc = 0; cc < 8; ++cc) acc[cc] = 0.f;
        for (int j = 0; j < 64; ++j) { const float s = ps[j] * wc[(size_t)j * DM];
#pragma unroll
            for (int cc = 0; cc < 8; ++cc) acc[cc] += pw[cc * 64 + j] * s; }
        v4u o; o.x = pk2(acc[0], acc[1]); o.y = pk2(acc[2], acc[3]); o.z = pk2(acc[4], acc[5]); o.w = pk2(acc[6], acc[7]);
        *(GAS v4u*)((bf16*)(ws + WS_WCAT) + (size_t)l * DM * DM + (size_t)n * DM + 768 + g * 64 + c8 * 8) = o;
    }
    { const int gt = gw * 64 + lane;
      if (gt < 128 * 16) { const int pos = gt >> 4, i = gt & 15; const float inv = powf(10000.0f, -(float)(2 * i) / 32.0f); const float ang = (float)pos * inv;
          float* rp = (float*)(ws + WS_ROPE) + gt * 2; rp[0] = cosf(ang); rp[1] = sinf(ang); } }
    { LAS float* red = (LAS float*)(F.lds + RING_OFF);
      for (int it = F.vcu; it < 4 * 96; it += F.G) {
          __syncthreads();
          const int l = it / 96, n = (it % 96) * 64 + lane;
          const float* wm = KIN(I_WMOD) + (size_t)l * DM * 6144 + n;
          float a0 = 0.f, a1 = 0.f, a2 = 0.f; const float* cv = KIN(I_C); const float* ccv = KIN(I_CCTX);
          const int k0 = F.wave * 128;
#pragma unroll 4
          for (int k = k0; k < k0 + 128; ++k) { const float w = wm[(size_t)k * 6144];
              a0 += silu_f(cv[k]) * w; a1 += silu_f(cv[DM + k]) * w; a2 += silu_f(ccv[k]) * w; }
          red[(F.wave * 3 + 0) * 64 + lane] = a0; red[(F.wave * 3 + 1) * 64 + lane] = a1; red[(F.wave * 3 + 2) * 64 + lane] = a2;
          __syncthreads();
          if (F.wave < 3) { float s = 0.f;
#pragma unroll
              for (int w = 0; w < 8; ++w) s += red[(w * 3 + F.wave) * 64 + lane];
              ((float*)(ws + WS_MOD))[((size_t)l * 3 + F.wave) * 6144 + n] = s + KIN(I_BMOD)[l * 6144 + n]; }
      }
      __syncthreads(); }
}

struct RowIO { const float* xlat; const float* xctx; float* olat; float* octx; };
template <bool COMBINE, bool ROUTER, bool FINAL>
__device__ __forceinline__ void norm_rows(Frame& F, const Args& a, int nrows, RowIO io, const float* ng, const float* modl, int seg_sh, int seg_sc,
                                          const float* modprev, const float* rw, const float* rb, float* fout) {
    unsigned char* ws = KWS();
    const int lane = lane_id_l(), tid = F.wave * 64 + lane; (void)tid; const int gw = F.vcu * NWAVES + F.wave, NGW = F.G * NWAVES;
    bf16* XN = (bf16*)(ws + WS_XN); const bf16* Y = (const bf16*)(ws + WS_Y);
    LAS unsigned* cntL = (LAS unsigned*)(F.lds + RING_OFF);
    if (ROUTER) { __syncthreads(); if (tid < 8) cntL[tid] = 0u; __syncthreads(); }
    for (int r = gw; r < nrows; r += NGW) {
        const bool lat = r < M_LAT; const int mrow = lat ? (r >> 13) : 2;
        const float* src = lat ? io.xlat + (size_t)r * DM : io.xctx + (size_t)(r - M_LAT) * DM;
        f32x4 v[4];
#pragma unroll
        for (int j = 0; j < 4; ++j) v[j] = *(const GAS f32x4*)(src + 4 * lane + 256 * j);
        if (COMBINE) {
            const unsigned p0 = ldu((const unsigned*)(ws + WS_SLOT) + 2 * r), p1 = ldu((const unsigned*)(ws + WS_SLOT) + 2 * r + 1);
            const float w0 = ldf((const float*)(ws + WS_ROUTE) + 4 * r + 1), w1 = ldf((const float*)(ws + WS_ROUTE) + 4 * r + 2);
            const float* g2 = modprev + mrow * 6144 + 5 * DM;
#pragma unroll
            for (int j = 0; j < 4; ++j) { const int c = 4 * lane + 256 * j;
                const v2u y0 = *(const GAS v2u*)(Y + (size_t)p0 * DM + c), y1 = *(const GAS v2u*)(Y + (size_t)p1 * DM + c);
                const f32x4 g = *(const GAS f32x4*)(g2 + c);
                f32x4 f; f[0] = w0 * bflo(y0.x) + w1 * bflo(y1.x); f[1] = w0 * bfhi(y0.x) + w1 * bfhi(y1.x); f[2] = w0 * bflo(y0.y) + w1 * bflo(y1.y); f[3] = w0 * bfhi(y0.y) + w1 * bfhi(y1.y);
                v[j] = v[j] + g * f; }
            if (!FINAL) { float* dst = lat ? io.olat + (size_t)r * DM : io.octx + (size_t)(r - M_LAT) * DM;
#pragma unroll
                for (int j = 0; j < 4; ++j) *(GAS f32x4*)(dst + 4 * lane + 256 * j) = v[j]; }
        }
        float ss = 0.f;
#pragma unroll
        for (int j = 0; j < 4; ++j) ss += (v[j][0] * v[j][0] + v[j][1] * v[j][1]) + (v[j][2] * v[j][2] + v[j][3] * v[j][3]);
        const float rstd = 1.0f / sqrtf(wave_sum(ss) * (1.0f / DM) + EPS);
        if (FINAL) {
#pragma unroll
            for (int j = 0; j < 4; ++j) { const int c = 4 * lane + 256 * j; const f32x4 g = *(const GAS f32x4*)(ng + c); *(GAS f32x4*)(fout + (size_t)r * DM + c) = v[j] * rstd * g; }
            continue;
        }
        const float* sh = modl + mrow * 6144 + seg_sh * DM; const float* sc = modl + mrow * 6144 + seg_sc * DM;
        float lg[8];
        if (ROUTER) {
#pragma unroll
            for (int e = 0; e < 8; ++e) lg[e] = 0.f; }
#pragma unroll
        for (int j = 0; j < 4; ++j) { const int c = 4 * lane + 256 * j;
            const f32x4 g = *(const GAS f32x4*)(ng + c), s1 = *(const GAS f32x4*)(sc + c), s0 = *(const GAS f32x4*)(sh + c);
            f32x4 h = v[j] * rstd * g; h = h * (s1 + 1.0f) + s0;
            v2u o; o.x = pk2(h[0], h[1]); o.y = pk2(h[2], h[3]);
            *(GAS v2u*)(XN + (size_t)r * DM + c) = o;
            if (ROUTER) {
#pragma unroll
                for (int q = 0; q < 4; ++q) { const f32x4 wa = *(const GAS f32x4*)(rw + (size_t)(c + q) * 8), wb = *(const GAS f32x4*)(rw + (size_t)(c + q) * 8 + 4);
                    lg[0] += h[q] * wa[0]; lg[1] += h[q] * wa[1]; lg[2] += h[q] * wa[2]; lg[3] += h[q] * wa[3];
                    lg[4] += h[q] * wb[0]; lg[5] += h[q] * wb[1]; lg[6] += h[q] * wb[2]; lg[7] += h[q] * wb[3]; } }
        }
        if (ROUTER) {
#pragma unroll
            for (int e = 0; e < 8; ++e) lg[e] = wave_sum(lg[e]) + rb[e];
            int e0 = 0; float v0 = lg[0];
#pragma unroll
            for (int e = 1; e < 8; ++e) if (lg[e] > v0) { v0 = lg[e]; e0 = e; }
            int e1 = -1; float v1 = -INFINITY;
#pragma unroll
            for (int e = 0; e < 8; ++e) if (e != e0 && lg[e] > v1) { v1 = lg[e]; e1 = e; }
            const float p0 = 1.0f / (1.0f + __expf(v1 - v0)), p1 = 1.0f - p0;
            if (lane == 0) { v4u o; o.x = (unsigned)e0 | ((unsigned)e1 << 8); o.y = __float_as_uint(p0); o.z = __float_as_uint(p1); o.w = 0u;
                *(GAS v4u*)((unsigned*)(ws + WS_ROUTE) + 4 * r) = o;
                __hip_atomic_fetch_add(cntL + e0, 1u, __ATOMIC_RELAXED, __HIP_MEMORY_SCOPE_WORKGROUP); __hip_atomic_fetch_add(cntL + e1, 1u, __ATOMIC_RELAXED, __HIP_MEMORY_SCOPE_WORKGROUP); }
        }
    }
    if (ROUTER) { __syncthreads(); if (tid < 8) ((unsigned*)(ws + WS_CNT))[F.vcu * 8 + tid] = cntL[tid]; __syncthreads(); }
}

__device__ __forceinline__ void moe_gather(Frame& F, const Args& a, int nrows) {
    unsigned char* ws = KWS();
    const int lane = lane_id_l(), tid = F.wave * 64 + lane; (void)tid; const int gw = F.vcu * NWAVES + F.wave, NGW = F.G * NWAVES;
    LAS unsigned* L = (LAS unsigned*)(F.lds + RING_OFF);
    __syncthreads();
    if (tid < 32) L[tid] = 0u;
    __syncthreads();
    for (int idx = tid; idx < F.G * 8; idx += NWAVES * 64) { const unsigned v = ldu((const unsigned*)(ws + WS_CNT) + idx); const int wg = idx >> 3, e = idx & 7;
        __hip_atomic_fetch_add(L + e, v, __ATOMIC_RELAXED, __HIP_MEMORY_SCOPE_WORKGROUP);
        if (wg < F.vcu) __hip_atomic_fetch_add(L + 8 + e, v, __ATOMIC_RELAXED, __HIP_MEMORY_SCOPE_WORKGROUP); }
    __syncthreads();
    if (tid == 0) { unsigned t0 = 0u;
        for (int e = 0; e < 8; ++e) { L[16 + e] = t0 * 256u + L[8 + e]; t0 += (L[e] + 255u) >> 8; if (F.vcu == 0) ((unsigned*)(ws + WS_SEG))[e] = t0; } }
    __syncthreads();
    const bf16* XN = (const bf16*)(ws + WS_XN); bf16* XG = (bf16*)(ws + WS_XG);
    for (int r = gw; r < nrows; r += NGW) {
        const unsigned ee = ldu((const unsigned*)(ws + WS_ROUTE) + 4 * r); const int e0 = ee & 0xff, e1 = (ee >> 8) & 0xff;
        unsigned p0 = 0u, p1 = 0u;
        if (lane == 0) { p0 = L[16 + e0] + __hip_atomic_fetch_add(L + 24 + e0, 1u, __ATOMIC_RELAXED, __HIP_MEMORY_SCOPE_WORKGROUP);
                         p1 = L[16 + e1] + __hip_atomic_fetch_add(L + 24 + e1, 1u, __ATOMIC_RELAXED, __HIP_MEMORY_SCOPE_WORKGROUP);
                         v2u o; o.x = p0; o.y = p1; *(GAS v2u*)((unsigned*)(ws + WS_SLOT) + 2 * r) = o; }
        p0 = __builtin_amdgcn_readfirstlane(p0); p1 = __builtin_amdgcn_readfirstlane(p1);
        const v4u x0 = *(const GAS v4u*)(XN + (size_t)r * DM + 8 * lane), x1 = *(const GAS v4u*)(XN + (size_t)r * DM + 512 + 8 * lane);
        *(GAS v4u*)(XG + (size_t)p0 * DM + 8 * lane) = x0; *(GAS v4u*)(XG + (size_t)p0 * DM + 512 + 8 * lane) = x1;
        *(GAS v4u*)(XG + (size_t)p1 * DM + 8 * lane) = x0; *(GAS v4u*)(XG + (size_t)p1 * DM + 512 + 8 * lane) = x1;
    }
    __syncthreads();
}

__device__ __forceinline__ void prep_rows(Frame& F, const Args& a, int layer) {
    unsigned char* ws = KWS();
    const int lane = lane_id_l(), tid = F.wave * 64 + lane; (void)tid; const int gw = F.vcu * NWAVES + F.wave, NGW = F.G * NWAVES;
    const bf16* PX = (const bf16*)(ws + WS_PX);
    bf16* QA = (bf16*)(ws + WS_QA); bf16* KA = (bf16*)(ws + WS_KA); bf16* VA = (bf16*)(ws + WS_VA);
    bf16* QB = (bf16*)(ws + WS_QB); bf16* KB = (bf16*)(ws + WS_KB); bf16* VB = (bf16*)(ws + WS_VB); bf16* YC = (bf16*)(ws + WS_YCAT);
    const float* rope = (const float*)(ws + WS_ROPE);
    const float* qg = KIN(I_QG) + layer * 64; const float* kg = KIN(I_KG) + layer * 64;
    const int i8 = lane & 7;
    float gq[8], gk[8];
#pragma unroll
    for (int j = 0; j < 8; ++j) { gq[j] = qg[8 * i8 + j]; gk[j] = kg[8 * i8 + j]; }
    for (int r = gw; r < M_ALL; r += NGW) {
        const bool lat = r < M_LAT;
        const int b = lat ? (r >> 13) : ((r - M_LAT) >> 8), s = lat ? (r & 8191) : ((r - M_LAT) & 255);
        const int kvrow = b * KVR + (lat ? s : SEQ + s);
        const int gr = s >> 6, gc = s & 63;
        const bf16* px = PX + (size_t)r * INC;
        const int pos = (i8 < 4) ? gr : gc;
        float cs[8], sn[8];
#pragma unroll
        for (int j = 0; j < 8; ++j) { const int i = 8 * (i8 & 1) + j; cs[j] = ldf(rope + (pos * 16 + i) * 2); sn[j] = ldf(rope + (pos * 16 + i) * 2 + 1); }
#pragma unroll
        for (int which = 0; which < 2; ++which) {
            const int col = which == 0 ? C_AQ + 8 * lane : C_AK + 8 * (lane & 15);
            const v4u raw = *(const GAS v4u*)(px + col);
            float x[8]; x[0] = bflo(raw.x); x[1] = bfhi(raw.x); x[2] = bflo(raw.y); x[3] = bfhi(raw.y); x[4] = bflo(raw.z); x[5] = bfhi(raw.z); x[6] = bflo(raw.w); x[7] = bfhi(raw.w);
            float ss = 0.f;
#pragma unroll
            for (int j = 0; j < 8; ++j) ss += x[j] * x[j];
            ss += __shfl_xor(ss, 1); ss += __shfl_xor(ss, 2); ss += __shfl_xor(ss, 4);
            const float rstd = 1.0f / sqrtf(ss * (1.0f / 64.0f) + EPS);
            float y[8];
#pragma unroll
            for (int j = 0; j < 8; ++j) y[j] = x[j] * rstd * (which == 0 ? gq[j] : gk[j]);
            if (lat) {
#pragma unroll
                for (int j = 0; j < 8; ++j) { const float o = __shfl_xor(y[j], 2); y[j] = (i8 & 2) ? (y[j] * cs[j] + o * sn[j]) : (y[j] * cs[j] - o * sn[j]); }
            }
            const float scl = which == 0 ? C2F : 1.0f;
            v4u o; o.x = pk2(y[0] * scl, y[1] * scl); o.y = pk2(y[2] * scl, y[3] * scl); o.z = pk2(y[4] * scl, y[5] * scl); o.w = pk2(y[6] * scl, y[7] * scl);
            if (which == 0) *(GAS v4u*)(QA + (size_t)r * 512 + 8 * lane) = o;
            else if (lane < 16) *(GAS v4u*)(KA + (size_t)kvrow * 128 + 8 * lane) = o;
        }
        if (lane < 16) *(GAS v4u*)(VA + (size_t)kvrow * 128 + 8 * lane) = *(const GAS v4u*)(px + C_AV + 8 * lane);
        if (lane < 32) *(GAS v4u*)(KB + (size_t)kvrow * 256 + 8 * lane) = *(const GAS v4u*)(px + C_BK + 8 * lane);
        else           *(GAS v4u*)(VB + (size_t)kvrow * 256 + 8 * (lane - 32)) = *(const GAS v4u*)(px + C_BV + 8 * (lane - 32));
        if (lane < 32) { const v4u raw = *(const GAS v4u*)(px + C_BQ + 8 * lane);
            v4u o; o.x = pk2(bflo(raw.x) * C2F, bfhi(raw.x) * C2F); o.y = pk2(bflo(raw.y) * C2F, bfhi(raw.y) * C2F); o.z = pk2(bflo(raw.z) * C2F, bfhi(raw.z) * C2F); o.w = pk2(bflo(raw.w) * C2F, bfhi(raw.w) * C2F);
            *(GAS v4u*)(QB + (size_t)r * 256 + 8 * lane) = o; }
        { const int g = lane >> 4, w = 2 << g, N = lat ? SEQ : CTXL;
          const int lo = max(s - (w >> 1), 0), hi = min(s - (w >> 1) + w, N), cnt = hi - lo;
          const bf16* pb = PX + (size_t)(r - s + lo) * INC + C_CU + 4 * lane;
          float s0 = 0.f, s1 = 0.f, s2 = 0.f, s3 = 0.f;
          for (int i = 0; i < 16; ++i) { if (i < cnt) { const v2u u = *(const GAS v2u*)(pb + (size_t)i * INC); s0 += bflo(u.x); s1 += bfhi(u.x); s2 += bflo(u.y); s3 += bfhi(u.y); } }
          const v2u u = *(const GAS v2u*)(px + C_CU + 4 * lane); const float inv = 1.0f / (float)cnt;
          v2u o; o.x = pk2(s0 * inv - bflo(u.x), s1 * inv - bfhi(u.x)); o.y = pk2(s2 * inv - bflo(u.y), s3 * inv - bfhi(u.y));
          *(GAS v2u*)(YC + (size_t)r * DM + 768 + 4 * lane) = o; }
    }
}

#ifndef PHMASK
#define PHMASK 0xfff
#endif
#ifndef NAIVE_ATTN
#define NAIVE_ATTN 0
#endif
#if NAIVE_ATTN
__device__ __forceinline__ void naive_dense(const bf16* Q, int qp, const bf16* K, const bf16* V, int kp, int nkeys, bf16* O, int op, int lane) {
    const int qi = lane >> 1, hf = (lane & 1) * 32;
    float q[32], acc[32];
    { const bf16* qrow = Q + (size_t)qi * qp + hf;
#pragma unroll
      for (int d = 0; d < 32; d += 2) { const unsigned w = *(const GAS unsigned*)(qrow + d); q[d] = bflo(w); q[d + 1] = bfhi(w); acc[d] = 0.f; acc[d + 1] = 0.f; } }
    float m = -INFINITY, l = 0.f;
#pragma unroll 1
    for (int k = 0; k < nkeys; ++k) {
        const bf16* kr = K + (size_t)k * kp + hf; const bf16* vr = V + (size_t)k * kp + hf;
        float s = 0.f;
#pragma unroll
        for (int d = 0; d < 32; d += 2) { const unsigned w = *(const GAS unsigned*)(kr + d); s += q[d] * bflo(w) + q[d + 1] * bfhi(w); }
        s += __shfl_xor(s, 1);
        const float mn = fmaxf(m, s), al = exp2f(m - mn), p = exp2f(s - mn);
        l = l * al + p; m = mn;
#pragma unroll
        for (int d = 0; d < 32; d += 2) { const unsigned w = *(const GAS unsigned*)(vr + d); acc[d] = acc[d] * al + p * bflo(w); acc[d + 1] = acc[d + 1] * al + p * bfhi(w); }
    }
    const float il = 1.0f / l; bf16* orow = O + (size_t)qi * op + hf;
#pragma unroll
    for (int d = 0; d < 32; d += 2) *(GAS unsigned*)(orow + d) = pk2(acc[d] * il, acc[d + 1] * il);
}
__device__ __forceinline__ void naive_na(const bf16* Q, const bf16* K, const bf16* V, const float* bias, int r, int c0, bf16* O, int lane) {
    const int qi = lane >> 1, hf = (lane & 1) * 32, c = c0 + qi;
    float q[32], acc[32];
    { const bf16* qrow = Q + (size_t)qi * 256 + hf;
#pragma unroll
      for (int d = 0; d < 32; d += 2) { const unsigned w = *(const GAS unsigned*)(qrow + d); q[d] = bflo(w); q[d + 1] = bfhi(w); acc[d] = 0.f; acc[d + 1] = 0.f; } }
    const int rs = min(max(r - 4, 0), 120), cs = min(max(c - 8, 0), 48);
    float m = -INFINITY, l = 0.f;
#pragma unroll 1
    for (int k = 0; k < 128 + 256; ++k) {
        size_t krow; float bv = 0.f;
        if (k < 128) { const int kr = rs + (k >> 4), kc = cs + (k & 15); krow = (size_t)kr * 64 + kc; bv = bias[(kr - r + 7) * 31 + (kc - c + 15)] * LOG2E; }
        else krow = (size_t)SEQ + (k - 128);
        const bf16* kp_ = K + krow * 256 + hf; const bf16* vp_ = V + krow * 256 + hf;
        float s = 0.f;
#pragma unroll
        for (int d = 0; d < 32; d += 2) { const unsigned w = *(const GAS unsigned*)(kp_ + d); s += q[d] * bflo(w) + q[d + 1] * bfhi(w); }
        s += __shfl_xor(s, 1); s += bv;
        const float mn = fmaxf(m, s), al = exp2f(m - mn), p = exp2f(s - mn);
        l = l * al + p; m = mn;
#pragma unroll
        for (int d = 0; d < 32; d += 2) { const unsigned w = *(const GAS unsigned*)(vp_ + d); acc[d] = acc[d] * al + p * bflo(w); acc[d + 1] = acc[d + 1] * al + p * bfhi(w); }
    }
    const float il = 1.0f / l; bf16* orow = O + (size_t)qi * 1024 + hf;
#pragma unroll
    for (int d = 0; d < 32; d += 2) *(GAS unsigned*)(orow + d) = pk2(acc[d] * il, acc[d + 1] * il);
}
#endif

__device__ __forceinline__ void attn_phase_all(Frame& F, const Args& a, int layer, bool want_ctx, char* lds) {
    unsigned char* ws = KWS();
    const bf16* QA = (const bf16*)(ws + WS_QA); const bf16* KA = (const bf16*)(ws + WS_KA); const bf16* VA = (const bf16*)(ws + WS_VA);
    const bf16* QB = (const bf16*)(ws + WS_QB); const bf16* KB = (const bf16*)(ws + WS_KB); const bf16* VB = (const bf16*)(ws + WS_VB); bf16* YC = (bf16*)(ws + WS_YCAT);
    const float* relb = KIN(I_RELB) + (size_t)layer * 4 * 15 * 31;
#if NAIVE_ATTN
    const int gw = F.vcu * NWAVES + F.wave, NGW = F.G * NWAVES, lane = lane_id_l();
    for (int it = gw; it < 2 * 8 * 256; it += NGW) { const int blk = it & 255, h = (it >> 8) & 7, b = it >> 11; const size_t row = (size_t)b * SEQ + blk * 32;
        naive_dense(QA + row * 512 + h * 64, 512, KA + (size_t)b * KVR * 128 + (h >> 2) * 64, VA + (size_t)b * KVR * 128 + (h >> 2) * 64, 128, KVR, YC + row * 1024 + h * 64, 1024, lane); }
    for (int it = gw; it < 2 * 4 * 256; it += NGW) { const int rr = it & 255, h = (it >> 8) & 3, b = it >> 10; const int r = rr >> 1, c0 = (rr & 1) * 32; const size_t row = (size_t)b * SEQ + r * 64 + c0;
        naive_na(QB + row * 256 + h * 64, KB + (size_t)b * KVR * 256 + h * 64, VB + (size_t)b * KVR * 256 + h * 64, relb + h * 15 * 31, r, c0, YC + row * 1024 + 512 + h * 64, lane); }
    if (want_ctx) {
        for (int it = gw; it < 2 * 8 * 8; it += NGW) { const int blk = it & 7, h = (it >> 3) & 7, b = it >> 6; const size_t row = (size_t)M_LAT + b * CTXL + blk * 32;
            naive_dense(QA + row * 512 + h * 64, 512, KA + ((size_t)b * KVR + SEQ) * 128 + (h >> 2) * 64, VA + ((size_t)b * KVR + SEQ) * 128 + (h >> 2) * 64, 128, CTXL, YC + row * 1024 + h * 64, 1024, lane); }
        for (int it = gw; it < 2 * 4 * 8; it += NGW) { const int blk = it & 7, h = (it >> 3) & 3, b = it >> 5; const size_t row = (size_t)M_LAT + b * CTXL + blk * 32;
            naive_dense(QB + row * 256 + h * 64, 256, KB + ((size_t)b * KVR + SEQ) * 256 + h * 64, VB + ((size_t)b * KVR + SEQ) * 256 + h * 64, 256, CTXL, YC + row * 1024 + 512 + h * 64, 1024, lane); }
    }
#else
    typedef attn_body::bf16 abf;
    for (int ua = F.vcu; ua < 512; ua += F.G) {
        const int k = ua >> 8, x = (ua & 255) >> 5, i = ua & 31; const int bk = x >> 1, b = bk >> 1, kvh = bk & 1, h = kvh * 4 + (x & 1) * 2 + k;
        const size_t row = (size_t)b * SEQ + (size_t)i * 256;
        attn_body::AttnJob J; J.Q = (const abf*)(QA + row * 512 + h * 64); J.K = (const abf*)(KA + (size_t)b * KVR * 128 + kvh * 64); J.V = (const abf*)(VA + (size_t)b * KVR * 128 + kvh * 64);
        J.O = (abf*)(YC + row * 1024 + h * 64); J.qp = 512; J.kp = 128; J.op = 1024; J.NT = KVR / 64; J.n0 = KVR / 64; J.base0 = 0; J.base1 = 0; J.bm = 0; J.r0 = 0; J.rlo = 0; J.bias = relb;
        attn_body::attn_unit<8>(J, lds, F.wave);
    }
    for (int ub = F.vcu; ub < 256; ub += F.G) {
        const int b = ub >> 7, h = (ub >> 5) & 3, blk = ub & 31; const int r0 = 4 * blk, rlo = min(max(r0 - 4, 0), 116);
        const size_t row = (size_t)b * SEQ + (size_t)blk * 256;
        attn_body::AttnJob J; J.Q = (const abf*)(QB + row * 256 + h * 64); J.K = (const abf*)(KB + (size_t)b * KVR * 256 + h * 64); J.V = (const abf*)(VB + (size_t)b * KVR * 256 + h * 64);
        J.O = (abf*)(YC + row * 1024 + 512 + h * 64); J.qp = 256; J.kp = 256; J.op = 1024; J.NT = 16; J.n0 = 4; J.base0 = SEQ; J.base1 = rlo * 64; J.bm = 1; J.r0 = r0; J.rlo = rlo; J.bias = relb + h * 15 * 31;
        attn_body::attn_unit<8>(J, lds, F.wave);
    }
    if (want_ctx) {
        for (int uc = F.vcu; uc < 24; uc += F.G) {
            attn_body::AttnJob J; J.NT = 4; J.n0 = 4; J.base0 = SEQ; J.base1 = 0; J.bm = 0; J.r0 = 0; J.rlo = 0; J.bias = relb; J.op = 1024;
            if (uc < 16) { const int b = uc >> 3, h = uc & 7; const size_t row = (size_t)M_LAT + (size_t)b * CTXL;
                J.Q = (const abf*)(QA + row * 512 + h * 64); J.K = (const abf*)(KA + (size_t)b * KVR * 128 + (h >> 2) * 64); J.V = (const abf*)(VA + (size_t)b * KVR * 128 + (h >> 2) * 64);
                J.O = (abf*)(YC + row * 1024 + h * 64); J.qp = 512; J.kp = 128; }
            else { const int j = uc - 16, b = j >> 2, h = j & 3; const size_t row = (size_t)M_LAT + (size_t)b * CTXL;
                J.Q = (const abf*)(QB + row * 256 + h * 64); J.K = (const abf*)(KB + (size_t)b * KVR * 256 + h * 64); J.V = (const abf*)(VB + (size_t)b * KVR * 256 + h * 64);
                J.O = (abf*)(YC + row * 1024 + 512 + h * 64); J.qp = 256; J.kp = 256; }
            attn_body::attn_unit<8>(J, lds, F.wave);
        }
    }
#endif
}

constexpr int PH_PER_LAYER = 10, PH_FINAL = 1 + DEPTH * PH_PER_LAYER, PH_COUNT = PH_FINAL + 1;
__global__ void __launch_bounds__(NWAVES * 64, 2) fwd(Args args) {
    extern __shared__ __attribute__((aligned(16))) unsigned char lds[];
    Frame F;
    F.lds = (LAS unsigned char*)lds;
    F.MISC = (volatile LAS unsigned*)(F.lds + MISC_OFF);
    F.wave = __builtin_amdgcn_readfirstlane(threadIdx.x >> 6);
    F.G = gridDim.x; { const int bx = blockIdx.x; F.vcu = (F.G % 8 == 0) ? (bx % 8) * (F.G / 8) + bx / 8 : bx; }
    const int lo = args.ph_lo, hi = args.ph_hi; const bool single = args.single != 0;
    for (int u = threadIdx.x; u < (LDS_BYTES - LDSCTL_OFF) / 4; u += NWAVES * 64) ((LAS unsigned*)(F.lds + LDSCTL_OFF))[u] = 0u;
    __syncthreads();
    XcdBarrier bar; bar.bar = (unsigned*)(KWS() + WS_CTL) + CW_BAR; bar.x = 0; bar.st = nullptr; bar.w = F.wave;
    if (single) { bar = xcd_barrier_post((unsigned*)(KWS() + WS_CTL) + CW_BAR, F.MISC + 8); bar.w = F.wave; }
#define SEAM() do { if (single) { XcdBarrier b_ = bar; asm volatile("" : "+s"(b_.bar), "+s"(b_.x)); xcd_barrier(b_); } } while (0)
#define IN(k) (lo <= (k) && (k) < hi)
#define PHASE_VARS() int l = l_; asm volatile("" : "+s"(l)); unsigned char* const ws = KWS(); const int bx = (int)blockIdx.x; \
        const bool want_ctx = l < DEPTH - 1; const int fi = l >> 1; const int nMt = want_ctx ? 66 : 64, nrows = want_ctx ? M_ALL : M_LAT; \
        const float* const MODl = (const float*)(ws + WS_MOD) + (size_t)l * 3 * 6144; float* const XC = (float*)(ws + WS_XC); \
        (void)bx; (void)fi; (void)nMt; (void)nrows; (void)MODl; (void)XC

    if (((PHMASK >> 10) & 1) && IN(0)) { p0_prologue(F, args); SEAM(); }

    for (int l_ = 0; l_ < DEPTH; ++l_) {
        const int pb = 1 + l_ * PH_PER_LAYER;
        const bool moe = (l_ & 1) != 0;
        if (((PHMASK >> 0) & 1) && IN(pb + 0)) { PHASE_VARS();
            RowIO io{l == 0 ? KIN(I_X) : KOUT(), l == 0 ? KIN(I_CTX) : XC, KOUT(), XC};
            if (l == 2) norm_rows<true, false, false>(F, args, M_ALL, io, KIN(I_N1G) + l * DM, MODl, 0, 1, MODl - 3 * 6144, nullptr, nullptr, nullptr);
            else norm_rows<false, false, false>(F, args, M_ALL, io, KIN(I_N1G) + l * DM, MODl, 0, 1, nullptr, nullptr, nullptr, nullptr);
            SEAM();
        }
        if (((PHMASK >> 1) & 1) && IN(pb + 1)) { PHASE_VARS();
            pg8::Gemm g{(const bf16*)(ws + WS_XN), (const bf16*)(ws + WS_WIN) + (size_t)l * INC * DM, DM, DM, DM}; pg8::StaticOrder S; S.init(66, INC / 256, F.G, bx);
            pg8::EpiBf16 E{(bf16*)(ws + WS_PX), INC};
            pg8::gemm_phase<pg8::EpiBf16, pg8::StaticOrder, true, true>(F.lds + RING_OFF, g, S, E, F.wave);
            SEAM();
        }
        if (((PHMASK >> 2) & 1) && IN(pb + 2)) { PHASE_VARS(); prep_rows(F, args, l); SEAM(); }
        if (((PHMASK >> 3) & 1) && IN(pb + 3)) { PHASE_VARS(); attn_phase_all(F, args, l, want_ctx, (char*)lds + RING_OFF); SEAM(); }
        if (((PHMASK >> 4) & 1) && IN(pb + 4)) { PHASE_VARS();
            const bf16* wc = (const bf16*)(ws + WS_WCAT) + (size_t)l * DM * DM; const bf16* YC = (const bf16*)(ws + WS_YCAT); const bf16* PX = (const bf16*)(ws + WS_PX);
            float* M32 = (float*)(ws + WS_M32); bf16* MB = (bf16*)(ws + WS_MB);
            pg8::StaticOrder S; S.init(nMt, 4, F.G, bx);
            { pg8::Gemm g{YC, wc, 512, DM, DM}; pg8::EpiMerge<0> E{PX + C_G, INC, M32, MB}; pg8::gemm_phase<pg8::EpiMerge<0>, pg8::StaticOrder, true, true>(F.lds + RING_OFF, g, S, E, F.wave); }
            { pg8::Gemm g{YC + 512, wc + 512, 256, DM, DM}; pg8::EpiMerge<1> E{PX + C_G + 1024, INC, M32, MB}; pg8::gemm_phase<pg8::EpiMerge<1>, pg8::StaticOrder, true, true>(F.lds + RING_OFF, g, S, E, F.wave); }
            { pg8::Gemm g{YC + 768, wc + 768, 256, DM, DM}; pg8::EpiMerge<2> E{PX + C_G + 2048, INC, M32, MB}; pg8::gemm_phase<pg8::EpiMerge<2>, pg8::StaticOrder, true, true>(F.lds + RING_OFF, g, S, E, F.wave); }
            SEAM();
        }
        if (((PHMASK >> 5) & 1) && IN(pb + 5)) { PHASE_VARS();
            pg8::Gemm g{(const bf16*)(ws + WS_MB), (const bf16*)(ws + WS_WOUT) + (size_t)l * DM * DM, DM, DM, DM}; pg8::StaticOrder S; S.init(nMt, 4, F.G, bx);
            pg8::EpiResid E{l == 0 ? KIN(I_X) : KOUT(), l == 0 ? KIN(I_CTX) : XC, KOUT(), XC, MODl + 2 * DM};
            pg8::gemm_phase<pg8::EpiResid, pg8::StaticOrder, true, true>(F.lds + RING_OFF, g, S, E, F.wave);
            SEAM();
        }
        if (((PHMASK >> 6) & 1) && IN(pb + 6)) { PHASE_VARS();
            RowIO io{KOUT(), XC, KOUT(), XC};
            if (moe) norm_rows<false, true, false>(F, args, nrows, io, KIN(I_N2G) + l * DM, MODl, 3, 4, nullptr, KIN(I_RW) + (size_t)fi * DM * 8, KIN(I_RB) + fi * 8, nullptr);
            else norm_rows<false, false, false>(F, args, nrows, io, KIN(I_N2G) + l * DM, MODl, 3, 4, nullptr, nullptr, nullptr, nullptr);
            SEAM();
        }
        if (moe) {
            if (((PHMASK >> 7) & 1) && IN(pb + 7)) { PHASE_VARS(); moe_gather(F, args, nrows); SEAM(); }
            if (((PHMASK >> 8) & 1) && IN(pb + 8)) { PHASE_VARS();
                pg8::GroupedOrder S;
#pragma unroll
                for (int j = 0; j < 8; ++j) S.seg[j] = __builtin_amdgcn_readfirstlane((int)ldu((const unsigned*)(ws + WS_SEG) + j));
                S.so.init(S.seg[7], 2 * DFFE / 256, F.G, bx); S.estride = (long)2 * DFFE * DM * 2;
                pg8::Gemm g{(const bf16*)(ws + WS_XG), (const bf16*)(ws + WS_MW13) + (size_t)fi * NE * 2 * DFFE * DM, DM, DM, DM};
                pg8::EpiSwiGLU E{(bf16*)(ws + WS_H), DFFE};
                pg8::gemm_phase<pg8::EpiSwiGLU, pg8::GroupedOrder, true, true>(F.lds + RING_OFF, g, S, E, F.wave);
                SEAM();
            }
            if (((PHMASK >> 9) & 1) && IN(pb + 9)) { PHASE_VARS();
                pg8::GroupedOrder S;
#pragma unroll
                for (int j = 0; j < 8; ++j) S.seg[j] = __builtin_amdgcn_readfirstlane((int)ldu((const unsigned*)(ws + WS_SEG) + j));
                S.so.init(S.seg[7], 4, F.G, bx); S.estride = (long)DM * DFFE * 2;
                pg8::Gemm g{(const bf16*)(ws + WS_H), (const bf16*)(ws + WS_MW2) + (size_t)fi * NE * DM * DFFE, DFFE, DFFE, DFFE};
                pg8::EpiBf16 E{(bf16*)(ws + WS_Y), DM};
                pg8::gemm_phase<pg8::EpiBf16, pg8::GroupedOrder, true, true>(F.lds + RING_OFF, g, S, E, F.wave);
                SEAM();
            }
        } else {
            if (((PHMASK >> 8) & 1) && IN(pb + 8)) { PHASE_VARS();
                pg8::Gemm g{(const bf16*)(ws + WS_XN), (const bf16*)(ws + WS_W13) + (size_t)fi * 2 * DFF * DM, DM, DM, DM}; pg8::StaticOrder S; S.init(nMt, 2 * DFF / 256, F.G, bx);
                pg8::EpiSwiGLU E{(bf16*)(ws + WS_H), DFF};
                pg8::gemm_phase<pg8::EpiSwiGLU, pg8::StaticOrder, true, true>(F.lds + RING_OFF, g, S, E, F.wave);
                SEAM();
            }
            if (((PHMASK >> 9) & 1) && IN(pb + 9)) { PHASE_VARS();
                pg8::Gemm g{(const bf16*)(ws + WS_H), (const bf16*)(ws + WS_W2) + (size_t)fi * DM * DFF, DFF, DFF, DFF}; pg8::StaticOrder S; S.init(nMt, 4, F.G, bx);
                pg8::EpiResid E{KOUT(), XC, KOUT(), XC, MODl + 5 * DM};
                pg8::gemm_phase<pg8::EpiResid, pg8::StaticOrder, true, true>(F.lds + RING_OFF, g, S, E, F.wave);
                SEAM();
            }
        }
    }
    if (((PHMASK >> 11) & 1) && IN(PH_FINAL)) {
        unsigned char* const ws = KWS(); float* const XC = (float*)(ws + WS_XC);
        RowIO io{KOUT(), XC, KOUT(), XC};
        norm_rows<true, false, true>(F, args, M_LAT, io, KIN(I_FING), nullptr, 0, 0, (const float*)(ws + WS_MOD) + (size_t)3 * 3 * 6144, nullptr, nullptr, KOUT());
    }
#undef IN
#undef SEAM
#undef PHASE_VARS
}

#ifndef SINGLE_LAUNCH
#define SINGLE_LAUNCH 0
#endif
extern "C" void kernel_launch(void* const* d_in, const int* in_sizes, int n_in, void* d_out, int out_size, void* d_ws, size_t ws_size, hipStream_t stream) {
    static int grid = 0;
    if (grid == 0) {
        if (n_in != 27 || out_size != M_LAT * DM || ws_size < WS_END) { fprintf(stderr, "kernel_launch: unexpected shapes (n_in %d, out %d, ws %zu < %zu)\n", n_in, out_size, ws_size, (size_t)WS_END); grid = -1; return; }
        int dev = 0, cus = 0, per_cu = 0;
        if (hipGetDevice(&dev) != hipSuccess || hipDeviceGetAttribute(&cus, hipDeviceAttributeMultiprocessorCount, dev) != hipSuccess) { grid = -1; return; }
        if (hipFuncSetAttribute((const void*)fwd, hipFuncAttributeMaxDynamicSharedMemorySize, LDS_BYTES) != hipSuccess) { grid = -1; return; }
        if (hipOccupancyMaxActiveBlocksPerMultiprocessor(&per_cu, (const void*)fwd, NWAVES * 64, LDS_BYTES) != hipSuccess || per_cu < 1) { fprintf(stderr, "kernel_launch: occupancy query says %d\n", per_cu); }
        (void)hipGetLastError();
        grid = cus;
    }
    if (grid < 0) return;
    if (hipMemsetAsync((char*)d_ws + WS_CTL, 0, CTL_ZERO_BYTES, stream) != hipSuccess) return;
    Args a{};
    for (int i = 0; i < 27; ++i) a.in[i] = (const float*)d_in[i];
    a.out = (float*)d_out; a.ws = (unsigned char*)d_ws; a.pad = 0;
#if SINGLE_LAUNCH
    a.ph_lo = 0; a.ph_hi = PH_COUNT; a.single = 1;
    hipLaunchKernelGGL(fwd, dim3(grid), dim3(NWAVES * 64), LDS_BYTES, stream, a);
#else
    a.single = 0;
    for (int ph = 0; ph < PH_COUNT; ++ph) {
        if (ph >= 1 && ph < PH_FINAL) { const int l = (ph - 1) / PH_PER_LAYER, k = (ph - 1) % PH_PER_LAYER; if (k == 7 && !(l & 1)) continue; }
        a.ph_lo = ph; a.ph_hi = ph + 1;
        hipLaunchKernelGGL(fwd, dim3(grid), dim3(NWAVES * 64), LDS_BYTES, stream, a);
    }
#endif
}
```

```cpp
#include <hip/hip_runtime.h>
#include <hip/hip_bf16.h>
#include <cstdio>
#include <cstdint>
#include <cmath>
#define SINGLE_LAUNCH 1
namespace pg8 {
#define PG8_LAS __attribute__((address_space(3)))
typedef unsigned short bf16_t;
typedef short bf16x8 __attribute__((ext_vector_type(8)));
typedef float f32x4 __attribute__((ext_vector_type(4)));
typedef unsigned u32x4 __attribute__((ext_vector_type(4)));
constexpr int BM = 256, BK = 64, HALF = 128, HTB = HALF * BK * 2  , STAGE_BYTES = 8 * HTB, NXCD = 8, WGM = 4;

__host__ __device__ __forceinline__ int lds_byte(int r, int c) { const int st = (r >> 4) * 2 + (c >> 5), rr = r & 15, cc = c & 31, ob = rr * 64 + cc * 2; return st * 1024 + (ob ^ (((ob >> 9) & 1) << 5)); }
__host__ __device__ __forceinline__ void stage_rc(int b, int& R, int& C) { const int st = b / 1024, sb = b % 1024, swz = sb ^ (((sb >> 9) & 1) << 5); R = (st >> 1) * 16 + swz / 64; C = (st & 1) * 32 + (swz % 64) / 2; }
__host__ __device__ __forceinline__ int perm32(int rho) { const int n = rho >> 4, i = rho & 15; return 8 * (i >> 2) + 4 * n + (i & 3); }


struct Unit { int pm, pn, ks; long aofs, bofs; };
struct Gemm { const bf16_t* A; const bf16_t* Bt; int K, lda, ldb; int sw = 0x7F7F7F7F, sa = 0x7F7F7F7F; };

struct StaticOrder {
    int nM, nN, nwg, G, c;
    __device__ __forceinline__ void init(int nM_, int nN_, int G_, int c_) { nM = nM_; nN = nN_; nwg = nM * nN; G = G_; c = c_; }
    __device__ __forceinline__ bool next(int i, Unit& u) const {
        const long L = (long)i * G + c; if (L >= nwg) return false;
        int wgid = (int)L; { const int q = nwg / NXCD, r = nwg % NXCD, xcd = wgid % NXCD, off = wgid / NXCD; wgid = (xcd < r ? xcd * (q + 1) : r * (q + 1) + (xcd - r) * q) + off; }
        const int nig = WGM * nN, gid = wgid / nig, fm = gid * WGM, gsz = (nM - fm) < WGM ? (nM - fm) : WGM;
        u.pm = fm + ((wgid % nig) % gsz); u.pn = (wgid % nig) / gsz; u.ks = 0; u.aofs = 0; u.bofs = 0; return true;
    }
    __device__ __forceinline__ void a_ready(const Unit&) const {}
    __device__ __forceinline__ void done(const Unit&) const {}
};
struct SplitKOrder {
    int S, Ks, G, c, pm0;
    __device__ __forceinline__ bool next(int i, Unit& u) const {
        const int L = i * G + c; if (L >= 8 * S) return false;
        const int tile = L / S, s = L % S; u.pm = pm0 + (tile >> 2); u.pn = tile & 3; u.ks = s; u.aofs = (long)s * Ks * 2; u.bofs = (long)s * Ks * 2; return true;
    }
    __device__ __forceinline__ void a_ready(const Unit&) const {}
    __device__ __forceinline__ void done(const Unit&) const {}
};
struct GroupedSplitKOrder {
    int S, Ks, G, c, pm0, ntail; int seg[8]; long estride;
    __device__ __forceinline__ bool next(int i, Unit& u) const {
        const int L = i * G + c; if (L >= ntail * 4 * S) return false;
        const int tile = L / S, s = L % S; u.pm = pm0 + (tile >> 2); u.pn = tile & 3; u.ks = s; u.aofs = (long)s * Ks * 2;
        int e = 0;
#pragma unroll
        for (int j = 0; j < 7; ++j) e += (u.pm >= seg[j]) ? 1 : 0;
        u.bofs = (long)e * estride + (long)s * Ks * 2; return true;
    }
    __device__ __forceinline__ void a_ready(const Unit&) const {}
    __device__ __forceinline__ void done(const Unit&) const {}
};
struct GroupedOrder {
    StaticOrder so; int seg[8]; long estride;
    __device__ __forceinline__ bool next(int i, Unit& u) const {
        if (!so.next(i, u)) return false;
        int e = 0;
#pragma unroll
        for (int j = 0; j < 7; ++j) e += (u.pm >= seg[j]) ? 1 : 0;
        u.bofs = (long)e * estride; return true;
    }
    __device__ __forceinline__ void a_ready(const Unit&) const {}
    __device__ __forceinline__ void done(const Unit&) const {}
};

__device__ __forceinline__ unsigned cvt_pk_bf16(float lo, float hi) { unsigned r; asm volatile("v_cvt_pk_bf16_f32 %0, %1, %2" : "=v"(r) : "v"(lo), "v"(hi)); return r; }
typedef unsigned u32x2 __attribute__((ext_vector_type(2)));
__device__ __forceinline__ float bf_lo(unsigned w) { return __uint_as_float(w << 16); }
__device__ __forceinline__ float bf_hi(unsigned w) { return __uint_as_float(w & 0xffff0000u); }
__device__ __forceinline__ float sigmoidf_(float v) { return __builtin_amdgcn_rcpf(1.0f + __builtin_amdgcn_exp2f(-1.4426950408889634f * v)); }

struct EpiBf16 {
    static constexpr bool PERM = true, AFTER_DRAIN = false, MIDK = false;
    bf16_t* O; int ldc;
    __device__ __forceinline__ void operator()(const f32x4 (&acc)[2][2][4][2], const Unit& u, int wr, int wc, int fr, int fq) const {
        const int row0 = u.pm * BM + wr * 64 + fr; const int col0 = u.pn * BM + wc * 32 + 8 * fq;
#pragma unroll
        for (int ai = 0; ai < 2; ++ai)
#pragma unroll
            for (int m = 0; m < 4; ++m) { bf16_t* rowp = O + (size_t)(row0 + ai * HALF + m * 16) * ldc + col0;
#pragma unroll
                for (int bj = 0; bj < 2; ++bj) { const f32x4 v0 = acc[ai][bj][m][0], v1 = acc[ai][bj][m][1];
                    u32x4 w; w.x = cvt_pk_bf16(v0[0], v0[1]); w.y = cvt_pk_bf16(v0[2], v0[3]); w.z = cvt_pk_bf16(v1[0], v1[1]); w.w = cvt_pk_bf16(v1[2], v1[3]);
                    *(u32x4*)(rowp + bj * HALF) = w; } }
    }
};
struct EpiSwiGLU {
    static constexpr bool PERM = true, AFTER_DRAIN = false, MIDK = false;
    bf16_t* H; int ldc;
    __device__ __forceinline__ void operator()(const f32x4 (&acc)[2][2][4][2], const Unit& u, int wr, int wc, int fr, int fq) const {
        const int row0 = u.pm * BM + wr * 64 + fr; const int col0 = u.pn * (BM / 2) + wc * 32 + 8 * fq;
#pragma unroll
        for (int ai = 0; ai < 2; ++ai)
#pragma unroll
            for (int m = 0; m < 4; ++m) { bf16_t* rowp = H + (size_t)(row0 + ai * HALF + m * 16) * ldc + col0; float o[8];
#pragma unroll
                for (int n = 0; n < 2; ++n)
#pragma unroll
                    for (int j = 0; j < 4; ++j) { const float a = acc[ai][0][m][n][j], b = acc[ai][1][m][n][j]; o[4 * n + j] = a * sigmoidf_(a) * b; }
                u32x4 w; w.x = cvt_pk_bf16(o[0], o[1]); w.y = cvt_pk_bf16(o[2], o[3]); w.z = cvt_pk_bf16(o[4], o[5]); w.w = cvt_pk_bf16(o[6], o[7]);
                *(u32x4*)rowp = w;
                asm volatile("" ::: "memory"); }
    }
};
__device__ __forceinline__ unsigned pk_fp8x4(float a, float b, float c, float d) { unsigned w = 0u; w = __builtin_amdgcn_cvt_pk_fp8_f32(a, b, w, false); w = __builtin_amdgcn_cvt_pk_fp8_f32(c, d, w, true); return w; }
__device__ __forceinline__ float clamp448(float v) { return __builtin_fminf(__builtin_fmaxf(v, -448.f), 448.f); }
struct EpiSwiGLU8 {
    static constexpr bool PERM = true, AFTER_DRAIN = false, MIDK = false; static constexpr int NST = 8;
    unsigned char* H; int ldc; float hsc;
    __device__ __forceinline__ void operator()(const f32x4 (&acc)[2][2][4][2], const Unit& u, int wr, int wc, int fr, int fq) const {
        const int row0 = u.pm * BM + wr * 64 + fr; const int col0 = u.pn * (BM / 2) + wc * 32 + 8 * fq;
#pragma unroll
        for (int ai = 0; ai < 2; ++ai)
#pragma unroll
            for (int m = 0; m < 4; ++m) { unsigned char* rowp = H + (size_t)(row0 + ai * HALF + m * 16) * ldc + col0; float o[8];
#pragma unroll
                for (int n = 0; n < 2; ++n)
#pragma unroll
                    for (int j = 0; j < 4; ++j) { const float a = acc[ai][0][m][n][j], b = acc[ai][1][m][n][j]; o[4 * n + j] = clamp448(hsc * (a * sigmoidf_(a) * b)); }
                u32x2 w; w.x = pk_fp8x4(o[0], o[1], o[2], o[3]); w.y = pk_fp8x4(o[4], o[5], o[6], o[7]);
                *(u32x2*)rowp = w;
                asm volatile("" ::: "memory"); }
    }
};
struct EpiInProj {
    static constexpr bool PERM = true, AFTER_DRAIN = false, MIDK = false;
    bf16_t* O; int ldc; bf16_t* GF; int GT0;
    __device__ __forceinline__ void operator()(const f32x4 (&acc)[2][2][4][2], const Unit& u, int wr, int wc, int fr, int fq) const {
        if (u.pn < GT0) {
            const int row0 = u.pm * BM + wr * 64 + fr; const int col0 = u.pn * BM + wc * 32 + 8 * fq;
#pragma unroll
            for (int ai = 0; ai < 2; ++ai)
#pragma unroll
                for (int m = 0; m < 4; ++m) { bf16_t* rowp = O + (size_t)(row0 + ai * HALF + m * 16) * ldc + col0;
#pragma unroll
                    for (int bj = 0; bj < 2; ++bj) { const f32x4 v0 = acc[ai][bj][m][0], v1 = acc[ai][bj][m][1];
                        u32x4 w; w.x = cvt_pk_bf16(v0[0], v0[1]); w.y = cvt_pk_bf16(v0[2], v0[3]); w.z = cvt_pk_bf16(v1[0], v1[1]); w.w = cvt_pk_bf16(v1[2], v1[3]);
                        *(u32x4*)(rowp + bj * HALF) = w; } }
        } else {
            bf16_t* gb = GF + ((size_t)(u.pm * 12 + (u.pn - GT0)) * 128 + (size_t)(wr * 4 + wc) * 16) * 512 + (fq * 16 + fr) * 8;
#pragma unroll
            for (int ai = 0; ai < 2; ++ai)
#pragma unroll
                for (int m = 0; m < 4; ++m)
#pragma unroll
                    for (int bj = 0; bj < 2; ++bj) { const f32x4 v0 = acc[ai][bj][m][0], v1 = acc[ai][bj][m][1];
                        u32x4 w; w.x = cvt_pk_bf16(v0[0], v0[1]); w.y = cvt_pk_bf16(v0[2], v0[3]); w.z = cvt_pk_bf16(v1[0], v1[1]); w.w = cvt_pk_bf16(v1[2], v1[3]);
                        *(u32x4*)(gb + ((ai * 4 + m) * 2 + bj) * 512) = w; }
        }
    }
};
__device__ __forceinline__ float i2f(float bits) { return (float)__builtin_bit_cast(int, bits); }
typedef int v4i_e __attribute__((ext_vector_type(4)));
__device__ __forceinline__ f32x4 i2f4(f32x4 bits) { return __builtin_convertvector(__builtin_bit_cast(v4i_e, bits), f32x4); }
__device__ __forceinline__ f32x4 swiglu4(f32x4 ap, f32x4 bp) { f32x4 r;
#pragma unroll
    for (int j = 0; j < 4; ++j) r[j] = (ap[j] * bp[j]) * __builtin_amdgcn_rcpf(1.0f + __builtin_amdgcn_exp2f(ap[j]));
    return r; }
#define PG8_QSCALES(rs_, cs_, row0_, colb_) float rsv[2][4]; f32x4 csv[2][2]; \
    _Pragma("unroll") for (int ai = 0; ai < 2; ++ai) _Pragma("unroll") for (int m = 0; m < 4; ++m) rsv[ai][m] = (rs_)[(row0_) + ai * HALF + m * 16]; \
    _Pragma("unroll") for (int bj = 0; bj < 2; ++bj) { csv[bj][0] = *(const f32x4*)((cs_) + (colb_) + bj * HALF); csv[bj][1] = *(const f32x4*)((cs_) + (colb_) + bj * HALF + 4); }
struct EpiSwiGLUQ {
    static constexpr bool PERM = true, AFTER_DRAIN = false, MIDK = false;
    bf16_t* H; int ldc; const float* rs; const float* cs;
    __device__ __forceinline__ void operator()(const f32x4 (&acc)[2][2][4][2], const Unit& u, int wr, int wc, int fr, int fq) const {
        const int row0 = u.pm * BM + wr * 64 + fr; const int col0 = u.pn * (BM / 2) + wc * 32 + 8 * fq; const int colb = u.pn * BM + wc * 32 + 8 * fq;
        PG8_QSCALES(rs, cs, row0, colb)
        csv[0][0] = csv[0][0] * -1.4426950408889634f; csv[0][1] = csv[0][1] * -1.4426950408889634f; csv[1][0] = csv[1][0] * -0.6931471805599453f; csv[1][1] = csv[1][1] * -0.6931471805599453f;
#pragma unroll
        for (int ai = 0; ai < 2; ++ai)
#pragma unroll
            for (int m = 0; m < 4; ++m) { bf16_t* rowp = H + (size_t)(row0 + ai * HALF + m * 16) * ldc + col0; float o[8];
#pragma unroll
                for (int n = 0; n < 2; ++n) { const f32x4 r = swiglu4(i2f4(acc[ai][0][m][n]) * rsv[ai][m] * csv[0][n], i2f4(acc[ai][1][m][n]) * rsv[ai][m] * csv[1][n]);
                    o[4 * n] = r[0]; o[4 * n + 1] = r[1]; o[4 * n + 2] = r[2]; o[4 * n + 3] = r[3]; }
                u32x4 w; w.x = cvt_pk_bf16(o[0], o[1]); w.y = cvt_pk_bf16(o[2], o[3]); w.z = cvt_pk_bf16(o[4], o[5]); w.w = cvt_pk_bf16(o[6], o[7]);
                *(u32x4*)rowp = w;
                asm volatile("" ::: "memory"); }
    }
};
struct EpiSwiGLU8Q {
    static constexpr bool PERM = true, AFTER_DRAIN = false, MIDK = false;
    unsigned char* H; int ldc; float hsc; const float* rs; const float* cs;
    __device__ __forceinline__ void operator()(const f32x4 (&acc)[2][2][4][2], const Unit& u, int wr, int wc, int fr, int fq) const {
        const int row0 = u.pm * BM + wr * 64 + fr; const int col0 = u.pn * (BM / 2) + wc * 32 + 8 * fq; const int colb = (int)(u.bofs >> 10) + u.pn * BM + wc * 32 + 8 * fq;
        PG8_QSCALES(rs, cs, row0, colb)
        { const float k3 = -0.6931471805599453f * hsc; csv[0][0] = csv[0][0] * -1.4426950408889634f; csv[0][1] = csv[0][1] * -1.4426950408889634f; csv[1][0] = csv[1][0] * k3; csv[1][1] = csv[1][1] * k3; }
#pragma unroll
        for (int ai = 0; ai < 2; ++ai)
#pragma unroll
            for (int m = 0; m < 4; ++m) { unsigned char* rowp = H + (size_t)(row0 + ai * HALF + m * 16) * ldc + col0; float o[8];
#pragma unroll
                for (int n = 0; n < 2; ++n) { const f32x4 r = swiglu4(i2f4(acc[ai][0][m][n]) * rsv[ai][m] * csv[0][n], i2f4(acc[ai][1][m][n]) * rsv[ai][m] * csv[1][n]);
#pragma unroll
                    for (int j = 0; j < 4; ++j) o[4 * n + j] = __builtin_amdgcn_fmed3f(r[j], -448.f, 448.f); }
                u32x2 w; w.x = pk_fp8x4(o[0], o[1], o[2], o[3]); w.y = pk_fp8x4(o[4], o[5], o[6], o[7]);
                *(u32x2*)rowp = w;
                asm volatile("" ::: "memory"); }
    }
};
struct EpiInProjQ {
    static constexpr bool PERM = true, AFTER_DRAIN = false, MIDK = false;
    bf16_t* O; int ldc; bf16_t* GF; int GT0; const float* rs; const float* cs;
    __device__ __forceinline__ void operator()(const f32x4 (&acc)[2][2][4][2], const Unit& u, int wr, int wc, int fr, int fq) const {
        const int row0 = u.pm * BM + wr * 64 + fr; const int col0 = u.pn * BM + wc * 32 + 8 * fq;
        PG8_QSCALES(rs, cs, row0, col0)
        if (u.pn < GT0) {
#pragma unroll
            for (int ai = 0; ai < 2; ++ai)
#pragma unroll
                for (int m = 0; m < 4; ++m) { bf16_t* rowp = O + (size_t)(row0 + ai * HALF + m * 16) * ldc + col0;
#pragma unroll
                    for (int bj = 0; bj < 2; ++bj) { const f32x4 a0 = acc[ai][bj][m][0], a1 = acc[ai][bj][m][1]; f32x4 v0, v1;
#pragma unroll
                        for (int j = 0; j < 1; ++j) { v0 = i2f4(a0) * rsv[ai][m] * csv[bj][0]; v1 = i2f4(a1) * rsv[ai][m] * csv[bj][1]; }
                        u32x4 w; w.x = cvt_pk_bf16(v0[0], v0[1]); w.y = cvt_pk_bf16(v0[2], v0[3]); w.z = cvt_pk_bf16(v1[0], v1[1]); w.w = cvt_pk_bf16(v1[2], v1[3]);
                        *(u32x4*)(rowp + bj * HALF) = w; } }
        } else {
            f32x4 gsv[2][2];
#pragma unroll
            for (int bj = 0; bj < 2; ++bj) { gsv[bj][0] = csv[bj][0] * -1.4426950408889634f; gsv[bj][1] = csv[bj][1] * -1.4426950408889634f; }
            bf16_t* gb = GF + ((size_t)(u.pm * 12 + (u.pn - GT0)) * 128 + (size_t)(wr * 4 + wc) * 16) * 512 + (fq * 16 + fr) * 8;
#pragma unroll
            for (int ai = 0; ai < 2; ++ai)
#pragma unroll
                for (int m = 0; m < 4; ++m)
#pragma unroll
                    for (int bj = 0; bj < 2; ++bj) { const f32x4 a0 = acc[ai][bj][m][0], a1 = acc[ai][bj][m][1]; f32x4 v0, v1;
                        v0 = i2f4(a0) * rsv[ai][m] * gsv[bj][0]; v1 = i2f4(a1) * rsv[ai][m] * gsv[bj][1];
#pragma unroll
                        for (int j = 0; j < 4; ++j) { v0[j] = 1.0f + __builtin_amdgcn_exp2f(__builtin_amdgcn_fmed3f(v0[j], -72.134752f, 72.134752f)); v1[j] = 1.0f + __builtin_amdgcn_exp2f(__builtin_amdgcn_fmed3f(v1[j], -72.134752f, 72.134752f)); }
                        u32x4 w; w.x = cvt_pk_bf16(v0[0], v0[1]); w.y = cvt_pk_bf16(v0[2], v0[3]); w.z = cvt_pk_bf16(v1[0], v1[1]); w.w = cvt_pk_bf16(v1[2], v1[3]);
                        *(u32x4*)(gb + ((ai * 4 + m) * 2 + bj) * 512) = w; }
        }
    }
};
template <bool F32B> struct EpiResid {
    static constexpr bool PERM = true, AFTER_DRAIN = false, MIDK = false;
    const float* basef; bf16_t* xr; const float* gate;
    __device__ __forceinline__ void operator()(const f32x4 (&acc)[2][2][4][2], const Unit& u, int wr, int wc, int fr, int fq) const {
        const int col0 = u.pn * BM + wc * 32 + 8 * fq; const float* gp = gate + (u.pm >> 5) * 6144 + col0;
        f32x4 gv[2][2];
#pragma unroll
        for (int bj = 0; bj < 2; ++bj)
#pragma unroll
            for (int n = 0; n < 2; ++n) gv[bj][n] = *(const f32x4*)(gp + bj * HALF + 4 * n);
#pragma unroll
        for (int ai = 0; ai < 2; ++ai) {
#pragma unroll
            for (int m = 0; m < 4; ++m) { const size_t off = (size_t)(u.pm * BM + wr * 64 + fr + ai * HALF + m * 16) * 1024 + col0;
#pragma unroll
                for (int bj = 0; bj < 2; ++bj) { f32x4 b0, b1;
                    if (F32B) { b0 = *(const f32x4*)(basef + off + bj * HALF); b1 = *(const f32x4*)(basef + off + bj * HALF + 4); }
                    else { const u32x4 w = *(const u32x4*)(xr + off + bj * HALF); b0[0] = bf_lo(w.x); b0[1] = bf_hi(w.x); b0[2] = bf_lo(w.y); b0[3] = bf_hi(w.y); b1[0] = bf_lo(w.z); b1[1] = bf_hi(w.z); b1[2] = bf_lo(w.w); b1[3] = bf_hi(w.w); }
                    const f32x4 v0 = b0 + gv[bj][0] * acc[ai][bj][m][0], v1 = b1 + gv[bj][1] * acc[ai][bj][m][1];
                    u32x4 o; o.x = cvt_pk_bf16(v0[0], v0[1]); o.y = cvt_pk_bf16(v0[2], v0[3]); o.z = cvt_pk_bf16(v1[0], v1[1]); o.w = cvt_pk_bf16(v1[2], v1[3]);
                    *(u32x4*)(xr + off + bj * HALF) = o; } }
            asm volatile("" ::: "memory"); }
    }
};
struct EpiSlab {
    static constexpr bool PERM = true, AFTER_DRAIN = false, MIDK = false;
    bf16_t* SL; int pm0; long sstride;
    __device__ __forceinline__ void operator()(const f32x4 (&acc)[2][2][4][2], const Unit& u, int wr, int wc, int fr, int fq) const {
        bf16_t* O = SL + (size_t)u.ks * sstride + (size_t)(u.pm - pm0) * BM * 1024;
        const int row0 = wr * 64 + fr; const int col0 = u.pn * BM + wc * 32 + 8 * fq;
#pragma unroll
        for (int ai = 0; ai < 2; ++ai)
#pragma unroll
            for (int m = 0; m < 4; ++m) { bf16_t* rowp = O + (size_t)(row0 + ai * HALF + m * 16) * 1024 + col0;
#pragma unroll
                for (int bj = 0; bj < 2; ++bj) { const f32x4 v0 = acc[ai][bj][m][0], v1 = acc[ai][bj][m][1];
                    u32x4 w; w.x = cvt_pk_bf16(v0[0], v0[1]); w.y = cvt_pk_bf16(v0[2], v0[3]); w.z = cvt_pk_bf16(v1[0], v1[1]); w.w = cvt_pk_bf16(v1[2], v1[3]);
                    *(u32x4*)(rowp + bj * HALF) = w; } }
    }
};
struct EpiPartial {
    static constexpr bool PERM = false, AFTER_DRAIN = false, MIDK = false;
    float* P; const float* gate;
    __device__ __forceinline__ void operator()(const f32x4 (&acc)[2][2][4][2], const Unit& u, int wr, int wc, int fr, int fq) const {
        const int col0 = u.pn * BM + wc * 32 + 4 * fq; float* os = P + ((size_t)u.ks * 512 + (size_t)(u.pm - 64) * BM) * 1024;
        f32x4 gv[2][2];
#pragma unroll
        for (int bj = 0; bj < 2; ++bj)
#pragma unroll
            for (int n = 0; n < 2; ++n) gv[bj][n] = *(const f32x4*)(gate + col0 + bj * HALF + n * 16);
#pragma unroll
        for (int ai = 0; ai < 2; ++ai)
#pragma unroll
            for (int m = 0; m < 4; ++m) { const size_t off = (size_t)(wr * 64 + fr + ai * HALF + m * 16) * 1024 + col0;
#pragma unroll
                for (int bj = 0; bj < 2; ++bj)
#pragma unroll
                    for (int n = 0; n < 2; ++n) *(f32x4*)(os + off + bj * HALF + n * 16) = gv[bj][n] * acc[ai][bj][m][n]; }
    }
};
struct EpiMergeR {
    static constexpr bool PERM = true, AFTER_DRAIN = false, MIDK = true;
    const bf16_t* GF; bf16_t* mb;
    static __device__ __forceinline__ float en(float g) { g = __builtin_fminf(__builtin_fmaxf(g, -50.f), 50.f); return __builtin_amdgcn_exp2f(-1.4426950408889634f * g); }
    static __device__ __forceinline__ float ratio(float s0, float s1) { return s1 * __builtin_amdgcn_rcpf(s0); }
    __device__ __forceinline__ void mid(f32x4 (&acc)[2][2][4][2], const Unit& u, int t, int wr, int wc, int fr, int fq) const {
        const bf16_t* g0p = GF + ((size_t)(u.pm * 12 + (t == 8 ? 0 : 4) + u.pn) * 128 + (size_t)(wr * 4 + wc) * 16) * 512 + (fq * 16 + fr) * 8;
        const bf16_t* g1p = g0p + (size_t)4 * 128 * 512;
#pragma unroll
        for (int ai = 0; ai < 2; ++ai) {
            u32x4 g0[4][2], g1[4][2];
#pragma unroll
            for (int m = 0; m < 4; ++m)
#pragma unroll
                for (int bj = 0; bj < 2; ++bj) { g0[m][bj] = *(const u32x4*)(g0p + ((ai * 4 + m) * 2 + bj) * 512); g1[m][bj] = *(const u32x4*)(g1p + ((ai * 4 + m) * 2 + bj) * 512); }
#pragma unroll
            for (int m = 0; m < 4; ++m)
#pragma unroll
                for (int bj = 0; bj < 2; ++bj) { const u32x4 a = g0[m][bj], b = g1[m][bj]; f32x4 r0, r1;
                    r0[0] = ratio(bf_lo(a.x), bf_lo(b.x)); r0[1] = ratio(bf_hi(a.x), bf_hi(b.x)); r0[2] = ratio(bf_lo(a.y), bf_lo(b.y)); r0[3] = ratio(bf_hi(a.y), bf_hi(b.y));
                    r1[0] = ratio(bf_lo(a.z), bf_lo(b.z)); r1[1] = ratio(bf_hi(a.z), bf_hi(b.z)); r1[2] = ratio(bf_lo(a.w), bf_lo(b.w)); r1[3] = ratio(bf_hi(a.w), bf_hi(b.w));
                    acc[ai][bj][m][0] = acc[ai][bj][m][0] * r0; acc[ai][bj][m][1] = acc[ai][bj][m][1] * r1; }
            asm volatile("" ::: "memory"); }
    }
    __device__ __forceinline__ void operator()(const f32x4 (&acc)[2][2][4][2], const Unit& u, int wr, int wc, int fr, int fq) const {
        const bf16_t* gp = GF + ((size_t)(u.pm * 12 + 8 + u.pn) * 128 + (size_t)(wr * 4 + wc) * 16) * 512 + (fq * 16 + fr) * 8;
        const int row0 = u.pm * BM + wr * 64 + fr; const int col0 = u.pn * BM + wc * 32 + 8 * fq;
#pragma unroll
        for (int ai = 0; ai < 2; ++ai) {
            u32x4 gw[4][2];
#pragma unroll
            for (int m = 0; m < 4; ++m)
#pragma unroll
                for (int bj = 0; bj < 2; ++bj) gw[m][bj] = *(const u32x4*)(gp + ((ai * 4 + m) * 2 + bj) * 512);
#pragma unroll
            for (int m = 0; m < 4; ++m) { bf16_t* rowp = mb + (size_t)(row0 + ai * HALF + m * 16) * 1024 + col0;
#pragma unroll
                for (int bj = 0; bj < 2; ++bj) { const u32x4 g = gw[m][bj]; const f32x4 v0 = acc[ai][bj][m][0], v1 = acc[ai][bj][m][1]; float o[8];
                    o[0] = v0[0] * __builtin_amdgcn_rcpf(bf_lo(g.x)); o[1] = v0[1] * __builtin_amdgcn_rcpf(bf_hi(g.x)); o[2] = v0[2] * __builtin_amdgcn_rcpf(bf_lo(g.y)); o[3] = v0[3] * __builtin_amdgcn_rcpf(bf_hi(g.y));
                    o[4] = v1[0] * __builtin_amdgcn_rcpf(bf_lo(g.z)); o[5] = v1[1] * __builtin_amdgcn_rcpf(bf_hi(g.z)); o[6] = v1[2] * __builtin_amdgcn_rcpf(bf_lo(g.w)); o[7] = v1[3] * __builtin_amdgcn_rcpf(bf_hi(g.w));
                    u32x4 w; w.x = cvt_pk_bf16(o[0], o[1]); w.y = cvt_pk_bf16(o[2], o[3]); w.z = cvt_pk_bf16(o[4], o[5]); w.w = cvt_pk_bf16(o[6], o[7]);
                    *(u32x4*)(rowp + bj * HALF) = w; } }
            asm volatile("" ::: "memory"); }
    }
};

typedef int v8i_t __attribute__((ext_vector_type(8)));
typedef int v4i_t __attribute__((ext_vector_type(4)));
__device__ __forceinline__ v8i_t cat8(bf16x8 lo, bf16x8 hi) { const v4i_t a = __builtin_bit_cast(v4i_t, lo), b = __builtin_bit_cast(v4i_t, hi); return __builtin_shufflevector(a, b, 0, 1, 2, 3, 4, 5, 6, 7); }
template <class Epi, class Sched, bool ALIGN_EPI = false, bool SP2 = false, bool FP8 = false, bool I8 = false>
__device__ __forceinline__ void gemm_phase(PG8_LAS unsigned char* lds, const Gemm g, const Sched& S, const Epi& E, const int wave_id) {
    int tid_; asm volatile("v_mbcnt_lo_u32_b32 %0, -1, 0\n\tv_mbcnt_hi_u32_b32 %0, -1, %0" : "=v"(tid_)); tid_ += wave_id * 64;
    const int tid = tid_, wid = __builtin_amdgcn_readfirstlane(tid >> 6), lane = tid & 63, wr = wid >> 2, wc = wid & 3, fr = lane & 15, fq = lane >> 4;
    const int K = g.K, nt = K / BK;
    unsigned voffA[2], voffB[2];
#pragma unroll
    for (int i = 0; i < 2; ++i) { int R, C; stage_rc(tid * 16 + i * 8192, R, C); const int Rb = Epi::PERM ? ((R & ~31) + perm32(R & 31)) : R;
        voffA[i] = (unsigned)(R * g.lda + C) * 2u; voffB[i] = (unsigned)(Rb * g.ldb + C) * 2u; }
    const size_t kstep = (size_t)(BK * 2);
    const size_t hstepA = (size_t)HALF * g.lda * 2, hstepB = (size_t)HALF * g.ldb * 2;
    const size_t tstepA = 2 * hstepA, tstepB = 2 * hstepB;
    const unsigned ldsw = (unsigned)wid * 1024u;
    const int aoff = lds_byte(wr * 64 + fr, fq * 8), boff = lds_byte(wc * 32 + fr, fq * 8);
#define PG8_SA(b, h) (((b) * 2 + (h)) * HTB)
#define PG8_SB(b, h) ((4 + (b) * 2 + (h)) * HTB)
#define PG8_STAGE(bufoff, gbase, voff) do { _Pragma("unroll") for (int _i = 0; _i < 2; ++_i) \
        __builtin_amdgcn_global_load_lds((const unsigned*)((const char*)(gbase) + (voff)[_i]), (PG8_LAS unsigned*)(lds + (bufoff) + ldsw + _i * 8192), 16, 0, 0); } while (0)
#define PG8_LDA(dst, b, h) do { if constexpr (FP8) { _Pragma("unroll") for (int m = 0; m < 4; ++m) { const v4i_t lo_ = *(const PG8_LAS v4i_t*)(lds + PG8_SA(b, h) + aoff + m * 2048), hi_ = *(const PG8_LAS v4i_t*)(lds + PG8_SA(b, h) + aoff + m * 2048 + 1024); dst##8[m] = __builtin_shufflevector(lo_, hi_, 0, 1, 2, 3, 4, 5, 6, 7); } } \
        else { _Pragma("unroll") for (int m = 0; m < 4; ++m) _Pragma("unroll") for (int k = 0; k < 2; ++k) dst[m][k] = *(const PG8_LAS bf16x8*)(lds + PG8_SA(b, h) + aoff + m * 2048 + k * 1024); } } while (0)
#define PG8_LDB(dst, b, h) do { if constexpr (FP8) { _Pragma("unroll") for (int n = 0; n < 2; ++n) { const v4i_t lo_ = *(const PG8_LAS v4i_t*)(lds + PG8_SB(b, h) + boff + n * 2048), hi_ = *(const PG8_LAS v4i_t*)(lds + PG8_SB(b, h) + boff + n * 2048 + 1024); dst##8[n] = __builtin_shufflevector(lo_, hi_, 0, 1, 2, 3, 4, 5, 6, 7); } } \
        else { _Pragma("unroll") for (int n = 0; n < 2; ++n) _Pragma("unroll") for (int k = 0; k < 2; ++k) dst[n][k] = *(const PG8_LAS bf16x8*)(lds + PG8_SB(b, h) + boff + n * 2048 + k * 1024); } } while (0)
#define PG8_MMA(ai, bj, At, Bt) do { if constexpr (FP8) __builtin_amdgcn_sched_barrier(0); __builtin_amdgcn_s_setprio(1); _Pragma("unroll") for (int m = 0; m < 4; ++m) _Pragma("unroll") for (int n = 0; n < 2; ++n) { \
        if constexpr (FP8) { asm volatile("s_nop 1\n\tv_mfma_scale_f32_16x16x128_f8f6f4 %0, %1, %2, %0, %3, %4 op_sel_hi:[0,0,0]" : "+v"(acc[ai][bj][m][n]) : "v"(Bt##8[n]), "v"(At##8[m]), "v"(sw_), "v"(sa_)); } \
        else if constexpr (I8) { _Pragma("unroll") for (int k = 0; k < 2; ++k) acc[ai][bj][m][n] = __builtin_bit_cast(f32x4, __builtin_amdgcn_mfma_i32_16x16x64_i8(__builtin_bit_cast(v4i_t, Bt[n][k]), __builtin_bit_cast(v4i_t, At[m][k]), __builtin_bit_cast(v4i_t, acc[ai][bj][m][n]), 0, 0, 0)); } \
        else { _Pragma("unroll") for (int k = 0; k < 2; ++k) acc[ai][bj][m][n] = __builtin_amdgcn_mfma_f32_16x16x32_bf16(Bt[n][k], At[m][k], acc[ai][bj][m][n], 0, 0, 0); } } \
        __builtin_amdgcn_s_setprio(0); if constexpr (FP8) __builtin_amdgcn_sched_barrier(0); } while (0)
#define PG8_WAIT_V(n) asm volatile("s_waitcnt vmcnt(" #n ")" ::: "memory")
#define PG8_WAIT_L(n) asm volatile("s_waitcnt lgkmcnt(" #n ")" ::: "memory")
#define PG8_BAR __builtin_amdgcn_s_barrier()
#define PG8_SCHED __builtin_amdgcn_sched_barrier(0)
    Unit cur, nxt; int ui = 0;
    if (!S.next(0, cur)) return;
    f32x4 acc[2][2][4][2];
#pragma unroll
    for (int a = 0; a < 2; ++a)
#pragma unroll
        for (int b = 0; b < 2; ++b)
#pragma unroll
            for (int m = 0; m < 4; ++m)
#pragma unroll
                for (int n = 0; n < 2; ++n) acc[a][b][m][n] = (f32x4){0.f, 0.f, 0.f, 0.f};
    int sw_ = g.sw, sa_ = g.sa; asm volatile("" : "+s"(sw_), "+s"(sa_)); (void)sw_; (void)sa_;
    bf16x8 At[4][2], B0[2][2], B1[2][2]; v8i_t At8[4], B08[2], B18[2];
    const char* cA = (const char*)g.A + cur.aofs + (size_t)cur.pm * tstepA; const char* cB = (const char*)g.Bt + cur.bofs + (size_t)cur.pn * tstepB;
    S.a_ready(cur);
    if constexpr (SP2) {
        PG8_STAGE(PG8_SB(0, 0), cB, voffB); PG8_STAGE(PG8_SB(0, 1), cB + hstepB, voffB); PG8_STAGE(PG8_SA(0, 0), cA, voffA); PG8_STAGE(PG8_SA(0, 1), cA + hstepA, voffA);
        if (wr == 1) PG8_BAR;
        PG8_WAIT_V(2); PG8_BAR;
        PG8_STAGE(PG8_SB(1, 0), cB + kstep, voffB); PG8_STAGE(PG8_SA(1, 0), cA + kstep, voffA); PG8_STAGE(PG8_SB(1, 1), cB + hstepB + kstep, voffB);
        PG8_WAIT_V(6); PG8_BAR;
    } else {
        PG8_STAGE(PG8_SB(0, 0), cB, voffB); PG8_STAGE(PG8_SA(0, 0), cA, voffA); PG8_STAGE(PG8_SB(0, 1), cB + hstepB, voffB); PG8_STAGE(PG8_SA(0, 1), cA + hstepA, voffA);
        if (wr == 1) PG8_BAR;
        PG8_WAIT_V(4); PG8_BAR;
        PG8_STAGE(PG8_SB(1, 0), cB + kstep, voffB); PG8_STAGE(PG8_SA(1, 0), cA + kstep, voffA); PG8_STAGE(PG8_SB(1, 1), cB + hstepB + kstep, voffB);
        PG8_WAIT_V(6); PG8_BAR;
    }
    for (;;) {
        const bool has_next = S.next(ui + 1, nxt);
        const char* nA = has_next ? (const char*)g.A + nxt.aofs + (size_t)nxt.pm * tstepA : cA; const char* nB = has_next ? (const char*)g.Bt + nxt.bofs + (size_t)nxt.pn * tstepB : cB;
        for (int t = 0; t < nt; t += 2) {
            if constexpr (Epi::MIDK) { if (t == 8 || t == 12) { int ln_; asm volatile("v_mbcnt_lo_u32_b32 %0, -1, 0\n\tv_mbcnt_hi_u32_b32 %0, -1, %0" : "=v"(ln_)); E.mid(acc, cur, t, wr, wc, ln_ & 15, ln_ >> 4); } }
            const bool last = (t == nt - 2);
            const char* a1 = cA + (size_t)(t + 1) * kstep;
            const char* a2 = last ? nA : cA + (size_t)(t + 2) * kstep; const char* b2 = last ? nB : cB + (size_t)(t + 2) * kstep;
            const char* a3 = a2 + kstep; const char* b3 = b2 + kstep;
            if (last && has_next) S.a_ready(nxt);
            if constexpr (SP2) {
            PG8_LDB(B0, 0, 0); PG8_LDB(B1, 0, 1); PG8_SCHED; PG8_LDA(At, 0, 0); PG8_STAGE(PG8_SA(1, 1), a1 + hstepA, voffA);
            PG8_WAIT_V(8); PG8_WAIT_L(0); PG8_BAR; PG8_MMA(0, 0, At, B0); PG8_MMA(0, 1, At, B1); PG8_BAR; PG8_SCHED;
            PG8_LDA(At, 0, 1); PG8_STAGE(PG8_SB(0, 0), b2, voffB); PG8_STAGE(PG8_SB(0, 1), b2 + hstepB, voffB); PG8_STAGE(PG8_SA(0, 0), a2, voffA);
            PG8_WAIT_V(8); PG8_WAIT_L(0); PG8_BAR; PG8_MMA(1, 0, At, B0); PG8_MMA(1, 1, At, B1); PG8_BAR; PG8_SCHED;
            PG8_LDB(B0, 1, 0); PG8_LDB(B1, 1, 1); PG8_SCHED; PG8_LDA(At, 1, 0); PG8_STAGE(PG8_SA(0, 1), a2 + hstepA, voffA);
            PG8_WAIT_V(8); PG8_WAIT_L(0); PG8_BAR; PG8_MMA(0, 0, At, B0); PG8_MMA(0, 1, At, B1); PG8_BAR; PG8_SCHED;
            PG8_LDA(At, 1, 1); PG8_STAGE(PG8_SB(1, 0), b3, voffB); PG8_STAGE(PG8_SB(1, 1), b3 + hstepB, voffB); PG8_STAGE(PG8_SA(1, 0), a3, voffA);
            PG8_WAIT_V(8); PG8_WAIT_L(0); PG8_BAR; PG8_MMA(1, 0, At, B0); PG8_MMA(1, 1, At, B1); PG8_BAR; PG8_SCHED;
            } else {
            PG8_LDB(B0, 0, 0); PG8_SCHED; PG8_LDA(At, 0, 0); PG8_STAGE(PG8_SA(1, 1), a1 + hstepA, voffA);
            PG8_WAIT_L(8); PG8_BAR; PG8_WAIT_L(0); PG8_MMA(0, 0, At, B0); PG8_BAR; PG8_SCHED;
            PG8_LDB(B1, 0, 1); PG8_STAGE(PG8_SB(0, 0), b2, voffB);
            PG8_BAR; PG8_WAIT_L(0); PG8_MMA(0, 1, At, B1); PG8_BAR;
            PG8_LDA(At, 0, 1); PG8_STAGE(PG8_SA(0, 0), a2, voffA);
            PG8_BAR; PG8_WAIT_L(0); PG8_MMA(1, 0, At, B0); PG8_BAR; PG8_SCHED;
            PG8_STAGE(PG8_SB(0, 1), b2 + hstepB, voffB);
            PG8_WAIT_V(6); PG8_BAR; PG8_MMA(1, 1, At, B1); PG8_BAR;
            PG8_LDB(B0, 1, 0); PG8_SCHED; PG8_LDA(At, 1, 0); PG8_STAGE(PG8_SA(0, 1), a2 + hstepA, voffA);
            PG8_WAIT_L(8); PG8_BAR; PG8_WAIT_L(0); PG8_MMA(0, 0, At, B0); PG8_BAR; PG8_SCHED;
            PG8_LDB(B1, 1, 1); PG8_STAGE(PG8_SB(1, 0), b3, voffB);
            PG8_BAR; PG8_WAIT_L(0); PG8_MMA(0, 1, At, B1); PG8_BAR;
            PG8_LDA(At, 1, 1); PG8_STAGE(PG8_SA(1, 0), a3, voffA);
            PG8_BAR; PG8_WAIT_L(0); PG8_MMA(1, 0, At, B0); PG8_BAR; PG8_SCHED;
            PG8_STAGE(PG8_SB(1, 1), b3 + hstepB, voffB);
            PG8_WAIT_V(6); PG8_BAR; PG8_MMA(1, 1, At, B1); PG8_BAR;
            }
        }
        if constexpr (ALIGN_EPI) { if (wr == 0) PG8_BAR; }
        if constexpr (FP8) { asm volatile("s_nop 15\n\ts_nop 15" ::: "memory"); }
        if constexpr (!Epi::AFTER_DRAIN) { int ln_; asm volatile("v_mbcnt_lo_u32_b32 %0, -1, 0\n\tv_mbcnt_hi_u32_b32 %0, -1, %0" : "=v"(ln_)); const int fr_ = ln_ & 15, fq_ = ln_ >> 4;
            E(acc, cur, wr, wc, fr_, fq_); S.done(cur); }
        if (!has_next) break;
#pragma unroll
        for (int a = 0; a < 2; ++a)
#pragma unroll
            for (int b = 0; b < 2; ++b)
#pragma unroll
                for (int m = 0; m < 4; ++m)
#pragma unroll
                    for (int n = 0; n < 2; ++n) acc[a][b][m][n] = (f32x4){0.f, 0.f, 0.f, 0.f};
        cur = nxt; cA = nA; cB = nB; ++ui;
        if constexpr (ALIGN_EPI) { if (wr == 1) PG8_BAR; }
    }
    PG8_WAIT_V(0);
    if constexpr (!ALIGN_EPI) { if (wr == 0) PG8_BAR; }
    PG8_BAR;
    if constexpr (Epi::AFTER_DRAIN) { E.fused(acc, cur, wr, wc, fr, fq, lds, wid, lane); S.done(cur); }
#undef PG8_SA
#undef PG8_SB
#undef PG8_STAGE
#undef PG8_LDA
#undef PG8_LDB
#undef PG8_MMA
#undef PG8_WAIT_V
#undef PG8_WAIT_L
#undef PG8_BAR
#undef PG8_SCHED
}
}
#ifndef ATTN_NEWPIPE
#define ATTN_NEWPIPE 1
#endif
#ifndef ATTN_QK8
#define ATTN_QK8 1
#endif
namespace attn_body {
using bf16=__hip_bfloat16;
using bf16x8=__attribute__((ext_vector_type(8)))short;
using s16x4=__attribute__((ext_vector_type(4)))short;
using f32x16=__attribute__((ext_vector_type(16)))float;
using u32x4=__attribute__((ext_vector_type(4)))unsigned;
constexpr int D=64;
constexpr int NW=8,QBLK=32,QB=QBLK*NW,KVBLK=64;
constexpr int ATTN_UNIT_ROWS=QB;
__device__ __forceinline__ int crow(int r,int hi){return (r&3)+8*(r>>2)+4*hi;}
#define SBAR() __builtin_amdgcn_sched_barrier(0)
constexpr int NSLOT=3, SLOTB=8192;
constexpr int LDS_K=0, LDS_V=NSLOT*SLOTB, LDS_WS=2*NSLOT*SLOTB, LDS_OST=LDS_WS+NW*64*4, LDS_BYTES=LDS_OST+NW*4096;
constexpr float C2=0.125f*1.4426950408889634f;
__device__ __forceinline__ void glds16(const void*gsrc,unsigned lds_dst){unsigned keep;
  asm volatile("s_mov_b32 %0, m0\n\ts_mov_b32 m0, %2\n\ts_nop 0\n\tglobal_load_lds_dwordx4 %1, off\n\ts_mov_b32 m0, %0":"=&s"(keep):"v"(gsrc),"s"(lds_dst):"memory");}
__device__ __forceinline__ void glds16h(const void*gsrc,unsigned lds_dst){unsigned keep; unsigned long long ex;
  asm volatile("s_mov_b64 %1, exec\n\ts_mov_b64 exec, 0xffffffff\n\ts_mov_b32 %0, m0\n\ts_mov_b32 m0, %3\n\ts_nop 0\n\tglobal_load_lds_dwordx4 %2, off\n\ts_mov_b32 m0, %0\n\ts_mov_b64 exec, %1":"=&s"(keep),"=&s"(ex):"v"(gsrc),"s"(lds_dst):"memory");}
__device__ __forceinline__ float max3f(float a,float b,float c){float r;asm("v_max3_f32 %0, %1, %2, %3":"=v"(r):"v"(a),"v"(b),"v"(c));return r;}
__device__ __forceinline__ float max2f(float a,float b){float r;asm("v_max_f32_e32 %0, %1, %2":"=v"(r):"v"(a),"v"(b));return r;}
__device__ __forceinline__ float fadd_s(float a,float b){float r;asm("v_add_f32_e32 %0, %1, %2":"=v"(r):"v"(a),"v"(b));return r;}
__device__ __forceinline__ float fsub_s(float a,float b){float r;asm("v_sub_f32_e32 %0, %1, %2":"=v"(r):"v"(a),"v"(b));return r;}
typedef float f32x2_t __attribute__((ext_vector_type(2))); typedef __bf16 bf16x2_t __attribute__((ext_vector_type(2)));
__device__ __forceinline__ unsigned cvtpk_s(float lo,float hi){f32x2_t v={lo,hi};bf16x2_t b=__builtin_convertvector(v,bf16x2_t);return __builtin_bit_cast(unsigned,b);}
#define WAIT_BAR(N) asm volatile("s_waitcnt vmcnt(" #N ") lgkmcnt(0)\n\ts_barrier":::"memory")

__device__ __forceinline__ void qkt(f32x16&p0,f32x16&p1,const char*Kslot,const bf16x8*qr,const f32x16&negm,int r32,int hi){
  const char*kb=Kslot+hi*1024+r32*16;
  #pragma unroll
  for(int d0=0;d0<4;++d0){
    const bf16x8 b0=*reinterpret_cast<const bf16x8*>(kb+d0*2048);
    const bf16x8 b1=*reinterpret_cast<const bf16x8*>(kb+d0*2048+512);
    if(d0==0){p0=__builtin_amdgcn_mfma_f32_32x32x16_bf16(b0,qr[0],negm,0,0,0);p1=__builtin_amdgcn_mfma_f32_32x32x16_bf16(b1,qr[0],negm,0,0,0);}
    else{p0=__builtin_amdgcn_mfma_f32_32x32x16_bf16(b0,qr[d0],p0,0,0,0);p1=__builtin_amdgcn_mfma_f32_32x32x16_bf16(b1,qr[d0],p1,0,0,0);}}
}
typedef __attribute__((address_space(3))) const char* lds_cptr;
typedef short v4i16_t __attribute__((ext_vector_type(4)));
__device__ __forceinline__ void kload8(bf16x8*kf,lds_cptr kp){
  kf[0]=*(const __attribute__((address_space(3))) bf16x8*)(kp);      kf[1]=*(const __attribute__((address_space(3))) bf16x8*)(kp+512);
  kf[2]=*(const __attribute__((address_space(3))) bf16x8*)(kp+2048); kf[3]=*(const __attribute__((address_space(3))) bf16x8*)(kp+2560);
  kf[4]=*(const __attribute__((address_space(3))) bf16x8*)(kp+4096); kf[5]=*(const __attribute__((address_space(3))) bf16x8*)(kp+4608);
  kf[6]=*(const __attribute__((address_space(3))) bf16x8*)(kp+6144); kf[7]=*(const __attribute__((address_space(3))) bf16x8*)(kp+6656);
}
__device__ __forceinline__ void kload2(bf16x8*kf,lds_cptr kp,int j){ kf[2*j]=*(const __attribute__((address_space(3))) bf16x8*)(kp+j*2048); kf[2*j+1]=*(const __attribute__((address_space(3))) bf16x8*)(kp+j*2048+512); }
__device__ __forceinline__ s16x4 vtr(lds_cptr p){ return __builtin_bit_cast(s16x4,__builtin_amdgcn_ds_read_tr16_b64_v4i16((__attribute__((address_space(3))) v4i16_t*)p)); }
__device__ __forceinline__ float rowmax(const f32x16&p0,const f32x16&p1){
  float a=max3f(p0[0],p0[1],p1[0]),b=max3f(p0[2],p0[3],p1[1]);a=max3f(a,p1[2],p1[3]);
  #pragma unroll
  for(int r=4;r<16;r+=4){a=max3f(a,p0[r],p0[r+1]);b=max3f(b,p0[r+2],p0[r+3]);a=max3f(a,p1[r],p1[r+1]);b=max3f(b,p1[r+2],p1[r+3]);}
  const float m=max2f(a,b);
  auto rr=__builtin_amdgcn_permlane32_swap(__float_as_uint(m),__float_as_uint(m),false,false);
  return max2f(__uint_as_float(rr[0]),__uint_as_float(rr[1]));
}
__device__ __forceinline__ void pv(f32x16*o,int vb,bf16x8 pa0,bf16x8 pa1,bf16x8 pa2,bf16x8 pa3){
  #pragma unroll
  for(int d0=0;d0<2;++d0){s16x4 lo[4],hi[4];
    #pragma unroll
    for(int ks=0;ks<4;++ks){
      asm volatile("ds_read_b64_tr_b16 %0,%1 offset:%c2":"=&v"(lo[ks]):"v"(vb),"i"(d0*4096+ks*1024):"memory");
      asm volatile("ds_read_b64_tr_b16 %0,%1 offset:%c2":"=&v"(hi[ks]):"v"(vb),"i"(d0*4096+ks*1024+512):"memory");}
    asm volatile("s_waitcnt lgkmcnt(0)":::"memory");SBAR();
    #define PK(k) (bf16x8){lo[k][0],lo[k][1],lo[k][2],lo[k][3],hi[k][0],hi[k][1],hi[k][2],hi[k][3]}
    o[d0]=__builtin_amdgcn_mfma_f32_32x32x16_bf16(pa0,PK(0),o[d0],0,0,0);
    o[d0]=__builtin_amdgcn_mfma_f32_32x32x16_bf16(pa1,PK(1),o[d0],0,0,0);
    o[d0]=__builtin_amdgcn_mfma_f32_32x32x16_bf16(pa2,PK(2),o[d0],0,0,0);
    o[d0]=__builtin_amdgcn_mfma_f32_32x32x16_bf16(pa3,PK(3),o[d0],0,0,0);
    #undef PK
  }
}


#ifndef AJ_QP
#define AJ_QP 1792
#endif
struct AttnJob { const bf16* Q; const bf16* K; const bf16* V; bf16* O; int base0, base1; int r0, rlo; const float* bias;
  int qt0; const float* gq; const float* rope; float mref; const unsigned char* K8; const unsigned char* VT8; };
__device__ __forceinline__ float bfl_(unsigned w){return __uint_as_float(w<<16);} __device__ __forceinline__ float bfh_(unsigned w){return __uint_as_float(w&0xffff0000u);}
constexpr int LDS_BTAB=LDS_BYTES, BTAB_BYTES=15*128*4, LDS_BYTES_ALL=LDS_BTAB+BTAB_BYTES;
typedef __attribute__((address_space(3))) const float* lds_fptr;
__device__ __forceinline__ void bmask(f32x16&p0,f32x16&p1,int w,int rlo,int qr,int rs,int cs,int hi,lds_fptr tp0){
  const float NEG=-INFINITY; const int kr=rlo+w;
  if(kr<rs||kr>rs+7){
    #pragma unroll
    for(int r=0;r<16;++r){p0[r]=NEG;p1[r]=NEG;}
  } else {
    const lds_fptr tp=tp0+(kr-qr+7)*128;
    #pragma unroll
    for(int r=0;r<16;++r){ const int kc0=(r&3)+8*(r>>2); const int kc=kc0+4*hi; const float b0=tp[kc0],b1=tp[kc0+32];
      p0[r]=((unsigned)(kc-cs)<16u)?p0[r]+b0:NEG; p1[r]=((unsigned)(kc+32-cs)<16u)?p1[r]+b1:NEG; }
  }
}
#ifndef ATTN_STORE16
#define ATTN_STORE16(p,v) (*(u32x4*)(p)=(v))
#endif
typedef int v8i_a __attribute__((ext_vector_type(8))); typedef int v4i_a __attribute__((ext_vector_type(4)));
__device__ __forceinline__ unsigned pk8a(float a,float b,float c,float d){ a=__builtin_fminf(__builtin_fmaxf(a,-448.f),448.f); b=__builtin_fminf(__builtin_fmaxf(b,-448.f),448.f); c=__builtin_fminf(__builtin_fmaxf(c,-448.f),448.f); d=__builtin_fminf(__builtin_fmaxf(d,-448.f),448.f);
  unsigned w=0u; w=__builtin_amdgcn_cvt_pk_fp8_f32(a,b,w,false); w=__builtin_amdgcn_cvt_pk_fp8_f32(c,d,w,true); return w; }
__device__ __forceinline__ int pkb8(float a,float b,float c,float d){ int w; asm volatile("":"=v"(w)); w=__builtin_amdgcn_cvt_pk_bf8_f32(a,b,w,false); w=__builtin_amdgcn_cvt_pk_bf8_f32(c,d,w,true); return w; }
template<int THRL,int KIND,int PV=0> __device__ __forceinline__ void attn_unit(const AttnJob&J,char*shm,const int wave_id){
  constexpr int QP_=AJ_QP, KP_=(KIND==0||KIND==2)?128:AJ_QP, VP_=AJ_QP, OP_=1024, NT_=(KIND==0)?132:(KIND==1)?16:4, N0_=(KIND==0)?128:4, QMODE_=(KIND==0)?1:(KIND==2)?2:0; constexpr bool BM_=(KIND==1);
  int tid_; asm volatile("v_mbcnt_lo_u32_b32 %0, -1, 0\n\tv_mbcnt_hi_u32_b32 %0, -1, %0":"=v"(tid_)); tid_+=wave_id*64; const int tid=tid_,lane=tid&63,r32=lane&31,hi=lane>>5; const int wid=__builtin_amdgcn_readfirstlane(tid>>6);
  constexpr int qp=QP_,kp=KP_,vp=VP_,op=OP_,n0=N0_; const int base0=J.base0,base1=J.base1;
  const bf16*Qw=J.Q+(long)(wid*QBLK)*qp;
  const bf16*Kh=J.K,*Vh=J.V;
  const unsigned lds0=(unsigned)(uintptr_t)shm;
  float*wsf=(float*)(shm+LDS_WS)+wid*64;
  const bf16*ksrc=Kh+(long)lane*kp+wid*8;
  const bf16*vsrc=Vh+(long)(16*(wid&3)+(lane>>2))*vp+(wid>>2)*32+(lane&3)*8;
  const unsigned kdst=lds0+LDS_K+wid*1024, vdst=lds0+LDS_V+wid*1024;
  #define KROW(t) (((t)<n0)?(base0+KVBLK*(t)):(base1+KVBLK*((t)-n0)))
  constexpr bool F8_=(KIND==0)&&(PV==7||PV==8)&&(ATTN_QK8!=0); constexpr bool P8_=(KIND==0)&&(PV==8);
  const unsigned char*ksrc8=J.K8+(long)(8*wid+((lane&31)>>2))*128+(((lane&3)^((2*wid+((lane>>4)&1))&3))*16);
  const unsigned kdst8=lds0+LDS_K+wid*512;
  #define DMA_K(t,slot) do{ if constexpr(F8_){ glds16h(ksrc8+(long)KROW(t)*128,(unsigned)__builtin_amdgcn_readfirstlane(kdst8+(slot))); } else { glds16(ksrc+(long)KROW(t)*kp,(unsigned)__builtin_amdgcn_readfirstlane(kdst+(slot))); } }while(0)
  const unsigned char*vsrc8=J.VT8+(long)(8*wid+((lane&31)>>2))*64+(((lane&3)^((2*wid+((lane>>4)&1))&3))*16);
  const unsigned vdst8=lds0+LDS_V+wid*512;
  #define DMA_V(t,slot) do{ if constexpr(P8_){ glds16h(vsrc8+(long)(KROW(t)>>6)*8192,(unsigned)__builtin_amdgcn_readfirstlane(vdst8+(slot))); } else { glds16(vsrc+(long)KROW(t)*vp,(unsigned)__builtin_amdgcn_readfirstlane(vdst+(slot))); } }while(0)
  const int vb0=(int)(lds0+LDS_V)+((lane>>4)&1)*32+(lane&3)*8+(4*hi+((lane&15)>>2))*64;
  const char*Kbase=shm+LDS_K; bf16x8 kf[8];
  const lds_cptr shm3=(lds_cptr)shm; const lds_cptr kp0=shm3+LDS_K+hi*1024+r32*16; const lds_cptr vp0=shm3+LDS_V+((lane>>4)&1)*32+(lane&3)*8+(4*hi+((lane&15)>>2))*64;
  constexpr int NT=NT_;
  constexpr int NTs=BM_?0:NT;
  const int qr_=J.r0+(wid>>1), qc_=32*(wid&1)+r32; const int rs_=min(max(qr_-4,0),120), cs_=min(max(qc_-8,0),48), rlo_=J.rlo; constexpr bool bm_=BM_;
  const lds_fptr btp_=(lds_fptr)((lds_cptr)shm+LDS_BTAB)+(63-qc_+4*hi);
  if(bm_){ __attribute__((address_space(3))) float*bt=(__attribute__((address_space(3))) float*)((__attribute__((address_space(3))) char*)shm+LDS_BTAB);
    for(int i=tid;i<15*128;i+=NW*64){const int dr=i>>7,dc=(i&127)-63; bt[i]=(dc>=-15&&dc<=15)?J.bias[dr*31+dc+15]*1.4426950408889634f:0.f;} }
  DMA_K(0,0);DMA_V(0,0);DMA_K(1,SLOTB);
  bf16x8 qr[4]; v8i_a q8;
  if constexpr(F8_){
    bf16x8 qv[4];
    #pragma unroll
    for(int i=0;i<4;++i)qv[i]=*reinterpret_cast<const bf16x8*>(&Qw[(long)r32*qp+32*hi+8*i]);
    float y[32]; float ss=0.f;
    #pragma unroll
    for(int i=0;i<4;++i){ const u32x4 w=__builtin_bit_cast(u32x4,qv[i]);
      y[8*i]=bfl_(w.x);y[8*i+1]=bfh_(w.x);y[8*i+2]=bfl_(w.y);y[8*i+3]=bfh_(w.y);y[8*i+4]=bfl_(w.z);y[8*i+5]=bfh_(w.z);y[8*i+6]=bfl_(w.w);y[8*i+7]=bfh_(w.w); }
    #pragma unroll
    for(int i=0;i<32;++i)ss+=y[i]*y[i];
    { auto rr=__builtin_amdgcn_permlane32_swap(__float_as_uint(ss),__float_as_uint(ss),false,false); ss=__uint_as_float(rr[0])+__uint_as_float(rr[1]); }
    const float rstd=16.0f*C2/sqrtf(ss*(1.0f/64.0f)+1e-6f);
    typedef float f4_ __attribute__((ext_vector_type(4)));
    #pragma unroll
    for(int i=0;i<8;++i){ const f4_ g=*(const f4_*)(J.gq+32*hi+4*i); y[4*i]*=rstd*g[0];y[4*i+1]*=rstd*g[1];y[4*i+2]*=rstd*g[2];y[4*i+3]*=rstd*g[3]; }
    { const int t=J.qt0+wid*QBLK+r32; const int pos=hi?(t&63):(t>>6); const float*rp=J.rope+pos*32;
      #pragma unroll
      for(int i=0;i<8;++i){ const f4_ tb=*(const f4_*)(rp+4*i);
        { const float a=y[2*i],b=y[2*i+16]; y[2*i]=a*tb[0]-b*tb[1]; y[2*i+16]=b*tb[0]+a*tb[1]; }
        { const float a=y[2*i+1],b=y[2*i+17]; y[2*i+1]=a*tb[2]-b*tb[3]; y[2*i+17]=b*tb[2]+a*tb[3]; } } }
    #pragma unroll
    for(int m=0;m<8;++m)q8[m]=(int)pk8a(y[4*m],y[4*m+1],y[4*m+2],y[4*m+3]);
    asm volatile("":"+v"(q8));
  } else {
  #pragma unroll
  for(int d0=0;d0<4;++d0)qr[d0]=*reinterpret_cast<const bf16x8*>(&Qw[(long)r32*qp+d0*16+hi*8]);
  }
  if(QMODE_!=0&&!F8_){
    float y[4][8]; float ss=0.f;
    #pragma unroll
    for(int d0=0;d0<4;++d0){ const u32x4 w=__builtin_bit_cast(u32x4,qr[d0]);
      y[d0][0]=bfl_(w.x);y[d0][1]=bfh_(w.x);y[d0][2]=bfl_(w.y);y[d0][3]=bfh_(w.y);y[d0][4]=bfl_(w.z);y[d0][5]=bfh_(w.z);y[d0][6]=bfl_(w.w);y[d0][7]=bfh_(w.w);
      #pragma unroll
      for(int j=0;j<8;++j)ss+=y[d0][j]*y[d0][j]; }
    { auto rr=__builtin_amdgcn_permlane32_swap(__float_as_uint(ss),__float_as_uint(ss),false,false); ss=__uint_as_float(rr[0])+__uint_as_float(rr[1]); }
    const float rstd=C2/sqrtf(ss*(1.0f/64.0f)+1e-6f);
    #pragma unroll
    for(int d0=0;d0<4;++d0){
      { typedef float f4_ __attribute__((ext_vector_type(4))); const f4_ g0=*(const f4_*)(J.gq+16*d0+8*hi),g1=*(const f4_*)(J.gq+16*d0+8*hi+4);
        y[d0][0]*=rstd*g0[0];y[d0][1]*=rstd*g0[1];y[d0][2]*=rstd*g0[2];y[d0][3]*=rstd*g0[3];y[d0][4]*=rstd*g1[0];y[d0][5]*=rstd*g1[1];y[d0][6]*=rstd*g1[2];y[d0][7]*=rstd*g1[3]; } }
    if(QMODE_==1){ const int t=J.qt0+wid*QBLK+r32, gr=t>>6, gc=t&63;
      typedef float f4_ __attribute__((ext_vector_type(4))); f4_ rr_[4],rc_[4];
      #pragma unroll
      for(int q=0;q<4;++q){ rr_[q]=*(const f4_*)(J.rope+(gr*16+8*hi)*2+4*q); rc_[q]=*(const f4_*)(J.rope+(gc*16+8*hi)*2+4*q); }
      #pragma unroll
      for(int j=0;j<8;++j){ const float cr=rr_[j>>1][2*(j&1)],sr=rr_[j>>1][2*(j&1)+1],cc=rc_[j>>1][2*(j&1)],sc=rc_[j>>1][2*(j&1)+1];
        const float a1=y[0][j],a2=y[1][j],b1=y[2][j],b2=y[3][j];
        y[0][j]=a1*cr-a2*sr; y[1][j]=a2*cr+a1*sr; y[2][j]=b1*cc-b2*sc; y[3][j]=b2*cc+b1*sc; } }
    #pragma unroll
    for(int d0=0;d0<4;++d0){ u32x4 w; w.x=cvtpk_s(y[d0][0],y[d0][1]); w.y=cvtpk_s(y[d0][2],y[d0][3]); w.z=cvtpk_s(y[d0][4],y[d0][5]); w.w=cvtpk_s(y[d0][6],y[d0][7]); qr[d0]=__builtin_bit_cast(bf16x8,w); }
  }
  constexpr bool MS_=(KIND!=1);
  float l_reg=0.f; float mhat=0.f;f32x16 o[2];o[0]=f32x16{};o[1]=f32x16{};f32x16 o2=f32x16{};
  int one2_=0x3f803f80; asm volatile("":"+s"(one2_)); const u32x4 ones4_={(unsigned)one2_,(unsigned)one2_,(unsigned)one2_,(unsigned)one2_}; bf16x8 ONES_=__builtin_bit_cast(bf16x8,ones4_); asm volatile("":"+v"(ONES_));
 f32x16 negm=f32x16{};asm volatile("":"+v"(negm));
  typedef float f32x4_ __attribute__((ext_vector_type(4))); f32x4_ o2s={0.f,0.f,0.f,0.f};
  int sb2_=(((lane&8)==0)==(((lane>>4)&1)==0))?0x3f803f80:0; asm volatile("":"+v"(sb2_)); const u32x4 sb4_={(unsigned)sb2_,(unsigned)sb2_,(unsigned)sb2_,(unsigned)sb2_}; const bf16x8 SUMB_=__builtin_bit_cast(bf16x8,sb4_);
  #define CMASK(P0,P1,t) do{ if(bm_&&(t)>=4)bmask(P0,P1,(t)-4,rlo_,qr_,rs_,cs_,hi,btp_); }while(0)
  bool resc=false;
  #define START(P0,P1) do{ const float rm=rowmax(P0,P1); resc=false; \
    { const float dl=rm; mhat=fadd_s(mhat,dl); \
      _Pragma("unroll") for(int r=0;r<16;++r){P0[r]=fsub_s(P0[r],dl);P1[r]=fsub_s(P1[r],dl);} \
      _Pragma("unroll") for(int r=0;r<16;++r)negm[r]=-mhat; asm volatile("":"+v"(negm)); } \
    _Pragma("unroll") for(int r=0;r<16;++r)P0[r]=__builtin_amdgcn_exp2f(P0[r]); }while(0)
  #define RESC() do{ if(resc){ asm volatile("s_waitcnt lgkmcnt(0)":::"memory"); \
      _Pragma("unroll") for(int r=0;r<16;++r){const float f_=wsf[crow(r,hi)];o[0][r]*=f_;o[1][r]*=f_;if constexpr(MS_)o2[r]*=f_;} } }while(0)
  f32x16 pA0,pA1,pB0,pB1; s16x4 vlo[8],vhi[8]; u32x4 pw0,pw1,pw2,pw3;
  int sl_prev=0,sl_cur=0,sl_next=SLOTB;
  #define ROT() do{sl_prev=sl_cur;sl_cur=sl_next;sl_next=(sl_next==(NSLOT-1)*SLOTB)?0:sl_next+SLOTB;}while(0)
  DMA_K(2,2*SLOTB);
  WAIT_BAR(3);
  constexpr bool NEWP_=(KIND==0)&&(ATTN_NEWPIPE!=0);
  if constexpr(!NEWP_){
  qkt(pA0,pA1,Kbase,qr,negm,r32,hi);asm volatile("s_nop 15\n\ts_nop 7":"+v"(pA0),"+v"(pA1));CMASK(pA0,pA1,0);
  START(pA0,pA1);
  _Pragma("unroll") for(int r=0;r<16;++r)pA1[r]=__builtin_amdgcn_exp2f(pA1[r]);
  WAIT_BAR(0);
  DMA_K(3,0);DMA_V(1,SLOTB);
  ROT();
  kload8(kf,kp0+sl_cur);
  WAIT_BAR(2);
  #define PKW(P,B) cvtpk_s(P[B],P[B+1])
  #define PAF(k) __builtin_bit_cast(bf16x8,pw##k)
  #define VFR(i) (bf16x8){vlo[i][0],vlo[i][1],vlo[i][2],vlo[i][3],vhi[i][0],vhi[i][1],vhi[i][2],vhi[i][3]}
  #define PIN(x) asm volatile("":"+v"(x))
  #define MX3(a,b,c) __builtin_fmaxf(__builtin_fmaxf((a),(b)),(c))
  #define GAPA(MF,A0,A1,A2,A3,W0,W1,PW) do{ MF; if constexpr(!MS_){ sacc+=A0; sacc+=A1; sacc+=A2; sacc+=A3; PIN(sacc); } W0; W1; PIN(PW); SBAR(); }while(0)
  #define SUMM(k) do{ if constexpr(MS_){ o2=__builtin_amdgcn_mfma_f32_32x32x16_bf16(PAF(k),ONES_,o2,0,0,0); SBAR(); } }while(0)
  #define EX(v) __builtin_amdgcn_exp2f(v)
  #define GAPB(MF,X,B) do{ MF; X[B]=EX(X[B]); X[B+1]=EX(X[B+1]); X[B+2]=EX(X[B+2]); X[B+3]=EX(X[B+3]); PIN(X); SBAR(); }while(0)
  #define VRD(i) do{ vlo[i]=vtr(vp_+(((i)>>2)*4096+((i)&3)*1024)); vhi[i]=vtr(vp_+(((i)>>2)*4096+((i)&3)*1024+512)); }while(0)
  #define KRD(G,j) do{ if(G){ kload2(kf,kp0+sl_next,j); SBAR(); } }while(0)
  #define STEP(C0,C1,P0,P1,t,GK,GV,GL) do{ SBAR(); \
    const lds_cptr vp_=vp0+sl_prev; \
    VRD(0); SBAR(); float sacc=MS_?0.f:(P0[0]+P0[1]); \
    GAPA(C0=__builtin_amdgcn_mfma_f32_32x32x16_bf16(kf[0],qr[0],negm,0,0,0), P0[2],P0[3],P0[4],P0[5],     pw0[0]=PKW(P0,0), pw0[1]=PKW(P0,2), pw0); \
    VRD(4); SBAR(); GAPA(C1=__builtin_amdgcn_mfma_f32_32x32x16_bf16(kf[1],qr[0],negm,0,0,0), P0[6],P0[7],P0[8],P0[9],     pw0[2]=PKW(P0,4), pw0[3]=PKW(P0,6), pw0); \
    VRD(1); SBAR(); GAPA(C0=__builtin_amdgcn_mfma_f32_32x32x16_bf16(kf[2],qr[1],C0,0,0,0),   P0[10],P0[11],P0[12],P0[13], pw1[0]=PKW(P0,8), pw1[1]=PKW(P0,10), pw1); \
    VRD(5); SBAR(); GAPA(C1=__builtin_amdgcn_mfma_f32_32x32x16_bf16(kf[3],qr[1],C1,0,0,0),   P0[14],P0[15],P1[0],P1[1],   pw1[2]=PKW(P0,12),pw1[3]=PKW(P0,14), pw1); \
    VRD(2); SBAR(); GAPA(C0=__builtin_amdgcn_mfma_f32_32x32x16_bf16(kf[4],qr[2],C0,0,0,0),   P1[2],P1[3],P1[4],P1[5],     pw2[0]=PKW(P1,0), pw2[1]=PKW(P1,2), pw2); \
    VRD(6); SBAR(); GAPA(C1=__builtin_amdgcn_mfma_f32_32x32x16_bf16(kf[5],qr[2],C1,0,0,0),   P1[6],P1[7],P1[8],P1[9],     pw2[2]=PKW(P1,4), pw2[3]=PKW(P1,6), pw2); \
    VRD(3); SBAR(); GAPA(C0=__builtin_amdgcn_mfma_f32_32x32x16_bf16(kf[6],qr[3],C0,0,0,0),   P1[10],P1[11],P1[12],P1[13], pw3[0]=PKW(P1,8), pw3[1]=PKW(P1,10), pw3); \
    VRD(7); SBAR(); GAPA(C1=__builtin_amdgcn_mfma_f32_32x32x16_bf16(kf[7],qr[3],C1,0,0,0),   P1[14],P1[15],0.f,0.f,       pw3[2]=PKW(P1,12),pw3[3]=PKW(P1,14), pw3); \
    if constexpr(!MS_) l_reg+=sacc; \
    if(GK){DMA_K((t)+3,sl_cur);} if(GV){DMA_V((t)+1,sl_next);} \
    CMASK(C0,C1,t); \
    { float a=MX3(C0[0],C0[1],C1[0]),b=MX3(C0[2],C0[3],C1[1]); a=MX3(a,C1[2],C1[3]); \
      _Pragma("unroll") for(int r=4;r<16;r+=4){a=MX3(a,C0[r],C0[r+1]);b=MX3(b,C0[r+2],C0[r+3]);a=MX3(a,C1[r],C1[r+1]);b=MX3(b,C1[r+2],C1[r+3]);} \
      float rm=__builtin_fmaxf(a,b); { auto rr=__builtin_amdgcn_permlane32_swap(__float_as_uint(rm),__float_as_uint(rm),false,false); rm=__builtin_fmaxf(__uint_as_float(rr[0]),__uint_as_float(rr[1])); } \
      resc=false; \
      if(__builtin_expect(__any(rm>(float)THRL),0)){ const float dl=__builtin_fmaxf(rm,0.f); mhat+=dl; \
        _Pragma("unroll") for(int r=0;r<16;++r){C0[r]-=dl;C1[r]-=dl;} \
        _Pragma("unroll") for(int r=0;r<16;++r)negm[r]=-mhat; asm volatile("":"+v"(negm)); \
        const float f=__builtin_amdgcn_exp2f(-dl); if constexpr(!MS_) l_reg*=f; if(hi==0)wsf[r32]=f; resc=true; } } \
    SBAR(); \
    GAPB(o[0]=__builtin_amdgcn_mfma_f32_32x32x16_bf16(PAF(0),VFR(0),o[0],0,0,0), C0,0); \
    GAPB(o[1]=__builtin_amdgcn_mfma_f32_32x32x16_bf16(PAF(0),VFR(4),o[1],0,0,0), C0,4); SUMM(0); \
    KRD(GL,0); GAPB(o[0]=__builtin_amdgcn_mfma_f32_32x32x16_bf16(PAF(1),VFR(1),o[0],0,0,0), C0,8); \
    KRD(GL,1); GAPB(o[1]=__builtin_amdgcn_mfma_f32_32x32x16_bf16(PAF(1),VFR(5),o[1],0,0,0), C0,12); SUMM(1); \
    KRD(GL,2); GAPB(o[0]=__builtin_amdgcn_mfma_f32_32x32x16_bf16(PAF(2),VFR(2),o[0],0,0,0), C1,0); \
    KRD(GL,3); GAPB(o[1]=__builtin_amdgcn_mfma_f32_32x32x16_bf16(PAF(2),VFR(6),o[1],0,0,0), C1,4); SUMM(2); \
    GAPB(o[0]=__builtin_amdgcn_mfma_f32_32x32x16_bf16(PAF(3),VFR(3),o[0],0,0,0), C1,8); \
    GAPB(o[1]=__builtin_amdgcn_mfma_f32_32x32x16_bf16(PAF(3),VFR(7),o[1],0,0,0), C1,12); SUMM(3); \
    }while(0)
  int t=1;
  #undef CMASK
  #define CMASK(P0,P1,t) do{}while(0)
  for(;t+5<NTs;t+=2){
    STEP(pB0,pB1,pA0,pA1,t,true,true,true);     WAIT_BAR(2); RESC(); ROT();
    STEP(pA0,pA1,pB0,pB1,t+1,true,true,true);   WAIT_BAR(2); RESC(); ROT();
  }
  #undef CMASK
  #define CMASK(P0,P1,t) do{ if(bm_&&(t)>=4)bmask(P0,P1,(t)-4,rlo_,qr_,rs_,cs_,hi,btp_); }while(0)
  #define ENDW(tt) do{ if((tt)+3<NT){WAIT_BAR(2);} else if((tt)+2<NT){WAIT_BAR(1);} else {WAIT_BAR(0);} }while(0)
  for(;t+1<NT;t+=2){
    STEP(pB0,pB1,pA0,pA1,t,(t+3<NT),(t+1<NT),(t+1<NT));       ENDW(t);   RESC(); ROT();
    STEP(pA0,pA1,pB0,pB1,t+1,(t+4<NT),(t+2<NT),(t+2<NT));     ENDW(t+1); RESC(); ROT();
  }
  STEP(pB0,pB1,pA0,pA1,NT-1,false,false,false); RESC();
  { if constexpr(!MS_){ float sacc=pB0[0]+pB0[1]; _Pragma("unroll") for(int r=2;r<16;++r)sacc+=pB0[r]; _Pragma("unroll") for(int r=0;r<16;++r)sacc+=pB1[r]; l_reg+=sacc; }
    pw0=(u32x4){PKW(pB0,0),PKW(pB0,2),PKW(pB0,4),PKW(pB0,6)};pw1=(u32x4){PKW(pB0,8),PKW(pB0,10),PKW(pB0,12),PKW(pB0,14)};pw2=(u32x4){PKW(pB1,0),PKW(pB1,2),PKW(pB1,4),PKW(pB1,6)};pw3=(u32x4){PKW(pB1,8),PKW(pB1,10),PKW(pB1,12),PKW(pB1,14)};
    SBAR(); pv(o,vb0+sl_cur,PAF(0),PAF(1),PAF(2),PAF(3)); SUMM(0); SUMM(1); SUMM(2); SUMM(3); }
  } else if constexpr(PV==8) {
  { float nm_=-J.mref; asm volatile("":"+v"(nm_)); _Pragma("unroll") for(int r=0;r<16;++r)negm[r]=nm_; asm volatile("":"+v"(negm)); }
  v8i_a kf8[2],vf8[2],pw8; int sca_=0x7F7F7F7F, scb_=0x7B7B7B7B, scv_=0x7C7C7C7C; asm volatile("":"+v"(sca_),"+v"(scb_),"+v"(scv_));
  int sb8_=(((lane&8)==0)==(((lane>>4)&1)==0))?0x38383838:0; asm volatile("":"+v"(sb8_)); const v8i_a SUMB8={sb8_,sb8_,sb8_,sb8_,sb8_,sb8_,sb8_,sb8_};
  const int ko0_=r32*64+(((2*hi)^((r32>>2)&3))*16); const lds_cptr kp8a=shm3+LDS_K+ko0_, kp8b=shm3+LDS_K+(ko0_^16), vq8a=shm3+LDS_V+ko0_, vq8b=shm3+LDS_V+(ko0_^16);
  #define KLD8(n,slot) do{ const v4i_a lo_=*(const __attribute__((address_space(3))) v4i_a*)(kp8a+(slot)+(n)*2048), hi_=*(const __attribute__((address_space(3))) v4i_a*)(kp8b+(slot)+(n)*2048); kf8[n]=__builtin_shufflevector(lo_,hi_,0,1,2,3,4,5,6,7); }while(0)
  #define VLD8(n,slot) do{ const v4i_a lo_=*(const __attribute__((address_space(3))) v4i_a*)(vq8a+(slot)+(n)*2048), hi_=*(const __attribute__((address_space(3))) v4i_a*)(vq8b+(slot)+(n)*2048); vf8[n]=__builtin_shufflevector(lo_,hi_,0,1,2,3,4,5,6,7); }while(0)
  #define MFQ8(G,C,n) do{ if(G){ asm volatile("s_nop 1\n\tv_mfma_scale_f32_32x32x64_f8f6f4 %0, %1, %2, %3, %4, %5 op_sel_hi:[0,0,0]" : "=&v"(C) : "v"(kf8[n]), "v"(q8), "v"(negm), "v"(sca_), "v"(scb_)); } }while(0)
  #define MFP8(d) asm volatile("s_nop 1\n\tv_mfma_scale_f32_32x32x64_f8f6f4 %0, %1, %2, %0, %3, %4 op_sel_hi:[0,0,0] cbsz:1" : "+v"(o[d]) : "v"(pw8), "v"(vf8[d]), "v"(sca_), "v"(scv_))
  #define MFS8() asm volatile("s_nop 1\n\tv_mfma_scale_f32_16x16x128_f8f6f4 %0, %1, %2, %0, %3, %4 op_sel_hi:[0,0,0] cbsz:1" : "+v"(o2s) : "v"(pw8), "v"(SUMB8), "v"(sca_), "v"(sca_))
  #define PKP8(C0,C1) do{ pw8[0]=pkb8(C0[0],C0[1],C0[2],C0[3]); pw8[1]=pkb8(C0[4],C0[5],C0[6],C0[7]); pw8[2]=pkb8(C0[8],C0[9],C0[10],C0[11]); pw8[3]=pkb8(C0[12],C0[13],C0[14],C0[15]); \
      pw8[4]=pkb8(C1[0],C1[1],C1[2],C1[3]); pw8[5]=pkb8(C1[4],C1[5],C1[6],C1[7]); pw8[6]=pkb8(C1[8],C1[9],C1[10],C1[11]); pw8[7]=pkb8(C1[12],C1[13],C1[14],C1[15]); PIN(pw8); }while(0)
  #define NOPS5(a,b) asm volatile("s_nop 15\n\ts_nop 15\n\ts_nop 15\n\ts_nop 15\n\ts_nop 15":"+v"(a),"+v"(b))
  KLD8(0,0); KLD8(1,0); MFQ8(true,pA0,0); MFQ8(true,pA1,1); NOPS5(pA0,pA1);
  _Pragma("unroll") for(int r=0;r<16;++r){pA0[r]=__builtin_amdgcn_exp2f(pA0[r]);pA1[r]=__builtin_amdgcn_exp2f(pA1[r]);}
  PKP8(pA0,pA1);
  WAIT_BAR(0);
  DMA_K(3,0);DMA_V(1,SLOTB);
  ROT();
  KLD8(0,SLOTB); KLD8(1,SLOTB); MFQ8(true,pB0,0); MFQ8(true,pB1,1); NOPS5(pB0,pB1); KLD8(0,2*SLOTB); KLD8(1,2*SLOTB);
  WAIT_BAR(1);
  DMA_K(4,SLOTB);
  #define EXS(X,i) X[i]=EX(X[i])
  #define EX4(X,i) do{ EXS(X,i); EXS(X,(i)+1); EXS(X,(i)+2); EXS(X,(i)+3); PIN(X); SBAR(); }while(0)
  #define STEP8(N0,N1,C0,C1,t,GK,GV,GL,GQ) do{ SBAR(); \
    VLD8(0,sl_prev); VLD8(1,sl_prev); SBAR(); \
    MFQ8(GQ,N0,0); EX4(C0,0); EX4(C0,4); \
    MFQ8(GQ,N1,1); EX4(C0,8); EX4(C0,12); \
    if(GK){DMA_K((t)+4,sl_next);} if(GV){DMA_V((t)+1,sl_next);} SBAR(); \
    if(GL){ KLD8(0,sl_prev); KLD8(1,sl_prev); } SBAR();         \
    MFP8(0); EX4(C1,0); \
    MFP8(1); EX4(C1,4); \
    MFS8();  EX4(C1,8); \
    EX4(C1,12); \
    PKP8(C0,C1); SBAR(); \
    }while(0)
  #define ENDWN(tt) do{ if((tt)+4<NT){WAIT_BAR(2);} else if((tt)+2<NT){WAIT_BAR(1);} else {WAIT_BAR(0);} }while(0)
  int t=1;
  for(;t+5<NT;t+=2){
    STEP8(pA0,pA1,pB0,pB1,t,true,true,true,true);     WAIT_BAR(2); ROT();
    STEP8(pB0,pB1,pA0,pA1,t+1,true,true,true,true);   WAIT_BAR(2); ROT();
  }
  for(;t+1<NT;t+=2){
    STEP8(pA0,pA1,pB0,pB1,t,(t+4<NT),(t+1<NT),(t+2<NT),(t+1<NT));       ENDWN(t);   ROT();
    STEP8(pB0,pB1,pA0,pA1,t+1,(t+5<NT),(t+2<NT),(t+3<NT),(t+2<NT));     ENDWN(t+1); ROT();
  }
  STEP8(pA0,pA1,pB0,pB1,NT-1,false,false,false,false);
  SBAR(); VLD8(0,sl_cur); VLD8(1,sl_cur); SBAR(); MFP8(0); MFP8(1); MFS8(); NOPS5(o[0],o[1]);
  #undef KLD8
  #undef VLD8
  #undef MFQ8
  #undef MFP8
  #undef MFS8
  #undef PKP8
  #undef NOPS5
  #undef EXS
  #undef EX4
  #undef STEP8
  #undef ENDWN
  } else if constexpr(PV==7) {
  { float nm_=-J.mref; asm volatile("":"+v"(nm_)); _Pragma("unroll") for(int r=0;r<16;++r)negm[r]=nm_; asm volatile("":"+v"(negm)); }
  v8i_a kf8[2]; int sca_=0x7F7F7F7F, scb_=0x7B7B7B7B; asm volatile("":"+v"(sca_),"+v"(scb_));
  const int ko0_=r32*64+(((2*hi)^((r32>>2)&3))*16); const lds_cptr kp8a=shm3+LDS_K+ko0_, kp8b=shm3+LDS_K+(ko0_^16);
  #define KLD8(n,slot) do{ const v4i_a lo_=*(const __attribute__((address_space(3))) v4i_a*)(kp8a+(slot)+(n)*2048), hi_=*(const __attribute__((address_space(3))) v4i_a*)(kp8b+(slot)+(n)*2048); kf8[n]=__builtin_shufflevector(lo_,hi_,0,1,2,3,4,5,6,7); }while(0)
  #define MFQ8(G,C,n) do{ if(G){ asm volatile("s_nop 1\n\tv_mfma_scale_f32_32x32x64_f8f6f4 %0, %1, %2, %3, %4, %5 op_sel_hi:[0,0,0]" : "=&v"(C) : "v"(kf8[n]), "v"(q8), "v"(negm), "v"(sca_), "v"(scb_)); } }while(0)
  if constexpr(F8_){ KLD8(0,0); KLD8(1,0); MFQ8(true,pA0,0); MFQ8(true,pA1,1); asm volatile("s_nop 15\n\ts_nop 15\n\ts_nop 15\n\ts_nop 15\n\ts_nop 15":"+v"(pA0),"+v"(pA1)); }
  else { qkt(pA0,pA1,Kbase,qr,negm,r32,hi); }
  _Pragma("unroll") for(int r=0;r<16;++r){pA0[r]=__builtin_amdgcn_exp2f(pA0[r]);pA1[r]=__builtin_amdgcn_exp2f(pA1[r]);}
  pw0=(u32x4){PKW(pA0,0),PKW(pA0,2),PKW(pA0,4),PKW(pA0,6)};pw1=(u32x4){PKW(pA0,8),PKW(pA0,10),PKW(pA0,12),PKW(pA0,14)};pw2=(u32x4){PKW(pA1,0),PKW(pA1,2),PKW(pA1,4),PKW(pA1,6)};pw3=(u32x4){PKW(pA1,8),PKW(pA1,10),PKW(pA1,12),PKW(pA1,14)};
  WAIT_BAR(0);
  DMA_K(3,0);DMA_V(1,SLOTB);
  ROT();
  if constexpr(F8_){ KLD8(0,SLOTB); KLD8(1,SLOTB); MFQ8(true,pB0,0); MFQ8(true,pB1,1); asm volatile("s_nop 15\n\ts_nop 15\n\ts_nop 15\n\ts_nop 15\n\ts_nop 15":"+v"(pB0),"+v"(pB1)); KLD8(0,2*SLOTB); KLD8(1,2*SLOTB); }
  else { qkt(pB0,pB1,Kbase+SLOTB,qr,negm,r32,hi); kload8(kf,kp0+2*SLOTB); }
  WAIT_BAR(1);
  DMA_K(4,SLOTB);
  #define MFQ(G,C,k,q,ACC) do{ if constexpr(F8_){ if((k)==0){ MFQ8(G,C,0); } else if((k)==5){ MFQ8(G,C,1); } } else { if(G){ C=__builtin_amdgcn_mfma_f32_32x32x16_bf16(kf[k],qr[q],ACC,0,0,0); } } }while(0)
  #define MFP(d,k,v) o[d]=__builtin_amdgcn_mfma_f32_32x32x16_bf16(PAF(k),VFR(v),o[d],0,0,0)
  #define MFS(k) o2s=__builtin_amdgcn_mfma_f32_16x16x32_bf16(PAF(k),SUMB_,o2s,0,0,0)
  #define EXS(X,i) X[i]=EX(X[i])
  #define KRDN(G,j) do{ if(G){ if constexpr(F8_){ if((j)==0){ KLD8(0,sl_prev); } else if((j)==1){ KLD8(1,sl_prev); } } else { kload2(kf,kp0+sl_prev,j); } SBAR(); } }while(0)
  #define STEPF(N0,N1,C0,C1,t,GK,GV,GL,GQ) do{ SBAR(); \
    const lds_cptr vp_=vp0+sl_prev; \
    VRD(0); SBAR(); MFQ(GQ,N0,0,0,negm); EXS(C0,0);  EXS(C0,1);  PIN(C0); SBAR(); \
    VRD(4); SBAR(); MFQ(GQ,N1,1,0,negm); EXS(C0,2);  EXS(C0,3);  PIN(C0); SBAR(); \
    VRD(1); SBAR(); MFQ(GQ,N0,2,1,N0);   EXS(C0,4);  EXS(C0,5);  PIN(C0); SBAR(); \
    VRD(5); SBAR(); MFQ(GQ,N1,3,1,N1);   EXS(C0,6);  EXS(C0,7);  PIN(C0); SBAR(); \
    VRD(2); SBAR(); MFQ(GQ,N0,4,2,N0);   EXS(C0,8);  EXS(C0,9);  PIN(C0); SBAR(); \
    VRD(6); SBAR(); MFQ(GQ,N1,5,2,N1);   EXS(C0,10); EXS(C0,11); PIN(C0); SBAR(); \
    VRD(3); SBAR(); MFQ(GQ,N0,6,3,N0);   EXS(C0,12); EXS(C0,13); PIN(C0); SBAR(); \
    VRD(7); SBAR(); MFQ(GQ,N1,7,3,N1);   EXS(C0,14); EXS(C0,15); PIN(C0); SBAR(); \
    if(GK){DMA_K((t)+4,sl_next);} if(GV){DMA_V((t)+1,sl_next);} SBAR(); \
    MFP(0,0,0); EXS(C1,0); EXS(C1,1); PIN(C1); SBAR(); \
    MFP(1,0,4); EXS(C1,2); EXS(C1,3); PIN(C1); SBAR(); \
    MFS(0);     EXS(C1,4); EXS(C1,5); PIN(C1); SBAR(); \
    MFP(0,1,1); pw0[0]=PKW(C0,0); pw0[1]=PKW(C0,2); pw0[2]=PKW(C0,4); pw0[3]=PKW(C0,6); PIN(pw0); SBAR(); \
    KRDN(GL,0); MFP(1,1,5); EXS(C1,6); EXS(C1,7); PIN(C1); SBAR(); \
    KRDN(GL,1); MFS(1);     EXS(C1,8); EXS(C1,9); PIN(C1); SBAR(); \
    MFP(0,2,2); pw1[0]=PKW(C0,8); pw1[1]=PKW(C0,10); pw1[2]=PKW(C0,12); pw1[3]=PKW(C0,14); PIN(pw1); SBAR(); \
    KRDN(GL,2); MFP(1,2,6); EXS(C1,10); EXS(C1,11); PIN(C1); SBAR(); \
    KRDN(GL,3); MFS(2);     EXS(C1,12); EXS(C1,13); PIN(C1); SBAR(); \
    MFP(0,3,3); pw2[0]=PKW(C1,0); pw2[1]=PKW(C1,2); pw2[2]=PKW(C1,4); pw2[3]=PKW(C1,6); PIN(pw2); SBAR(); \
    MFP(1,3,7); EXS(C1,14); EXS(C1,15); PIN(C1); SBAR(); \
    MFS(3);     SBAR(); \
    pw3[0]=PKW(C1,8); pw3[1]=PKW(C1,10); pw3[2]=PKW(C1,12); pw3[3]=PKW(C1,14); PIN(pw3); SBAR(); \
    }while(0)
  #define ENDWN(tt) do{ if((tt)+4<NT){WAIT_BAR(2);} else if((tt)+2<NT){WAIT_BAR(1);} else {WAIT_BAR(0);} }while(0)
  int t=1;
  for(;t+5<NT;t+=2){
    STEPF(pA0,pA1,pB0,pB1,t,true,true,true,true);     WAIT_BAR(2); ROT();
    STEPF(pB0,pB1,pA0,pA1,t+1,true,true,true,true);   WAIT_BAR(2); ROT();
  }
  for(;t+1<NT;t+=2){
    STEPF(pA0,pA1,pB0,pB1,t,(t+4<NT),(t+1<NT),(t+2<NT),(t+1<NT));       ENDWN(t);   ROT();
    STEPF(pB0,pB1,pA0,pA1,t+1,(t+5<NT),(t+2<NT),(t+3<NT),(t+2<NT));     ENDWN(t+1); ROT();
  }
  STEPF(pA0,pA1,pB0,pB1,NT-1,false,false,false,false);
  SBAR(); pv(o,vb0+sl_cur,PAF(0),PAF(1),PAF(2),PAF(3)); MFS(0); MFS(1); MFS(2); MFS(3);
  #undef MFQ
  #undef MFP
  #undef MFS
  #undef EXS
  #undef KRDN
  #undef STEPF
  #undef KLD8
  #undef MFQ8
  #undef ENDWN
  } else {
  qkt(pA0,pA1,Kbase,qr,negm,r32,hi);asm volatile("s_nop 15\n\ts_nop 7":"+v"(pA0),"+v"(pA1));
  START(pA0,pA1);
  _Pragma("unroll") for(int r=0;r<16;++r)pA1[r]=__builtin_amdgcn_exp2f(pA1[r]);
  pw0=(u32x4){PKW(pA0,0),PKW(pA0,2),PKW(pA0,4),PKW(pA0,6)};pw1=(u32x4){PKW(pA0,8),PKW(pA0,10),PKW(pA0,12),PKW(pA0,14)};pw2=(u32x4){PKW(pA1,0),PKW(pA1,2),PKW(pA1,4),PKW(pA1,6)};pw3=(u32x4){PKW(pA1,8),PKW(pA1,10),PKW(pA1,12),PKW(pA1,14)};
  WAIT_BAR(0);
  DMA_K(3,0);DMA_V(1,SLOTB);
  ROT();
  qkt(pB0,pB1,Kbase+SLOTB,qr,negm,r32,hi);asm volatile("s_nop 15\n\ts_nop 7":"+v"(pB0),"+v"(pB1));
  kload8(kf,kp0+2*SLOTB);
  WAIT_BAR(1);
  DMA_K(4,SLOTB);
  #define MFQ(G,C,k,q,ACC) do{ if(G){ C=__builtin_amdgcn_mfma_f32_32x32x16_bf16(kf[k],qr[q],ACC,0,0,0); } }while(0)
  #define MFP(d,k,v) o[d]=__builtin_amdgcn_mfma_f32_32x32x16_bf16(PAF(k),VFR(v),o[d],0,0,0)
  #define MFS(k) o2=__builtin_amdgcn_mfma_f32_32x32x16_bf16(PAF(k),ONES_,o2,0,0,0)
  #define EXS(X,i) X[i]=EX(X[i])
  #define KRDN(G,j) do{ if(G){ kload2(kf,kp0+sl_prev,j); SBAR(); } }while(0)
  #define STEPN(N0,N1,C0,C1,t,GK,GV,GL,GQ) do{ SBAR(); \
    const lds_cptr vp_=vp0+sl_prev; float a_,b_,rm_; \
    VRD(0); SBAR(); MFQ(GQ,N0,0,0,negm); a_=MX3(C0[0],C0[1],C1[0]); b_=MX3(C0[2],C0[3],C1[1]); a_=MX3(a_,C1[2],C1[3]); a_=MX3(a_,C0[4],C0[5]); PIN(a_); PIN(b_); SBAR(); \
    VRD(4); SBAR(); MFQ(GQ,N1,1,0,negm); b_=MX3(b_,C0[6],C0[7]); a_=MX3(a_,C1[4],C1[5]); b_=MX3(b_,C1[6],C1[7]); a_=MX3(a_,C0[8],C0[9]); PIN(a_); PIN(b_); SBAR(); \
    VRD(1); SBAR(); MFQ(GQ,N0,2,1,N0);   b_=MX3(b_,C0[10],C0[11]); a_=MX3(a_,C1[8],C1[9]); b_=MX3(b_,C1[10],C1[11]); a_=MX3(a_,C0[12],C0[13]); PIN(a_); PIN(b_); SBAR(); \
    VRD(5); SBAR(); MFQ(GQ,N1,3,1,N1);   b_=MX3(b_,C0[14],C0[15]); a_=MX3(a_,C1[12],C1[13]); b_=MX3(b_,C1[14],C1[15]); rm_=__builtin_fmaxf(a_,b_); PIN(rm_); SBAR(); \
    VRD(2); SBAR(); MFQ(GQ,N0,4,2,N0); \
    { auto rr=__builtin_amdgcn_permlane32_swap(__float_as_uint(rm_),__float_as_uint(rm_),false,false); rm_=__builtin_fmaxf(__uint_as_float(rr[0]),__uint_as_float(rr[1])); } \
    resc=false; \
    if(__builtin_expect(__any(rm_>(float)THRL),0)){ const float dl=__builtin_fmaxf(rm_,0.f); mhat+=dl; \
      _Pragma("unroll") for(int r=0;r<16;++r){C0[r]-=dl;C1[r]-=dl;} \
      if(GQ){ _Pragma("unroll") for(int r=0;r<16;++r){N0[r]-=dl;N1[r]-=dl;} }                      \
      _Pragma("unroll") for(int r=0;r<16;++r)negm[r]=-mhat; asm volatile("":"+v"(negm)); \
      const float f=__builtin_amdgcn_exp2f(-dl); if(hi==0)wsf[r32]=f; resc=true; } \
    SBAR(); \
    VRD(6); SBAR(); MFQ(GQ,N1,5,2,N1); EXS(C0,0); EXS(C0,1); PIN(C0); SBAR(); \
    VRD(3); SBAR(); MFQ(GQ,N0,6,3,N0); EXS(C0,2); EXS(C0,3); PIN(C0); SBAR(); \
    VRD(7); SBAR(); MFQ(GQ,N1,7,3,N1); EXS(C0,4); EXS(C0,5); PIN(C0); SBAR(); \
    if(GK){DMA_K((t)+4,sl_next);} if(GV){DMA_V((t)+1,sl_next);} SBAR(); \
    MFP(0,0,0); EXS(C0,6); EXS(C0,7); EXS(C0,8); PIN(C0); SBAR(); \
    MFP(1,0,4); EXS(C0,9); EXS(C0,10); EXS(C0,11); PIN(C0); SBAR(); \
    MFS(0);     EXS(C0,12); EXS(C0,13); EXS(C0,14); PIN(C0); SBAR(); \
    MFP(0,1,1); pw0[0]=PKW(C0,0); pw0[1]=PKW(C0,2); pw0[2]=PKW(C0,4); pw0[3]=PKW(C0,6); EXS(C0,15); PIN(pw0); PIN(C0); SBAR(); \
    KRDN(GL,0); MFP(1,1,5); EXS(C1,0); EXS(C1,1); PIN(C1); SBAR(); \
    KRDN(GL,1); MFS(1);     EXS(C1,2); EXS(C1,3); PIN(C1); SBAR(); \
    MFP(0,2,2); pw1[0]=PKW(C0,8); pw1[1]=PKW(C0,10); pw1[2]=PKW(C0,12); pw1[3]=PKW(C0,14); EXS(C1,4); PIN(pw1); PIN(C1); SBAR(); \
    KRDN(GL,2); MFP(1,2,6); EXS(C1,5); EXS(C1,6); PIN(C1); SBAR(); \
    KRDN(GL,3); MFS(2);     EXS(C1,7); EXS(C1,8); PIN(C1); SBAR(); \
    MFP(0,3,3); pw2[0]=PKW(C1,0); pw2[1]=PKW(C1,2); pw2[2]=PKW(C1,4); pw2[3]=PKW(C1,6); EXS(C1,9); PIN(pw2); PIN(C1); SBAR(); \
    MFP(1,3,7); EXS(C1,10); EXS(C1,11); EXS(C1,12); PIN(C1); SBAR(); \
    MFS(3);     EXS(C1,13); EXS(C1,14); EXS(C1,15); PIN(C1); SBAR(); \
    pw3[0]=PKW(C1,8); pw3[1]=PKW(C1,10); pw3[2]=PKW(C1,12); pw3[3]=PKW(C1,14); PIN(pw3); SBAR(); \
    }while(0)
  #define ENDWN(tt) do{ if((tt)+4<NT){WAIT_BAR(2);} else if((tt)+2<NT){WAIT_BAR(1);} else {WAIT_BAR(0);} }while(0)
  int t=1;
  for(;t+5<NT;t+=2){
    STEPN(pA0,pA1,pB0,pB1,t,true,true,true,true);     WAIT_BAR(2); RESC(); ROT();
    STEPN(pB0,pB1,pA0,pA1,t+1,true,true,true,true);   WAIT_BAR(2); RESC(); ROT();
  }
  for(;t+1<NT;t+=2){
    STEPN(pA0,pA1,pB0,pB1,t,(t+4<NT),(t+1<NT),(t+2<NT),(t+1<NT));       ENDWN(t);   RESC(); ROT();
    STEPN(pB0,pB1,pA0,pA1,t+1,(t+5<NT),(t+2<NT),(t+3<NT),(t+2<NT));     ENDWN(t+1); RESC(); ROT();
  }
  STEPN(pA0,pA1,pB0,pB1,NT-1,false,false,false,false); RESC();
  SBAR(); pv(o,vb0+sl_cur,PAF(0),PAF(1),PAF(2),PAF(3)); SUMM(0); SUMM(1); SUMM(2); SUMM(3);
  #undef MFQ
  #undef MFP
  #undef MFS
  #undef EXS
  #undef KRDN
  #undef STEPN
  #undef ENDWN
  }
  #undef PKW
  #undef PAF
  #undef VFR
  #undef PIN
  #undef MX3
  #undef GAPA
  #undef SUMM
  #undef GAPB
  #undef EX
  #undef VRD
  #undef KRD
  #undef STEP
  #undef ENDW
  constexpr bool S16_=(KIND==0)&&(ATTN_NEWPIPE!=0)&&(PV==7||PV==8);
  if constexpr(S16_){ asm volatile("s_nop 15\n\ts_nop 7":"+v"(o2s));
    if((lane&7)==0){ const int qb=((lane&8)?16:0)+4*(lane>>4); _Pragma("unroll") for(int j=0;j<4;++j)wsf[32+qb+j]=o2s[j]; }
    asm volatile("s_waitcnt lgkmcnt(0)":::"memory"); }
  else if constexpr(MS_){ asm volatile("s_nop 15\n\ts_nop 7":"+v"(o2)); }
  else { auto rr=__builtin_amdgcn_permlane32_swap(__float_as_uint(l_reg),__float_as_uint(l_reg),false,false);l_reg=__uint_as_float(rr[0])+__uint_as_float(rr[1]); if(hi==0)wsf[32+r32]=l_reg;asm volatile("s_waitcnt lgkmcnt(0)":::"memory"); }
  float rli[16];
  #pragma unroll
  for(int r=0;r<16;++r)rli[r]=__builtin_amdgcn_rcpf((MS_&&!S16_)?o2[r]:wsf[32+crow(r,hi)]);
  bf16*Ow=J.O+(long)(wid*QBLK)*op;
  { bf16*stg=(bf16*)(shm+LDS_OST)+wid*2048;
    #pragma unroll
    for(int r=0;r<16;++r){const int orow=crow(r,hi);
      #pragma unroll
      for(int d0=0;d0<2;++d0)stg[orow*64+d0*32+r32]=__float2bfloat16(o[d0][r]*rli[r]);}
    asm volatile("s_waitcnt lgkmcnt(0)":::"memory");
    #pragma unroll
    for(int i=0;i<4;++i){const int row=i*8+(lane>>3),ch=lane&7; const u32x4 v=*(const u32x4*)(stg+row*64+ch*8); ATTN_STORE16(Ow+(long)row*op+ch*8,v);} }
  asm volatile("s_waitcnt lgkmcnt(0)\n\ts_barrier":::"memory");
  #undef DMA_K
  #undef KROW
  #undef DMA_V
  #undef CMASK
  #undef START
  #undef RESC
  #undef ROT
}
constexpr int ATTN_LDS_BYTES=LDS_BYTES_ALL;
#undef SBAR
#undef WAIT_BAR
}

constexpr int NWAVES = 8;
constexpr int DM = 1024, NB = 2, SEQ = 8192, DEPTH = 4, CTXL = 256;
constexpr int M_LAT = NB * SEQ, M_CTX = NB * CTXL, M_ALL = M_LAT + M_CTX;
constexpr int INC = 4864;
constexpr int PXW = 1792;
constexpr int C_AQ = 0, C_AK = 512, C_AV = 640, C_BQ = 768, C_BK = 1024, C_BV = 1280, C_CU = 1536, C_G = 1792;
constexpr int DFF = 2816, DFFE = 3584, NE = 8;
constexpr int KVR = SEQ + CTXL;
constexpr int XG_ROWS = 36352;
constexpr float EPS = 1e-6f;
constexpr float C2F = 0.125f * 1.4426950408889634f;
constexpr float LOG2E = 1.4426950408889634f;

constexpr size_t MiB = 1u << 20;
constexpr size_t WS_CTL = 0, CTL_ZERO_BYTES = 32 * 1024;
constexpr size_t WS_MOD = 1 * MiB;
constexpr size_t WS_ROPE = WS_MOD + 512 * 1024;
constexpr size_t WS_CNT = WS_ROPE + 64 * 1024;
constexpr size_t WS_SEG = WS_CNT + 64 * 1024;
constexpr size_t WS_ROUTE = 2 * MiB;
constexpr size_t WS_SLOT = WS_ROUTE + 512 * 1024;
constexpr size_t WS_XC = 4 * MiB;
constexpr size_t WS_WINS = WS_XC;
constexpr size_t WS_W13S = WS_XC + 128 * 1024;
constexpr size_t WS_MW13S = WS_XC + 256 * 1024;
constexpr size_t WS_XNS = WS_XC + 768 * 1024;
constexpr size_t WS_XGS = WS_XC + 896 * 1024;
constexpr size_t WS_WIN = 6 * MiB;
constexpr size_t WS_WCAT = WS_WIN + (size_t)4 * INC * DM * 2;
constexpr size_t WS_WOUT = WS_WCAT + (size_t)4 * DM * DM * 2;
constexpr size_t WS_W13 = WS_WOUT + (size_t)4 * DM * DM * 2;
constexpr size_t WS_W2 = WS_W13 + (size_t)2 * 2 * DFF * DM * 2;
constexpr size_t WS_MW13 = WS_W2 + (size_t)2 * DM * DFF * 2;
constexpr size_t WS_MW2 = WS_MW13 + (size_t)2 * NE * 2 * DFFE * DM * 2;
constexpr size_t WS_XN = WS_MW2 + (size_t)2 * NE * DM * DFFE * 2;
constexpr size_t WS_XG = WS_XN + (size_t)M_ALL * DM * 2;
constexpr size_t WS_SL = WS_XG;
constexpr int SL_TILES = 10, SL_S = 7;
constexpr size_t WS_Y = WS_XG + (size_t)XG_ROWS * DM * 2;
constexpr size_t WS_XR = WS_Y + (size_t)XG_ROWS * DM * 2;
constexpr size_t WS_R = WS_XR + (size_t)M_ALL * DM * 2;
constexpr size_t WS_PX = WS_R;
constexpr size_t WS_GF = WS_PX + (size_t)M_ALL * PXW * 2;
constexpr size_t WS_KA = WS_GF + (size_t)66 * 12 * 131072;
constexpr size_t WS_KA8 = WS_KA + (size_t)M_ALL * 128 * 2;
constexpr size_t WS_VT8 = WS_KA8 + (size_t)M_ALL * 128;
constexpr size_t WS_YCAT = WS_VT8 + (size_t)264 * 2 * 4096;
constexpr size_t WS_MB = WS_YCAT + (size_t)M_ALL * DM * 2;
constexpr size_t WS_PART = WS_MB + (size_t)M_ALL * DM * 2;
constexpr size_t WS_END0 = WS_PART + (size_t)11 * M_CTX * DM * 4;
constexpr size_t WS_H = WS_R;
constexpr size_t WS_END = (WS_H + (size_t)XG_ROWS * DFFE * 2 > WS_END0) ? WS_H + (size_t)XG_ROWS * DFFE * 2 : WS_END0;
static_assert(WS_SEG + 64 <= WS_ROUTE && WS_SLOT + (size_t)M_ALL * 8 <= WS_XC && WS_XGS + (size_t)XG_ROWS * 4 <= WS_WIN && WS_MW13S + (size_t)16 * 7168 * 4 <= WS_XNS && WS_XNS + (size_t)M_ALL * 4 <= WS_XGS, "small tables");
constexpr int CW_BAR = 4096;
static_assert((CW_BAR + 3456) * 4 <= (int)CTL_ZERO_BYTES, "barrier words inside the per-call memset");

constexpr int RING_OFF = 0, RING_BYTES = 131072;
constexpr int LDSCTL_OFF = RING_BYTES, MISC_OFF = LDSCTL_OFF + 320;
constexpr int LDS_BYTES = 147456;
static_assert(attn_body::ATTN_LDS_BYTES <= RING_BYTES, "attention LDS");

#define GAS __attribute__((address_space(1)))
#define LAS __attribute__((address_space(3)))
typedef unsigned short bf16;
typedef unsigned v4u __attribute__((ext_vector_type(4)));
typedef unsigned v2u __attribute__((ext_vector_type(2)));
typedef float f32x4 __attribute__((ext_vector_type(4)));
typedef GAS unsigned gu32;
#define RLX_AGENT __ATOMIC_RELAXED, __HIP_MEMORY_SCOPE_AGENT
#define LDS_WAIT() asm volatile("s_waitcnt lgkmcnt(0)" ::: "memory")
#define VM_WAIT() asm volatile("s_waitcnt vmcnt(0)" ::: "memory")
__device__ __forceinline__ unsigned f2bf(float f) { unsigned u = __builtin_bit_cast(unsigned, f); return (u + 0x7fffu + ((u >> 16) & 1u)) >> 16; }
__device__ __forceinline__ unsigned pk2(float lo, float hi) { return f2bf(lo) | (f2bf(hi) << 16); }
__device__ __forceinline__ float bflo(unsigned w) { return __uint_as_float(w << 16); }
__device__ __forceinline__ float bfhi(unsigned w) { return __uint_as_float(w & 0xffff0000u); }
__device__ __forceinline__ unsigned ldu(const unsigned* p) { return __hip_atomic_load(p, RLX_AGENT); }
__device__ __forceinline__ float ldf(const float* p) { return __uint_as_float(__hip_atomic_load((const unsigned*)p, RLX_AGENT)); }
#define XB_TMO      128
#define XB_XCNT(j)  (256  + 64 * (j))
#define XB_XSUB(j)  (1280 + 64 * (j))
#define XB_XGEN(j)  (2304 + 64 * (j))
#define XB_TOP      3328
#define XB_TOPGEN   3392
#define XCD_BAR_WORDS 3456
#define XB_SPIN_CAP (1u << 18)

__device__ __forceinline__ unsigned xb_ld(unsigned* p)              { return __hip_atomic_load(p, __ATOMIC_RELAXED, __HIP_MEMORY_SCOPE_AGENT); }
__device__ __forceinline__ unsigned xb_add(unsigned* p, unsigned v) { return __hip_atomic_fetch_add(p, v, __ATOMIC_RELAXED, __HIP_MEMORY_SCOPE_AGENT); }
__device__ __forceinline__ unsigned xb_xcc_id() { return (unsigned)__builtin_amdgcn_s_getreg((3 << 11) | 20) & 0xFu; }
#define XB_SPIN(cond, bar) do { unsigned _sp = 0; while (cond) { __builtin_amdgcn_s_sleep(1); \
    if ((++_sp & 255u) == 0u) { if (xb_ld(&(bar)[XB_TMO])) break; if (_sp > XB_SPIN_CAP) { atomicAdd(&(bar)[XB_TMO], 1u); break; } } } } while (0)

struct XcdBarrier {
    int w;
    unsigned* bar; unsigned x;
    volatile LAS unsigned* st;
};

__device__ __forceinline__ XcdBarrier xcd_barrier_post(unsigned* bar, volatile LAS unsigned* st) {
    XcdBarrier b; b.bar = bar; b.x = xb_xcc_id(); b.st = st; b.w = 0;
    if (threadIdx.x == 0) (void)xb_add(&bar[XB_XCNT(b.x)], 1u);
    return b;
}
__device__ __forceinline__ void xcd_barrier_complete(unsigned* bar, unsigned x, unsigned& nloc, unsigned& nx) {
    const unsigned G = gridDim.x * gridDim.y * gridDim.z;
    unsigned sum, cnt, mine, sp = 0u;
    for (;;) {
        sum = 0u; cnt = 0u; mine = 0u;
#pragma unroll
        for (unsigned j = 0; j < 16; ++j) { const unsigned c = xb_ld(&bar[XB_XCNT(j)]); sum += c; cnt += (c > 0u) ? 1u : 0u; mine = (j == x) ? c : mine; }
        if (sum == G) break;
        __builtin_amdgcn_s_sleep(1);
        if ((++sp & 255u) == 0u) { if (xb_ld(&bar[XB_TMO])) break; if (sp > XB_SPIN_CAP) { atomicAdd(&bar[XB_TMO], 1u); break; } }
    }
    nloc = mine > 0u ? mine : 1u; nx = cnt > 0u ? cnt : 1u;
}

__device__ __forceinline__ void xcd_barrier(const XcdBarrier& b) {
    asm volatile("s_waitcnt vmcnt(0)" ::: "memory");
    __syncthreads();
    int lane0_; asm volatile("v_mbcnt_lo_u32_b32 %0, -1, 0\n\tv_mbcnt_hi_u32_b32 %0, -1, %0" : "=v"(lane0_));
    if (b.w == 0 && lane0_ == 0) {
        unsigned* bar = b.bar;
        __builtin_amdgcn_s_waitcnt(0);
        unsigned nloc = b.st[0], nx = b.st[1];
        if (nloc == 0u) { xcd_barrier_complete(bar, b.x, nloc, nx); b.st[0] = nloc; b.st[1] = nx; }
        const unsigned old = xb_add(&bar[XB_XSUB(b.x)], 1u);
        const unsigned gen = old / nloc;
        if (old + 1u == (gen + 1u) * nloc) {
            __builtin_amdgcn_fence(__ATOMIC_RELEASE, "agent");
            asm volatile("s_waitcnt vmcnt(0)" ::: "memory");
            const unsigned og = xb_add(&bar[XB_TOP], 1u);
            const unsigned tg = og / nx;
            if (og + 1u == (tg + 1u) * nx) xb_add(&bar[XB_TOPGEN], 1u);
            else XB_SPIN(xb_ld(&bar[XB_TOPGEN]) == tg, bar);
            __builtin_amdgcn_fence(__ATOMIC_ACQUIRE, "agent");
            xb_add(&bar[XB_XGEN(b.x)], 1u);
            asm volatile("s_waitcnt vmcnt(0)" ::: "memory");
        } else {
            XB_SPIN(xb_ld(&bar[XB_XGEN(b.x)]) == gen, bar);
            __builtin_amdgcn_fence(__ATOMIC_ACQUIRE, "agent");
            asm volatile("s_waitcnt vmcnt(0)" ::: "memory");
        }
    }
    __syncthreads();
}

struct Args { const float* in[27]; float* out; unsigned char* ws; int ph_lo, ph_hi, single, pad; };
enum { I_X = 0, I_C, I_CTX, I_CCTX, I_WMOD, I_BMOD, I_N1G, I_N2G, I_WIN, I_QG, I_KG, I_RELB, I_POOLW, I_POOLS, I_WPA, I_WPB, I_WPC, I_WOUT,
       I_FW1, I_FW3, I_FW2, I_RW, I_RB, I_MW1, I_MW3, I_MW2, I_FING };

typedef __attribute__((address_space(4))) const unsigned char* karg_t;
__device__ __forceinline__ unsigned long long karg_u64(int off) { karg_t kp = (karg_t)__builtin_amdgcn_kernarg_segment_ptr(); return *(volatile __attribute__((address_space(4))) const unsigned long long*)(kp + off); }
#define KIN(i) ((const float*)karg_u64(8 * (i)))
#define KOUT() ((float*)karg_u64(8 * 27))
#define KWS() ((unsigned char*)karg_u64(8 * 28))

struct Frame {
    LAS unsigned char* lds;
    volatile LAS unsigned* MISC;
    int wave, vcu, G;
};
__device__ __forceinline__ int lane_id_l() { int l; asm volatile("v_mbcnt_lo_u32_b32 %0, -1, 0\n\tv_mbcnt_hi_u32_b32 %0, -1, %0" : "=v"(l)); return l; }

template <int M> __device__ __forceinline__ float xshfl(float v) { return __int_as_float(__builtin_amdgcn_ds_swizzle(__float_as_int(v), 0x1f | (M << 10))); }
__device__ __forceinline__ float silu_f(float v) { return v / (1.0f + __expf(-v)); }

__device__ __forceinline__ unsigned cvtpk(float lo, float hi) { unsigned r; asm volatile("v_cvt_pk_bf16_f32 %0, %1, %2" : "=v"(r) : "v"(lo), "v"(hi)); return r; }
__device__ __forceinline__ void p0_transpose_item(const float* W, int K, int N, bf16* WT, int ldt, int koff, int mode, int item, int lane, int sc_lo = 0, int sc_hi = 0) {
    const int nblk = N / 64, kb = item / nblk, nb = item % nblk, k0 = 64 * kb, n0 = 64 * nb;
    const int ng = lane & 15, kg = lane >> 4;
    const float* src = W + (size_t)(k0 + 16 * kg) * N + n0 + 4 * ng;
    f32x4 v[16];
#pragma unroll
    for (int j = 0; j < 16; ++j) v[j] = __builtin_nontemporal_load((const GAS f32x4*)(src + (size_t)j * N));
    const int nbase = n0 + 4 * ng; const int drow = mode == 0 ? nbase : ((nbase >> 7) * 256 + (mode == 2 ? 128 : 0) + (nbase & 127));
    if (nbase >= sc_lo && nbase < sc_hi) {
#pragma unroll
        for (int j = 0; j < 16; ++j) v[j] = v[j] * C2F; }
    bf16* dst = WT + (size_t)drow * ldt + koff + k0 + 16 * kg;
#pragma unroll
    for (int c = 0; c < 4; ++c) {
        v4u o0, o1;
        o0.x = cvtpk(v[0][c], v[1][c]); o0.y = cvtpk(v[2][c], v[3][c]); o0.z = cvtpk(v[4][c], v[5][c]); o0.w = cvtpk(v[6][c], v[7][c]);
        o1.x = cvtpk(v[8][c], v[9][c]); o1.y = cvtpk(v[10][c], v[11][c]); o1.z = cvtpk(v[12][c], v[13][c]); o1.w = cvtpk(v[14][c], v[15][c]);
        *(GAS v4u*)(dst + (size_t)c * ldt) = o0; *(GAS v4u*)(dst + (size_t)c * ldt + 8) = o1; }
}
constexpr float WSC8 = 64.0f; constexpr int WSC8_E8M0 = 0x79797979;
constexpr float HSC8 = 4.0f;  constexpr int HSC8_E8M0 = 0x7D7D7D7D;
__device__ __forceinline__ float c448(float v) { return __builtin_fminf(__builtin_fmaxf(v, -448.f), 448.f); }
__device__ __forceinline__ unsigned pk8(float a, float b, float c, float d) { a = c448(a); b = c448(b); c = c448(c); d = c448(d); unsigned w = 0u; w = __builtin_amdgcn_cvt_pk_fp8_f32(a, b, w, false); w = __builtin_amdgcn_cvt_pk_fp8_f32(c, d, w, true); return w; }
__device__ __forceinline__ void p0_transpose8_item(const float* W, int K, int N, unsigned char* W8, int ldt, int mode, int item, int lane) {
    const int nblk = N / 64, kb = item / nblk, nb = item % nblk, k0 = 64 * kb, n0 = 64 * nb;
    const int ng = lane & 15, kg = lane >> 4;
    const float* src = W + (size_t)(k0 + 16 * kg) * N + n0 + 4 * ng;
    f32x4 v[16];
#pragma unroll
    for (int j = 0; j < 16; ++j) v[j] = __builtin_nontemporal_load((const GAS f32x4*)(src + (size_t)j * N)) * WSC8;
    const int nbase = n0 + 4 * ng; const int drow = mode == 0 ? nbase : ((nbase >> 7) * 256 + (mode == 2 ? 128 : 0) + (nbase & 127));
    unsigned char* dst = W8 + (size_t)drow * ldt + k0 + 16 * kg;
#pragma unroll
    for (int c = 0; c < 4; ++c) {
        v4u o; o.x = pk8(v[0][c], v[1][c], v[2][c], v[3][c]); o.y = pk8(v[4][c], v[5][c], v[6][c], v[7][c]); o.z = pk8(v[8][c], v[9][c], v[10][c], v[11][c]); o.w = pk8(v[12][c], v[13][c], v[14][c], v[15][c]);
        *(GAS v4u*)(dst + (size_t)c * ldt) = o; }
}
__device__ __forceinline__ unsigned pk_i8(float a, float b, float c, float d) { const int ia = (int)__builtin_rintf(a), ib = (int)__builtin_rintf(b), ic = (int)__builtin_rintf(c), id = (int)__builtin_rintf(d);
    return ((unsigned)ia & 0xffu) | (((unsigned)ib & 0xffu) << 8) | (((unsigned)ic & 0xffu) << 16) | ((unsigned)id << 24); }
__device__ __forceinline__ float xmax32(float v) { auto rr = __builtin_amdgcn_permlane32_swap(__float_as_uint(v), __float_as_uint(v), false, false); return __builtin_fmaxf(__uint_as_float(rr[0]), __uint_as_float(rr[1])); }
__device__ __forceinline__ void p0_quant_strip(Frame& F, const float* W, int N, unsigned char* W8, float* WSc, int mode, int strip, int lane, int sc_lo = 0, int sc_hi = 0) {
    const int n0 = 64 * strip, ng = lane & 15, kg = lane >> 4;
    f32x4 v[2][16];
#pragma unroll
    for (int jb = 0; jb < 2; ++jb) { const float* src = W + (size_t)(64 * (2 * F.wave + jb) + 16 * kg) * N + n0 + 4 * ng;
#pragma unroll
        for (int j = 0; j < 16; ++j) v[jb][j] = __builtin_nontemporal_load((const GAS f32x4*)(src + (size_t)j * N)); }
    f32x4 mx = (f32x4){0.f, 0.f, 0.f, 0.f};
#pragma unroll
    for (int jb = 0; jb < 2; ++jb)
#pragma unroll
        for (int j = 0; j < 16; ++j)
#pragma unroll
            for (int c = 0; c < 4; ++c) mx[c] = __builtin_fmaxf(mx[c], __builtin_fabsf(v[jb][j][c]));
#pragma unroll
    for (int c = 0; c < 4; ++c) { mx[c] = __builtin_fmaxf(mx[c], xshfl<16>(mx[c])); mx[c] = xmax32(mx[c]); }
    LAS float* red = (LAS float*)(F.lds + RING_OFF);
    __syncthreads();
    if (kg == 0) *(LAS f32x4*)(red + F.wave * 64 + 4 * ng) = mx;
    __syncthreads();
    f32x4 m = *(const LAS f32x4*)(red + 4 * ng);
#pragma unroll
    for (int w = 1; w < 8; ++w) { const f32x4 t = *(const LAS f32x4*)(red + w * 64 + 4 * ng);
#pragma unroll
        for (int c = 0; c < 4; ++c) m[c] = __builtin_fmaxf(m[c], t[c]); }
    f32x4 inv;
#pragma unroll
    for (int c = 0; c < 4; ++c) inv[c] = m[c] > 0.f ? 127.0f / m[c] : 0.f;
    const int nbase = n0 + 4 * ng; const int drow = mode == 0 ? nbase : ((nbase >> 7) * 256 + (mode == 2 ? 128 : 0) + (nbase & 127));
#pragma unroll
    for (int jb = 0; jb < 2; ++jb) { unsigned char* dst = W8 + (size_t)drow * DM + 64 * (2 * F.wave + jb) + 16 * kg;
#pragma unroll
        for (int c = 0; c < 4; ++c) { v4u o;
            o.x = pk_i8(v[jb][0][c] * inv[c], v[jb][1][c] * inv[c], v[jb][2][c] * inv[c], v[jb][3][c] * inv[c]);    o.y = pk_i8(v[jb][4][c] * inv[c], v[jb][5][c] * inv[c], v[jb][6][c] * inv[c], v[jb][7][c] * inv[c]);
            o.z = pk_i8(v[jb][8][c] * inv[c], v[jb][9][c] * inv[c], v[jb][10][c] * inv[c], v[jb][11][c] * inv[c]); o.w = pk_i8(v[jb][12][c] * inv[c], v[jb][13][c] * inv[c], v[jb][14][c] * inv[c], v[jb][15][c] * inv[c]);
            *(GAS v4u*)(dst + (size_t)c * DM) = o; } }
    if (F.wave == 0 && kg == 0) { const float f = (nbase >= sc_lo && nbase < sc_hi) ? C2F * (1.0f / 127.0f) : (1.0f / 127.0f);
        f32x4 sc; sc[0] = m[0] * f; sc[1] = m[1] * f; sc[2] = m[2] * f; sc[3] = m[3] * f; *(GAS f32x4*)(WSc + drow) = sc; }
}
__device__ __forceinline__ void p0_prologue(Frame& F, const Args& a) {
    unsigned char* ws = KWS(); const int lane = lane_id_l(), tid = F.wave * 64 + lane; (void)tid;
    const int gw = F.vcu * NWAVES + F.wave, NGW = F.G * NWAVES;
    { LAS float* red = (LAS float*)(F.lds + RING_OFF);
      for (int it = F.vcu; it < 4 * 96; it += F.G) {
          __syncthreads();
          const int l = it / 96, n = (it % 96) * 64 + lane;
          const float* wm = KIN(I_WMOD) + (size_t)l * DM * 6144 + n;
          float a0 = 0.f, a1 = 0.f, a2 = 0.f; const float* cv = KIN(I_C); const float* ccv = KIN(I_CCTX);
          const int k0 = F.wave * 128;
#pragma unroll 16
          for (int k = k0; k < k0 + 128; ++k) { const float w = wm[(size_t)k * 6144];
              a0 += silu_f(cv[k]) * w; a1 += silu_f(cv[DM + k]) * w; a2 += silu_f(ccv[k]) * w; }
          red[(F.wave * 3 + 0) * 64 + lane] = a0; red[(F.wave * 3 + 1) * 64 + lane] = a1; red[(F.wave * 3 + 2) * 64 + lane] = a2;
          __syncthreads();
          if (F.wave < 3) { float s = 0.f;
#pragma unroll
              for (int w = 0; w < 8; ++w) s += red[(w * 3 + F.wave) * 64 + lane];
              ((float*)(ws + WS_MOD))[((size_t)l * 3 + F.wave) * 6144 + n] = s + KIN(I_BMOD)[l * 6144 + n]; }
      }
      __syncthreads(); }
    { constexpr int S0 = INC / 64, S4 = DFF / 64, S7 = DFFE / 64;
      constexpr int NSTRIPS = 4 * S0 + 2 * 2 * S4 + 8 * 2 * S7;
      for (int st = F.vcu; st < NSTRIPS; st += F.G) {
          int r = st;
          if (r < 4 * S0) { const int l = r / S0; p0_quant_strip(F, KIN(I_WIN) + (size_t)l * DM * INC, INC, (unsigned char*)(ws + WS_WIN) + (size_t)l * INC * DM, (float*)(ws + WS_WINS) + l * INC, 0, r % S0, lane, C_BQ, C_BK); continue; } r -= 4 * S0;
          if (r < 2 * S4) { const int l = r / S4; p0_quant_strip(F, KIN(I_FW1) + (size_t)l * DM * DFF, DFF, (unsigned char*)(ws + WS_W13) + (size_t)l * 2 * DFF * DM, (float*)(ws + WS_W13S) + l * 2 * DFF, 1, r % S4, lane); continue; } r -= 2 * S4;
          if (r < 2 * S4) { const int l = r / S4; p0_quant_strip(F, KIN(I_FW3) + (size_t)l * DM * DFF, DFF, (unsigned char*)(ws + WS_W13) + (size_t)l * 2 * DFF * DM, (float*)(ws + WS_W13S) + l * 2 * DFF, 2, r % S4, lane); continue; } r -= 2 * S4;
          if (r < 8 * S7) { const int l = r / S7; p0_quant_strip(F, KIN(I_MW1) + (size_t)l * DM * DFFE, DFFE, (unsigned char*)(ws + WS_MW13) + (size_t)l * 2 * DFFE * DM, (float*)(ws + WS_MW13S) + l * 2 * DFFE, 1, r % S7, lane); continue; } r -= 8 * S7;
          { const int l = r / S7; p0_quant_strip(F, KIN(I_MW3) + (size_t)l * DM * DFFE, DFFE, (unsigned char*)(ws + WS_MW13) + (size_t)l * 2 * DFFE * DM, (float*)(ws + WS_MW13S) + l * 2 * DFFE, 2, r % S7, lane); }
      }
      __syncthreads(); }
    constexpr int I1 = (512 / 64) * (DM / 64), I2 = (256 / 64) * (DM / 64), I3 = (DM / 64) * (DM / 64), I6 = (DFF / 64) * (DM / 64), I9 = (DFFE / 64) * (DM / 64);
    constexpr int NITEMS = 4 * (I1 + I2 + I3) + 2 * I6 + 8 * I9;
    for (int it = gw; it < NITEMS; it += NGW) {
        int r = it;
        if (r < 4 * I1) { const int l = r / I1; p0_transpose_item(KIN(I_WPA) + (size_t)l * 512 * DM, 512, DM, (bf16*)(ws + WS_WCAT) + (size_t)l * DM * DM, DM, 0, 0, r % I1, lane); continue; } r -= 4 * I1;
        if (r < 4 * I2) { const int l = r / I2; p0_transpose_item(KIN(I_WPB) + (size_t)l * 256 * DM, 256, DM, (bf16*)(ws + WS_WCAT) + (size_t)l * DM * DM, DM, 512, 0, r % I2, lane); continue; } r -= 4 * I2;
        if (r < 4 * I3) { const int l = r / I3; p0_transpose_item(KIN(I_WOUT) + (size_t)l * DM * DM, DM, DM, (bf16*)(ws + WS_WOUT) + (size_t)l * DM * DM, DM, 0, 0, r % I3, lane); continue; } r -= 4 * I3;
        if (r < 2 * I6) { const int l = r / I6; p0_transpose_item(KIN(I_FW2) + (size_t)l * DFF * DM, DFF, DM, (bf16*)(ws + WS_W2) + (size_t)l * DM * DFF, DFF, 0, 0, r % I6, lane); continue; } r -= 2 * I6;
        { const int l = r / I9; p0_transpose8_item(KIN(I_MW2) + (size_t)l * DFFE * DM, DFFE, DM, (unsigned char*)(ws + WS_MW2) + (size_t)l * DM * DFFE, DFFE, 0, r % I9, lane); }
    }
    for (int it = gw; it < 4 * 4 * 8 * 16; it += NGW) {
        const int nchunk = it & 15, c8 = (it >> 4) & 7, g = (it >> 7) & 3, l = it >> 9;
        const int n = nchunk * 64 + lane;
        const float* pw = KIN(I_POOLW) + ((size_t)(l * 4 + g) * 64 + c8 * 8) * 64;
        const float* ps = KIN(I_POOLS) + l * 256 + g * 64;
        const float* wc = KIN(I_WPC) + ((size_t)l * 256 + g * 64) * DM + n;
        float acc[8];
#pragma unroll
        for (int cc = 0; cc < 8; ++cc) acc[cc] = 0.f;
        for (int j = 0; j < 64; ++j) { const float s = ps[j] * wc[(size_t)j * DM];
#pragma unroll
            for (int cc = 0; cc < 8; ++cc) acc[cc] += pw[cc * 64 + j] * s; }
        v4u o; o.x = pk2(acc[0], acc[1]); o.y = pk2(acc[2], acc[3]); o.z = pk2(acc[4], acc[5]); o.w = pk2(acc[6], acc[7]);
        *(GAS v4u*)((bf16*)(ws + WS_WCAT) + (size_t)l * DM * DM + (size_t)n * DM + 768 + g * 64 + c8 * 8) = o;
    }
    { const int gt = gw * 64 + lane;
      if (gt < 128 * 16) { const int pos = gt >> 4, i = gt & 15; const float inv = powf(10000.0f, -(float)(2 * i) / 32.0f); const float ang = (float)pos * inv;
          float* rp = (float*)(ws + WS_ROPE) + gt * 2; rp[0] = cosf(ang); rp[1] = sinf(ang); } }
}

constexpr int MOE2_STRIPS = 8 * 2 * (DFFE / 64), MOE2_ITEMS = 8 * (DFFE / 64) * (DM / 64);
__device__ __forceinline__ void moe2_convert(Frame& F, const Args& a, int wgslot, int nwgslots) {
    unsigned char* ws = KWS(); const int lane = lane_id_l();
    constexpr int S7 = DFFE / 64, I9 = (DFFE / 64) * (DM / 64);
    for (int st = wgslot; st < MOE2_STRIPS; st += nwgslots) {
        int r = st;
        if (r < 8 * S7) { const int l = 8 + r / S7; p0_quant_strip(F, KIN(I_MW1) + (size_t)l * DM * DFFE, DFFE, (unsigned char*)(ws + WS_MW13) + (size_t)l * 2 * DFFE * DM, (float*)(ws + WS_MW13S) + l * 2 * DFFE, 1, r % S7, lane); continue; } r -= 8 * S7;
        { const int l = 8 + r / S7; p0_quant_strip(F, KIN(I_MW3) + (size_t)l * DM * DFFE, DFFE, (unsigned char*)(ws + WS_MW13) + (size_t)l * 2 * DFFE * DM, (float*)(ws + WS_MW13S) + l * 2 * DFFE, 2, r % S7, lane); }
    }
    __syncthreads();
    const int sbase = MOE2_STRIPS / nwgslots, sextra = MOE2_STRIPS % nwgslots;
    const bool heavy_full = sextra > 0 && (sbase + 1) * 16 * nwgslots >= MOE2_STRIPS * 16 + MOE2_ITEMS;
    int k = wgslot, cnt = nwgslots;
    if (heavy_full) { if (wgslot < sextra) return; k = wgslot - sextra; cnt = nwgslots - sextra; }
    for (int J = k * NWAVES + F.wave; J < MOE2_ITEMS; J += cnt * NWAVES) { const int l = 8 + J / I9;
        p0_transpose8_item(KIN(I_MW2) + (size_t)l * DFFE * DM, DFFE, DM, (unsigned char*)(ws + WS_MW2) + (size_t)l * DM * DFFE, DFFE, 0, J % I9, lane); }
}

struct RowIO { const float* flat; const float* fctx; bf16* xr; int lat_f32, ctx_f32; };
template <bool COMBINE, bool ROUTER, bool FINAL>
__device__ __forceinline__ void norm_rows(Frame& F, const Args& a, int nrows, RowIO io, const float* ng, const float* modl, int seg_sh, int seg_sc,
                                          const float* modprev, const float* rw, const float* rb, float* fout, const float* part = nullptr, int nparts = 0) {
    unsigned char* ws = KWS();
    const int lane = lane_id_l(), tid = F.wave * 64 + lane; (void)tid; const int gw = F.vcu * NWAVES + F.wave, NGW = F.G * NWAVES;
    const int hl = lane & 31, hh = lane >> 5;
    bf16* XN = (bf16*)(ws + WS_XN); const bf16* Y = (const bf16*)(ws + WS_Y);
    LAS unsigned* cntL = (LAS unsigned*)(F.lds + RING_OFF);
    int tm = 0; if (COMBINE) { const int T = (int)ldu((const unsigned*)(ws + WS_SEG) + 7); const int nt_ = min(max(T - 128, 0), SL_TILES); tm = T - nt_; }
    LAS float* rwL = (LAS float*)(F.lds + RING_OFF + 4096);
    LAS float* GSl = (LAS float*)(F.lds + RING_OFF + 40960); LAS float* SHl = (LAS float*)(F.lds + RING_OFF + 53248); LAS float* G2l = (LAS float*)(F.lds + RING_OFF + 65536);
    v2u pre[5][8]; bool use_pre = false;
    if constexpr (!COMBINE && !FINAL) { if (io.lat_f32 == 0 && io.ctx_f32 == 0 && nrows <= 10 * NGW) { use_pre = true;
#pragma unroll
        for (int k = 0; k < 5; ++k) { const int p = gw + k * NGW; if (2 * p < nrows) { const bf16* s__ = io.xr + (size_t)(2 * p + hh) * DM;
#pragma unroll
            for (int j = 0; j < 8; ++j) pre[k][j] = *(const GAS v2u*)(s__ + 4 * hl + 128 * j); } } } }
    __syncthreads();
    for (int i = tid; i < 3 * DM; i += NWAVES * 64) { const int m_ = i >> 10, c_ = i & 1023;
        if (FINAL) { GSl[i] = ng[c_]; } else { GSl[i] = ng[c_] * (1.0f + modl[m_ * 6144 + seg_sc * DM + c_]); SHl[i] = modl[m_ * 6144 + seg_sh * DM + c_]; }
        if (COMBINE) G2l[i] = modprev[m_ * 6144 + 5 * DM + c_]; }
    __syncthreads();
    if (ROUTER) { __syncthreads(); if (tid < 64) cntL[tid] = 0u;
        for (int i = tid; i < DM * 8 / 4; i += NWAVES * 64) *(LAS f32x4*)(rwL + 4 * i) = *(const GAS f32x4*)(rw + 4 * i);
        __syncthreads(); }
    f32x4 vnf[8]; v2u vnh[8];
#define NR_LOAD(rr) do { const int r__ = (rr); const bool lat__ = r__ < M_LAT; const bool f32__ = lat__ ? (io.lat_f32 != 0) : (io.ctx_f32 != 0); \
        if (f32__) { const float* s__ = lat__ ? io.flat + (size_t)r__ * DM : io.fctx + (size_t)(r__ - M_LAT) * DM; \
            _Pragma("unroll") for (int j = 0; j < 8; ++j) vnf[j] = *(const GAS f32x4*)(s__ + 4 * hl + 128 * j); } \
        else { const bf16* s__ = io.xr + (size_t)r__ * DM; \
            _Pragma("unroll") for (int j = 0; j < 8; ++j) vnh[j] = *(const GAS v2u*)(s__ + 4 * hl + 128 * j); } } while (0)
#define NR_TAIL() \
        if (!COMBINE && !FINAL) { if (nparts > 0 && !lat) { \
            for (int s = 0; s < nparts; ++s) { \
_Pragma("unroll") \
                for (int j = 0; j < 8; ++j) v[j] = v[j] + *(const GAS f32x4*)(part + ((size_t)s * M_CTX + (r - M_LAT)) * DM + 4 * hl + 128 * j); } \
            bf16* dst = io.xr + (size_t)r * DM; \
_Pragma("unroll") \
            for (int j = 0; j < 8; ++j) { v2u o; o.x = pk2(v[j][0], v[j][1]); o.y = pk2(v[j][2], v[j][3]); *(GAS v2u*)(dst + 4 * hl + 128 * j) = o; } } } \
        float ss = 0.f; \
_Pragma("unroll") \
        for (int j = 0; j < 8; ++j) ss += (v[j][0] * v[j][0] + v[j][1] * v[j][1]) + (v[j][2] * v[j][2] + v[j][3] * v[j][3]); \
        ss += xshfl<1>(ss); ss += xshfl<2>(ss); ss += xshfl<4>(ss); ss += xshfl<8>(ss); ss += xshfl<16>(ss); \
        const float rstd = 1.0f / sqrtf(ss * (1.0f / DM) + EPS); \
        if (FINAL) { \
_Pragma("unroll") \
            for (int j = 0; j < 8; ++j) { const int c = 4 * hl + 128 * j; const f32x4 g = *(const LAS f32x4*)(GSl + c); *(GAS f32x4*)(fout + (size_t)r * DM + c) = v[j] * rstd * g; } \
            continue; \
        } \
        float lg[8]; \
        if (ROUTER) { \
_Pragma("unroll") \
            for (int e = 0; e < 8; ++e) lg[e] = 0.f; } \
        if constexpr (ROUTER) { \
_Pragma("unroll") \
            for (int j = 0; j < 8; ++j) { const int c = 4 * hl + 128 * j; \
                const f32x4 gs = *(const LAS f32x4*)(GSl + mrow * DM + c), s0 = *(const LAS f32x4*)(SHl + mrow * DM + c); \
                f32x4 h = v[j] * rstd * gs + s0; \
                v2u o; o.x = pk2(h[0], h[1]); o.y = pk2(h[2], h[3]); \
                *(GAS v2u*)(XN + (size_t)r * DM + c) = o; \
_Pragma("unroll") \
                for (int q = 0; q < 4; ++q) { const f32x4 wa = *(const LAS f32x4*)(rwL + (c + q) * 8), wb = *(const LAS f32x4*)(rwL + (c + q) * 8 + 4); \
                    lg[0] += h[q] * wa[0]; lg[1] += h[q] * wa[1]; lg[2] += h[q] * wa[2]; lg[3] += h[q] * wa[3]; \
                    lg[4] += h[q] * wb[0]; lg[5] += h[q] * wb[1]; lg[6] += h[q] * wb[2]; lg[7] += h[q] * wb[3]; } } \
        } else { \
        float mxh = 0.f; \
_Pragma("unroll") \
        for (int j = 0; j < 8; ++j) { const int c = 4 * hl + 128 * j; \
            const f32x4 gs = *(const LAS f32x4*)(GSl + mrow * DM + c), s0 = *(const LAS f32x4*)(SHl + mrow * DM + c); \
            const f32x4 h = v[j] * rstd * gs + s0; \
            mxh = __builtin_fmaxf(__builtin_fmaxf(mxh, __builtin_fmaxf(__builtin_fabsf(h[0]), __builtin_fabsf(h[1]))), __builtin_fmaxf(__builtin_fabsf(h[2]), __builtin_fabsf(h[3]))); } \
        mxh = __builtin_fmaxf(mxh, xshfl<1>(mxh)); mxh = __builtin_fmaxf(mxh, xshfl<2>(mxh)); mxh = __builtin_fmaxf(mxh, xshfl<4>(mxh)); mxh = __builtin_fmaxf(mxh, xshfl<8>(mxh)); mxh = __builtin_fmaxf(mxh, xshfl<16>(mxh)); \
        { const float qi = mxh > 0.f ? 127.0f / mxh : 0.f; unsigned char* XN8 = (unsigned char*)XN + (size_t)r * DM; \
_Pragma("unroll") \
          for (int j = 0; j < 8; ++j) { int c = 4 * hl + 128 * j; asm volatile("" : "+v"(c)); \
              const f32x4 gs = *(const LAS f32x4*)(GSl + mrow * DM + c), s0 = *(const LAS f32x4*)(SHl + mrow * DM + c); const f32x4 h = v[j] * rstd * gs + s0; \
              *(GAS unsigned*)(XN8 + c) = pk_i8(h[0] * qi, h[1] * qi, h[2] * qi, h[3] * qi); } \
          if (hl == 0) ((float*)(ws + WS_XNS))[r] = mxh * (1.0f / 127.0f); } \
        } \
        if (ROUTER) { \
_Pragma("unroll") \
            for (int e = 0; e < 8; ++e) { \
                lg[e] += xshfl<1>(lg[e]); lg[e] += xshfl<2>(lg[e]); lg[e] += xshfl<4>(lg[e]); lg[e] += xshfl<8>(lg[e]); lg[e] += xshfl<16>(lg[e]); \
                lg[e] += rb[e]; } \
            int e0 = 0; float v0 = lg[0]; \
_Pragma("unroll") \
            for (int e = 1; e < 8; ++e) if (lg[e] > v0) { v0 = lg[e]; e0 = e; } \
            int e1 = -1; float v1 = -INFINITY; \
_Pragma("unroll") \
            for (int e = 0; e < 8; ++e) if (e != e0 && lg[e] > v1) { v1 = lg[e]; e1 = e; } \
            const float p0 = 1.0f / (1.0f + __expf(v1 - v0)), p1 = 1.0f - p0; \
            if (hl == 0) { v4u o; o.x = (unsigned)e0 | ((unsigned)e1 << 8); o.y = __float_as_uint(p0); o.z = __float_as_uint(p1); o.w = 0u; \
                *(GAS v4u*)((unsigned*)(ws + WS_ROUTE) + 4 * r) = o; \
                __hip_atomic_fetch_add(cntL + F.wave * 8 + e0, 1u, __ATOMIC_RELAXED, __HIP_MEMORY_SCOPE_WORKGROUP); __hip_atomic_fetch_add(cntL + F.wave * 8 + e1, 1u, __ATOMIC_RELAXED, __HIP_MEMORY_SCOPE_WORKGROUP); } \
        }
    if (use_pre) {
#pragma unroll
        for (int k = 0; k < 5; ++k) { const int p = gw + k * NGW; if (2 * p >= nrows) continue;
            const int r = 2 * p + hh; const bool lat = r < M_LAT; const int mrow = lat ? (r >> 13) : 2;
            f32x4 v[8];
#pragma unroll
            for (int j = 0; j < 8; ++j) { v[j][0] = bflo(pre[k][j].x); v[j][1] = bfhi(pre[k][j].x); v[j][2] = bflo(pre[k][j].y); v[j][3] = bfhi(pre[k][j].y); }
            NR_TAIL()
        }
    } else {
    if (2 * gw < nrows) NR_LOAD(2 * gw + hh);
    for (int p = gw; 2 * p < nrows; p += NGW) {
        const int r = 2 * p + hh;
        const bool lat = r < M_LAT; const int mrow = lat ? (r >> 13) : 2;
        f32x4 v[8];
        if (lat ? (io.lat_f32 != 0) : (io.ctx_f32 != 0)) {
#pragma unroll
            for (int j = 0; j < 8; ++j) v[j] = vnf[j]; }
        else {
#pragma unroll
            for (int j = 0; j < 8; ++j) { v[j][0] = bflo(vnh[j].x); v[j][1] = bfhi(vnh[j].x); v[j][2] = bflo(vnh[j].y); v[j][3] = bfhi(vnh[j].y); } }
        if (2 * (p + NGW) < nrows) NR_LOAD(2 * (p + NGW) + hh);
        if (COMBINE) {
            const unsigned p0 = ldu((const unsigned*)(ws + WS_SLOT) + 2 * r), p1 = ldu((const unsigned*)(ws + WS_SLOT) + 2 * r + 1);
            const float w0 = ldf((const float*)(ws + WS_ROUTE) + 4 * r + 1), w1 = ldf((const float*)(ws + WS_ROUTE) + 4 * r + 2);
            const bool t0 = (int)(p0 >> 8) >= tm, t1 = (int)(p1 >> 8) >= tm;
            const bf16* SL = (const bf16*)(ws + WS_SL);
            v2u ya[8], yb[8];
#pragma unroll
            for (int j = 0; j < 8; ++j) { ya[j] = *(const GAS v2u*)(Y + (size_t)p0 * DM + 4 * hl + 128 * j); yb[j] = *(const GAS v2u*)(Y + (size_t)p1 * DM + 4 * hl + 128 * j); }
            f32x4 fa[8], fb[8];
#pragma unroll
            for (int j = 0; j < 8; ++j) { fa[j][0] = bflo(ya[j].x); fa[j][1] = bfhi(ya[j].x); fa[j][2] = bflo(ya[j].y); fa[j][3] = bfhi(ya[j].y);
                                          fb[j][0] = bflo(yb[j].x); fb[j][1] = bfhi(yb[j].x); fb[j][2] = bflo(yb[j].y); fb[j][3] = bfhi(yb[j].y); }
            if (t0) {
#pragma unroll
                for (int j = 0; j < 8; ++j) { fa[j] = (f32x4){0.f, 0.f, 0.f, 0.f};
                    for (int s = 0; s < SL_S; ++s) { const v2u y = *(const GAS v2u*)(SL + ((size_t)s * SL_TILES * 256 + (p0 - (unsigned)tm * 256u)) * DM + 4 * hl + 128 * j); fa[j][0] += bflo(y.x); fa[j][1] += bfhi(y.x); fa[j][2] += bflo(y.y); fa[j][3] += bfhi(y.y); } } }
            if (t1) {
#pragma unroll
                for (int j = 0; j < 8; ++j) { fb[j] = (f32x4){0.f, 0.f, 0.f, 0.f};
                    for (int s = 0; s < SL_S; ++s) { const v2u y = *(const GAS v2u*)(SL + ((size_t)s * SL_TILES * 256 + (p1 - (unsigned)tm * 256u)) * DM + 4 * hl + 128 * j); fb[j][0] += bflo(y.x); fb[j][1] += bfhi(y.x); fb[j][2] += bflo(y.y); fb[j][3] += bfhi(y.y); } } }
#pragma unroll
            for (int j = 0; j < 8; ++j) { const f32x4 g = *(const LAS f32x4*)(G2l + mrow * DM + 4 * hl + 128 * j);
                v[j] = v[j] + g * (fa[j] * w0 + fb[j] * w1); }
            if (!FINAL) { bf16* dst = io.xr + (size_t)r * DM;
#pragma unroll
                for (int j = 0; j < 8; ++j) { v2u o; o.x = pk2(v[j][0], v[j][1]); o.y = pk2(v[j][2], v[j][3]); *(GAS v2u*)(dst + 4 * hl + 128 * j) = o; } }
        }
        NR_TAIL()
    }
    }
    if (ROUTER) { __syncthreads(); if (tid < 64) ((unsigned*)(ws + WS_CNT))[F.vcu * 64 + tid] = cntL[tid]; __syncthreads(); }
#undef NR_LOAD
#undef NR_TAIL
}

__device__ __forceinline__ void moe_gather(Frame& F, const Args& a, int nrows) {
    unsigned char* ws = KWS();
    const int lane = lane_id_l(), tid = F.wave * 64 + lane; (void)tid; const int gw = F.vcu * NWAVES + F.wave, NGW = F.G * NWAVES;
    LAS unsigned* L = (LAS unsigned*)(F.lds + RING_OFF);
    __syncthreads();
    for (int i = tid; i < 208; i += NWAVES * 64) L[i] = 0u;
    __syncthreads();
    for (int idx = tid; idx < NGW * 8; idx += NWAVES * 64) { const unsigned v = ldu((const unsigned*)(ws + WS_CNT) + idx); const int g = idx >> 3, e = idx & 7;
        __hip_atomic_fetch_add(L + e, v, __ATOMIC_RELAXED, __HIP_MEMORY_SCOPE_WORKGROUP);
        if (g < F.vcu * NWAVES) __hip_atomic_fetch_add(L + 8 + e, v, __ATOMIC_RELAXED, __HIP_MEMORY_SCOPE_WORKGROUP);
        if ((g >> 3) == F.vcu) L[16 + (g & 7) * 8 + e] = v; }
    __syncthreads();
    if (tid == 0) { unsigned t0 = 0u;
        for (int e = 0; e < 8; ++e) { unsigned base = t0 * 256u + L[8 + e];
            for (int w = 0; w < NWAVES; ++w) { L[80 + w * 8 + e] = base; base += L[16 + w * 8 + e]; }
            t0 += (L[e] + 255u) >> 8; if (F.vcu == 0) ((unsigned*)(ws + WS_SEG))[e] = t0; } }
    __syncthreads();
    const bf16* XN = (const bf16*)(ws + WS_XN); bf16* XG = (bf16*)(ws + WS_XG);
    for (int r2 = 2 * gw; r2 < nrows; r2 += 2 * NGW) for (int r = r2; r < r2 + 2; ++r) {
        const unsigned ee = ldu((const unsigned*)(ws + WS_ROUTE) + 4 * r); const int e0 = ee & 0xff, e1 = (ee >> 8) & 0xff;
        unsigned p0 = 0u, p1 = 0u;
        if (lane == 0) { const unsigned c0 = L[144 + F.wave * 8 + e0], c1 = L[144 + F.wave * 8 + e1];
                         p0 = L[80 + F.wave * 8 + e0] + c0; p1 = L[80 + F.wave * 8 + e1] + c1; L[144 + F.wave * 8 + e0] = c0 + 1u; L[144 + F.wave * 8 + e1] = c1 + 1u;
                         v2u o; o.x = p0; o.y = p1; *(GAS v2u*)((unsigned*)(ws + WS_SLOT) + 2 * r) = o; }
        LDS_WAIT(); asm volatile("" ::: "memory");
        p0 = __builtin_amdgcn_readfirstlane(p0); p1 = __builtin_amdgcn_readfirstlane(p1);
        const v4u x0 = *(const GAS v4u*)(XN + (size_t)r * DM + 8 * lane), x1 = *(const GAS v4u*)(XN + (size_t)r * DM + 512 + 8 * lane);
        float f[16]; f[0] = bflo(x0.x); f[1] = bfhi(x0.x); f[2] = bflo(x0.y); f[3] = bfhi(x0.y); f[4] = bflo(x0.z); f[5] = bfhi(x0.z); f[6] = bflo(x0.w); f[7] = bfhi(x0.w);
        f[8] = bflo(x1.x); f[9] = bfhi(x1.x); f[10] = bflo(x1.y); f[11] = bfhi(x1.y); f[12] = bflo(x1.z); f[13] = bfhi(x1.z); f[14] = bflo(x1.w); f[15] = bfhi(x1.w);
        float mx = 0.f;
#pragma unroll
        for (int i = 0; i < 16; ++i) mx = __builtin_fmaxf(mx, __builtin_fabsf(f[i]));
        mx = __builtin_fmaxf(mx, xshfl<1>(mx)); mx = __builtin_fmaxf(mx, xshfl<2>(mx)); mx = __builtin_fmaxf(mx, xshfl<4>(mx)); mx = __builtin_fmaxf(mx, xshfl<8>(mx)); mx = __builtin_fmaxf(mx, xshfl<16>(mx)); mx = xmax32(mx);
        const float qi = mx > 0.f ? 127.0f / mx : 0.f;
        v2u y0, y1; y0.x = pk_i8(f[0] * qi, f[1] * qi, f[2] * qi, f[3] * qi); y0.y = pk_i8(f[4] * qi, f[5] * qi, f[6] * qi, f[7] * qi);
        y1.x = pk_i8(f[8] * qi, f[9] * qi, f[10] * qi, f[11] * qi); y1.y = pk_i8(f[12] * qi, f[13] * qi, f[14] * qi, f[15] * qi);
        unsigned char* XG8 = (unsigned char*)XG;
        *(GAS v2u*)(XG8 + (size_t)p0 * DM + 8 * lane) = y0; *(GAS v2u*)(XG8 + (size_t)p0 * DM + 512 + 8 * lane) = y1;
        *(GAS v2u*)(XG8 + (size_t)p1 * DM + 8 * lane) = y0; *(GAS v2u*)(XG8 + (size_t)p1 * DM + 512 + 8 * lane) = y1;
        if (lane == 0) { const float sc = mx * (1.0f / 127.0f); ((float*)(ws + WS_XGS))[p0] = sc; ((float*)(ws + WS_XGS))[p1] = sc; }
    }
    __syncthreads();
}

__device__ __forceinline__ void prep_rows(Frame& F, const Args& a, int layer) {
    unsigned char* ws = KWS();
    const int lane = lane_id_l(); const int gw = F.vcu * NWAVES + F.wave, NGW = F.G * NWAVES;
    const bf16* PX = (const bf16*)(ws + WS_PX); bf16* KA = (bf16*)(ws + WS_KA); bf16* YC = (bf16*)(ws + WS_YCAT);
    const float* rope = (const float*)(ws + WS_ROPE);
    const float* kg = KIN(I_KG) + layer * 64;
    v4u st0[6]; constexpr int PCH0 = 66, PHALO0 = 8, PPIECES0 = (PCH0 + 2 * PHALO0) * 32;
    { const int i8 = lane & 7, sub = lane >> 4, l16 = lane & 15;
      float gk[8];
#pragma unroll
      for (int j = 0; j < 8; ++j) gk[j] = kg[8 * i8 + j];
      if (F.vcu < 256) {
#pragma unroll
          for (int k = 0; k < 6; ++k) { const int pc = F.wave * 64 + lane + 512 * k; const int rr = min(max(F.vcu * PCH0 - PHALO0 + (pc >> 5), 0), M_ALL - 1);
              if (pc < PPIECES0) st0[k] = *(const GAS v4u*)(PX + (size_t)rr * PXW + C_CU + 8 * (pc & 31)); } }
      v4u rawp[3];
#pragma unroll
      for (int it = 0; it < 3; ++it) { const int r4 = 4 * gw + it * 4 * NGW; if (r4 < M_ALL) rawp[it] = *(const GAS v4u*)(PX + (size_t)(r4 + sub) * PXW + C_AK + 8 * l16); }
      int itn = 0;
      for (int r4 = 4 * gw; r4 < M_ALL; r4 += 4 * NGW, ++itn) {
          const int r = r4 + sub; const bool lat = r < M_LAT; const int s = lat ? (r & 8191) : ((r - M_LAT) & 255);
          v4u raw; if (itn == 0) raw = rawp[0]; else if (itn == 1) raw = rawp[1]; else if (itn == 2) raw = rawp[2]; else raw = *(const GAS v4u*)(PX + (size_t)r * PXW + C_AK + 8 * l16);
          float x[8]; x[0] = bflo(raw.x); x[1] = bfhi(raw.x); x[2] = bflo(raw.y); x[3] = bfhi(raw.y); x[4] = bflo(raw.z); x[5] = bfhi(raw.z); x[6] = bflo(raw.w); x[7] = bfhi(raw.w);
          float ss = 0.f;
#pragma unroll
          for (int j = 0; j < 8; ++j) ss += x[j] * x[j];
          ss += xshfl<1>(ss); ss += xshfl<2>(ss); ss += xshfl<4>(ss);
          const float rstd = 1.0f / sqrtf(ss * (1.0f / 64.0f) + EPS);
          const int pos = (i8 < 4) ? (s >> 6) : (s & 63);
          float y[8];
#pragma unroll
          for (int j = 0; j < 8; ++j) { y[j] = x[j] * rstd * gk[j]; const float o = xshfl<2>(y[j]);
              if (lat) { const int i = 8 * (i8 & 1) + j; const float cs = rope[(pos * 16 + i) * 2], sn = rope[(pos * 16 + i) * 2 + 1]; y[j] = (i8 & 2) ? (y[j] * cs + o * sn) : (y[j] * cs - o * sn); } }
          v4u o; o.x = pk2(y[0], y[1]); o.y = pk2(y[2], y[3]); o.z = pk2(y[4], y[5]); o.w = pk2(y[6], y[7]);
          *(GAS v4u*)(KA + (size_t)r * 128 + 8 * l16) = o;
          { v2u o8; o8.x = pk8(y[0], y[1], y[2], y[3]); o8.y = pk8(y[4], y[5], y[6], y[7]); *(GAS v2u*)((unsigned char*)(ws + WS_KA8) + (size_t)r * 128 + 8 * l16) = o8; }
      } }
    { LAS unsigned char* tl = F.lds + RING_OFF + 49152 + F.wave * 4096; unsigned char* VT8 = (unsigned char*)(ws + WS_VT8);
      for (int it = gw; it < 264 * 2; it += NGW) { const int T = it >> 1, kvh = it & 1;
          v4u xv[8];
#pragma unroll
          for (int i = 0; i < 8; ++i) xv[i] = *(const GAS v4u*)(PX + (size_t)(64 * T + 8 * i + (lane >> 3)) * PXW + C_AV + kvh * 64 + 8 * (lane & 7));
#pragma unroll
          for (int i = 0; i < 8; ++i) { const int k = 8 * i + (lane >> 3); const int pp = 32 * ((k >> 2) & 1) + 16 * (k >> 5) + 4 * ((k >> 3) & 3) + (k & 3);
              const unsigned w0 = pk8(8.f * bflo(xv[i].x), 8.f * bfhi(xv[i].x), 8.f * bflo(xv[i].y), 8.f * bfhi(xv[i].y)), w1 = pk8(8.f * bflo(xv[i].z), 8.f * bfhi(xv[i].z), 8.f * bflo(xv[i].w), 8.f * bfhi(xv[i].w));
              LAS unsigned char* q = tl + (8 * (lane & 7)) * 64 + pp;
              q[0] = (unsigned char)w0; q[64] = (unsigned char)(w0 >> 8); q[128] = (unsigned char)(w0 >> 16); q[192] = (unsigned char)(w0 >> 24);
              q[256] = (unsigned char)w1; q[320] = (unsigned char)(w1 >> 8); q[384] = (unsigned char)(w1 >> 16); q[448] = (unsigned char)(w1 >> 24); }
          LDS_WAIT(); asm volatile("" ::: "memory");
#pragma unroll
          for (int i = 0; i < 4; ++i) { const int d = 16 * i + (lane >> 2), ch = lane & 3; const v4u o = *(const LAS v4u*)(tl + d * 64 + ch * 16);
              *(GAS v4u*)(VT8 + ((size_t)it * 64 + d) * 64 + ch * 16) = o; }
          LDS_WAIT(); asm volatile("" ::: "memory"); } }
    { constexpr int PCH = 66, PHALO = 8, PROWS = PCH + 2 * PHALO, PPIECES = PROWS * 32; static_assert(PCH * 256 == M_ALL, "pool chunks");
      const int tid = F.wave * 64 + lane;
      for (int c = F.vcu; c < 256; c += F.G) {
          const int r0 = c * PCH;
          v4u st[6]; static_assert(PCH == PCH0 && PHALO == PHALO0, "prefetched chunk geometry");
#pragma unroll
          for (int k = 0; k < 6; ++k) { const int pc = tid + 512 * k; const int rr = min(max(r0 - PHALO + (pc >> 5), 0), M_ALL - 1);
              if (c == F.vcu) st[k] = st0[k]; else if (pc < PPIECES) st[k] = *(const GAS v4u*)(PX + (size_t)rr * PXW + C_CU + 8 * (pc & 31)); }
          __syncthreads();
#pragma unroll
          for (int k = 0; k < 6; ++k) { const int pc = tid + 512 * k; if (pc < PPIECES) *(LAS v4u*)(F.lds + RING_OFF + 16 * pc) = st[k]; }
          __syncthreads();
          for (int rl = F.wave; rl < PCH; rl += NWAVES) {
              const int r = r0 + rl; const bool lat = r < M_LAT; const int s = lat ? (r & 8191) : ((r - M_LAT) & 255);
              const int g = lane >> 4, w = 2 << g, N = lat ? SEQ : CTXL;
              const int lo = max(s - (w >> 1), 0), hi = min(s - (w >> 1) + w, N), cnt = hi - lo;
              LAS const unsigned char* pb = F.lds + RING_OFF + (rl + PHALO - s + lo) * 512 + 8 * lane;
              float s0 = 0.f, s1 = 0.f, s2 = 0.f, s3 = 0.f;
#pragma unroll
              for (int i = 0; i < 16; ++i) { if (i < cnt) { const v2u u = *(LAS const v2u*)(pb + i * 512); s0 += bflo(u.x); s1 += bfhi(u.x); s2 += bflo(u.y); s3 += bfhi(u.y); } }
              const v2u u = *(LAS const v2u*)(F.lds + RING_OFF + (rl + PHALO) * 512 + 8 * lane); const float inv = 1.0f / (float)cnt;
              v2u o; o.x = pk2(s0 * inv - bflo(u.x), s1 * inv - bfhi(u.x)); o.y = pk2(s2 * inv - bflo(u.y), s3 * inv - bfhi(u.y));
              *(GAS v2u*)(YC + (size_t)r * DM + 768 + 4 * lane) = o;
          }
      }
      __syncthreads(); }
}

#ifndef XTRA_BAR
#define XTRA_BAR 0
#endif
#ifndef GALIGN
#define GALIGN true
#endif
#ifndef GSP2
#define GSP2 true
#endif
#ifndef REPMASK
#define REPMASK 0
#endif
#ifndef PHMASK
#define PHMASK 0xfff
#endif
#ifndef NAIVE_ATTN
#define NAIVE_ATTN 0
#endif
#ifndef ATTN_PV
#define ATTN_PV 0
#endif
template <int PV> __device__ __forceinline__ void attn_phase_all(Frame& F, const Args& a, int layer, bool want_ctx, char* lds) {
    unsigned char* ws = KWS();
    typedef attn_body::bf16 abf;
    static_assert(AJ_QP == PXW, "attention q/k/v pitch");
    const abf* PX = (const abf*)(ws + WS_PX); const abf* KA = (const abf*)(ws + WS_KA); abf* YC = (abf*)(ws + WS_YCAT);
    const float* relb = KIN(I_RELB) + (size_t)layer * 4 * 15 * 31; const float* gq = KIN(I_QG) + layer * 64; const float* rope = (const float*)(ws + WS_ROPE);
    float mref; bool fixm, p8ok;
    { const int ln = lane_id_l(); float gqm = __builtin_fabsf(gq[ln]), gkm = __builtin_fabsf((KIN(I_KG) + layer * 64)[ln]);
      gqm = __builtin_fmaxf(gqm, xshfl<1>(gqm)); gqm = __builtin_fmaxf(gqm, xshfl<2>(gqm)); gqm = __builtin_fmaxf(gqm, xshfl<4>(gqm)); gqm = __builtin_fmaxf(gqm, xshfl<8>(gqm)); gqm = __builtin_fmaxf(gqm, xshfl<16>(gqm)); gqm = xmax32(gqm);
      gkm = __builtin_fmaxf(gkm, xshfl<1>(gkm)); gkm = __builtin_fmaxf(gkm, xshfl<2>(gkm)); gkm = __builtin_fmaxf(gkm, xshfl<4>(gkm)); gkm = __builtin_fmaxf(gkm, xshfl<8>(gkm)); gkm = __builtin_fmaxf(gkm, xshfl<16>(gkm)); gkm = xmax32(gkm);
      const float bnd = __uint_as_float(__builtin_amdgcn_readfirstlane(__float_as_uint(C2F * 64.0f * gqm * gkm)));
      mref = 1.02f * bnd; fixm = __builtin_amdgcn_readfirstlane((mref <= 30.0f && gqm <= 15.0f && gkm <= 50.0f) ? 1 : 0) != 0;
      p8ok = fixm && bnd <= 13.5f; if (p8ok) mref = 1.13f * bnd - 15.5f; }
    for (int ua = F.vcu; ua < 512; ua += F.G) {
        const int k = ua >> 8, x = (ua & 255) >> 5, i = ua & 31; const int bk = x >> 1, b = bk >> 1, kvh = bk & 1, h = kvh * 4 + (x & 1) * 2 + k;
        const size_t row = (size_t)b * SEQ + (size_t)i * 256;
        attn_body::AttnJob J; J.Q = PX + row * PXW + C_AQ + h * 64; J.K = KA + kvh * 64; J.V = PX + C_AV + kvh * 64;
        J.O = YC + row * 1024 + h * 64; J.base0 = b * SEQ; J.base1 = M_LAT + b * CTXL; J.r0 = 0; J.rlo = 0; J.bias = relb; J.qt0 = i * 256; J.gq = gq; J.rope = rope;
        J.K8 = (const unsigned char*)(ws + WS_KA8) + kvh * 64; J.VT8 = (const unsigned char*)(ws + WS_VT8) + kvh * 4096; J.mref = mref;
        if (p8ok) attn_body::attn_unit<8, 0, 8>(J, lds, F.wave); else if (fixm) attn_body::attn_unit<8, 0, 7>(J, lds, F.wave); else attn_body::attn_unit<8, 0, 0>(J, lds, F.wave);
    }
    for (int ub = F.vcu; ub < 256; ub += F.G) {
        const int b = ub >> 7, h = (ub >> 5) & 3, blk = ub & 31; const int r0 = 4 * blk, rlo = min(max(r0 - 4, 0), 116);
        const size_t row = (size_t)b * SEQ + (size_t)blk * 256;
        attn_body::AttnJob J; J.mref = 0.f; J.Q = PX + row * PXW + C_BQ + h * 64; J.K = PX + C_BK + h * 64; J.V = PX + C_BV + h * 64;
        J.O = YC + row * 1024 + 512 + h * 64; J.base0 = M_LAT + b * CTXL; J.base1 = b * SEQ + rlo * 64; J.r0 = r0; J.rlo = rlo; J.bias = relb + h * 15 * 31; J.qt0 = 0; J.gq = gq; J.rope = rope;
        attn_body::attn_unit<8, 1>(J, lds, F.wave);
    }
    if (want_ctx) {
        for (int uc = F.vcu; uc < 16; uc += F.G) { const int b = uc >> 3, h = uc & 7; const size_t row = (size_t)M_LAT + (size_t)b * CTXL;
            attn_body::AttnJob J; J.mref = 0.f; J.base0 = M_LAT + b * CTXL; J.base1 = 0; J.r0 = 0; J.rlo = 0; J.bias = relb; J.qt0 = 0; J.gq = gq; J.rope = rope;
            J.Q = PX + row * PXW + C_AQ + h * 64; J.K = KA + (h >> 2) * 64; J.V = PX + C_AV + (h >> 2) * 64; J.O = YC + row * 1024 + h * 64;
            attn_body::attn_unit<8, 2>(J, lds, F.wave); }
        for (int u2 = F.vcu; u2 < 24; u2 += F.G) if (u2 >= 16) { const int uc = u2 - 16, b = uc >> 2, h = uc & 3; const size_t row = (size_t)M_LAT + (size_t)b * CTXL;
            attn_body::AttnJob J; J.mref = 0.f; J.base0 = M_LAT + b * CTXL; J.base1 = 0; J.r0 = 0; J.rlo = 0; J.bias = relb; J.qt0 = 0; J.gq = gq; J.rope = rope;
            J.Q = PX + row * PXW + C_BQ + h * 64; J.K = PX + C_BK + h * 64; J.V = PX + C_BV + h * 64; J.O = YC + row * 1024 + 512 + h * 64;
            attn_body::attn_unit<8, 3>(J, lds, F.wave); }
    }
}

constexpr int PH_PER_LAYER = 10, PH_FINAL = 1 + DEPTH * PH_PER_LAYER, PH_COUNT = PH_FINAL + 1;
__global__ void __launch_bounds__(NWAVES * 64, 2) fwd(Args args) {
    extern __shared__ __attribute__((aligned(16))) unsigned char lds[];
    const int wave0 = __builtin_amdgcn_readfirstlane(threadIdx.x >> 6);
    for (int u = threadIdx.x; u < (LDS_BYTES - LDSCTL_OFF) / 4; u += NWAVES * 64) ((LAS unsigned*)((LAS unsigned char*)lds + LDSCTL_OFF))[u] = 0u;
    __syncthreads();
#define KARG_I(off) ((int)(unsigned)karg_u64(off))
#define SINGLE() (KARG_I(240) != 0)
    if (SINGLE()) { XcdBarrier b0 = xcd_barrier_post((unsigned*)(KWS() + WS_CTL) + CW_BAR, (volatile LAS unsigned*)((LAS unsigned char*)lds + MISC_OFF) + 8); (void)b0; }
#define SEAM() do { if (SINGLE()) { XcdBarrier b_; b_.bar = (unsigned*)(KWS() + WS_CTL) + CW_BAR; b_.x = xb_xcc_id(); b_.st = (volatile LAS unsigned*)((LAS unsigned char*)lds + MISC_OFF) + 8; b_.w = wave0; \
        asm volatile("" : "+s"(b_.bar), "+s"(b_.x)); xcd_barrier(b_); } } while (0)
#define IN(k) (KARG_I(232) <= (k) && (k) < (int)(karg_u64(232) >> 32))
#define MK_FRAME() Frame F; F.lds = (LAS unsigned char*)lds; F.MISC = (volatile LAS unsigned*)(F.lds + MISC_OFF); F.wave = wave0; F.G = (int)gridDim.x; \
        { int bxv = (int)blockIdx.x; asm volatile("" : "+s"(bxv), "+s"(F.wave), "+s"(F.G)); F.vcu = (F.G % 8 == 0) ? (bxv % 8) * (F.G / 8) + bxv / 8 : bxv; }
#define PHASE_VARS() int l = l_; asm volatile("" : "+s"(l)); unsigned char* const ws = KWS(); int bx = (int)blockIdx.x; asm volatile("" : "+s"(bx)); MK_FRAME(); \
        const bool want_ctx = l < DEPTH - 1; const int fi = l >> 1; const int nMt = want_ctx ? 66 : 64, nrows = want_ctx ? M_ALL : M_LAT; \
        const float* const MODl = (const float*)(ws + WS_MOD) + (size_t)l * 3 * 6144; bf16* const XR = (bf16*)(ws + WS_XR); \
        (void)bx; (void)fi; (void)nMt; (void)nrows; (void)MODl; (void)XR

    if (((PHMASK >> 10) & 1) && IN(0)) for (int rep_ = 0; rep_ < (((REPMASK >> 10) & 1) ? 2 : 1); ++rep_) { MK_FRAME(); p0_prologue(F, args); SEAM(); for (int xb_ = 0; xb_ < XTRA_BAR; ++xb_) SEAM(); }

    for (int l_ = 0; l_ < DEPTH; ++l_) {
        const int pb = 1 + l_ * PH_PER_LAYER;
        const bool moe = (l_ & 1) != 0;
        if (((PHMASK >> 0) & 1) && IN(pb + 0)) for (int rep_ = 0; rep_ < (((REPMASK >> 0) & 1) ? 2 : 1); ++rep_) { PHASE_VARS();
            RowIO io{KIN(I_X), KIN(I_CTX), XR, l == 0, l == 0};
            if (l == 2) norm_rows<true, false, false>(F, args, M_ALL, io, KIN(I_N1G) + l * DM, MODl, 0, 1, MODl - 3 * 6144, nullptr, nullptr, nullptr);
            else norm_rows<false, false, false>(F, args, M_ALL, io, KIN(I_N1G) + l * DM, MODl, 0, 1, nullptr, nullptr, nullptr, nullptr, (const float*)(ws + WS_PART), (l & 1) ? 11 : 0);
            SEAM();
        }
        if (((PHMASK >> 1) & 1) && IN(pb + 1)) for (int rep_ = 0; rep_ < (((REPMASK >> 1) & 1) ? 2 : 1); ++rep_) { PHASE_VARS();
            pg8::Gemm g{(const bf16*)(ws + WS_XN), (const bf16*)((const unsigned char*)(ws + WS_WIN) + (size_t)l * INC * DM), DM / 2, DM / 2, DM / 2}; pg8::StaticOrder S; S.init(66, INC / 256, F.G, bx);
            pg8::EpiInProjQ E{(bf16*)(ws + WS_PX), PXW, (bf16*)(ws + WS_GF), PXW / 256, (const float*)(ws + WS_XNS), (const float*)(ws + WS_WINS) + l * INC};
            pg8::gemm_phase<pg8::EpiInProjQ, pg8::StaticOrder, GALIGN, GSP2, false, true>(F.lds + RING_OFF, g, S, E, F.wave);
            SEAM();
        }
        if (((PHMASK >> 2) & 1) && IN(pb + 2)) for (int rep_ = 0; rep_ < (((REPMASK >> 2) & 1) ? 2 : 1); ++rep_) { PHASE_VARS(); prep_rows(F, args, l); SEAM(); }
        if (((PHMASK >> 3) & 1) && IN(pb + 3)) for (int rep_ = 0; rep_ < (((REPMASK >> 3) & 1) ? 2 : 1); ++rep_) { PHASE_VARS(); attn_phase_all<0>(F, args, l, want_ctx, (char*)lds + RING_OFF); SEAM(); }
        if (((PHMASK >> 4) & 1) && IN(pb + 4)) for (int rep_ = 0; rep_ < (((REPMASK >> 4) & 1) ? 2 : 1); ++rep_) { PHASE_VARS();
            const bf16* wc = (const bf16*)(ws + WS_WCAT) + (size_t)l * DM * DM; const bf16* YC = (const bf16*)(ws + WS_YCAT);
            bf16* MB = (bf16*)(ws + WS_MB);
            pg8::StaticOrder S; S.init(nMt, 4, F.G, bx);
            pg8::Gemm g{YC, wc, DM, DM, DM}; pg8::EpiMergeR E{(const bf16*)(ws + WS_GF), MB};
            pg8::gemm_phase<pg8::EpiMergeR, pg8::StaticOrder, GALIGN, GSP2>(F.lds + RING_OFF, g, S, E, F.wave);
            if (l < 3) {
                const int nidle = (nMt * 4 > F.G) ? 2 * F.G - nMt * 4 : 0;
                if (nidle > 0 && bx >= F.G - nidle) moe2_convert(F, args, l * nidle + (bx - (F.G - nidle)), 3 * nidle);
                else if (nidle == 0 && l == 0) moe2_convert(F, args, bx, F.G);
            }
            SEAM();
        }
        if (((PHMASK >> 5) & 1) && IN(pb + 5)) for (int rep_ = 0; rep_ < ((((REPMASK >> 5) & 1) && l_ == 0) ? 9 : 1); ++rep_) { PHASE_VARS();
            pg8::Gemm g{(const bf16*)(ws + WS_MB), (const bf16*)(ws + WS_WOUT) + (size_t)l * DM * DM, DM, DM, DM}; pg8::StaticOrder S; S.init(64, 4, F.G, bx);
            if (l == 0) { pg8::EpiResid<true> E{KIN(I_X), XR, MODl + 2 * DM}; pg8::gemm_phase<pg8::EpiResid<true>, pg8::StaticOrder, GALIGN, GSP2>(F.lds + RING_OFF, g, S, E, F.wave); }
            else { pg8::EpiResid<false> E{nullptr, XR, MODl + 2 * DM}; pg8::gemm_phase<pg8::EpiResid<false>, pg8::StaticOrder, GALIGN, GSP2>(F.lds + RING_OFF, g, S, E, F.wave); }
            if (want_ctx) {
                pg8::Gemm g2{(const bf16*)(ws + WS_MB), (const bf16*)(ws + WS_WOUT) + (size_t)l * DM * DM, 256, DM, DM}; pg8::SplitKOrder S2{4, 256, F.G, bx, 64};
                pg8::EpiPartial E2{(float*)(ws + WS_PART), MODl + 2 * 6144 + 2 * DM};
                pg8::gemm_phase<pg8::EpiPartial, pg8::SplitKOrder, GALIGN, GSP2>(F.lds + RING_OFF, g2, S2, E2, F.wave);
            }
            SEAM();
        }
        if (((PHMASK >> 6) & 1) && IN(pb + 6)) for (int rep_ = 0; rep_ < (((REPMASK >> 6) & 1) ? 2 : 1); ++rep_) { PHASE_VARS();
            RowIO io{KIN(I_X), KIN(I_CTX), XR, 0, l == 0};
            if (moe) norm_rows<false, true, false>(F, args, nrows, io, KIN(I_N2G) + l * DM, MODl, 3, 4, nullptr, KIN(I_RW) + (size_t)fi * DM * 8, KIN(I_RB) + fi * 8, nullptr, (const float*)(ws + WS_PART), want_ctx ? 4 : 0);
            else norm_rows<false, false, false>(F, args, nrows, io, KIN(I_N2G) + l * DM, MODl, 3, 4, nullptr, nullptr, nullptr, nullptr, (const float*)(ws + WS_PART), want_ctx ? 4 : 0);
            SEAM();
        }
        if (moe) {
            if (((PHMASK >> 7) & 1) && IN(pb + 7)) for (int rep_ = 0; rep_ < (((REPMASK >> 7) & 1) ? 2 : 1); ++rep_) { PHASE_VARS(); moe_gather(F, args, nrows); SEAM(); }
            if (((PHMASK >> 8) & 1) && IN(pb + 8)) for (int rep_ = 0; rep_ < (((REPMASK >> 13) & 1) ? 2 : 1); ++rep_) { PHASE_VARS();
                pg8::GroupedOrder S;
#pragma unroll
                for (int j = 0; j < 8; ++j) S.seg[j] = __builtin_amdgcn_readfirstlane((int)ldu((const unsigned*)(ws + WS_SEG) + j));
                S.so.init(S.seg[7], 2 * DFFE / 256, F.G, bx); S.estride = (long)2 * DFFE * DM;
                pg8::Gemm g{(const bf16*)(ws + WS_XG), (const bf16*)((const unsigned char*)(ws + WS_MW13) + (size_t)fi * NE * 2 * DFFE * DM), DM / 2, DM / 2, DM / 2};
                pg8::EpiSwiGLU8Q E{(unsigned char*)(ws + WS_H), DFFE, HSC8, (const float*)(ws + WS_XGS), (const float*)(ws + WS_MW13S) + (size_t)fi * NE * 2 * DFFE};
                pg8::gemm_phase<pg8::EpiSwiGLU8Q, pg8::GroupedOrder, GALIGN, GSP2, false, true>(F.lds + RING_OFF, g, S, E, F.wave);
                SEAM();
            }
            if (((PHMASK >> 9) & 1) && IN(pb + 9)) for (int rep_ = 0; rep_ < (((REPMASK >> 12) & 1) ? 2 : 1); ++rep_) { PHASE_VARS();
                pg8::GroupedOrder S;
#pragma unroll
                for (int j = 0; j < 8; ++j) S.seg[j] = __builtin_amdgcn_readfirstlane((int)ldu((const unsigned*)(ws + WS_SEG) + j));
                const int T = S.seg[7], ntail = min(max(T - 128, 0), SL_TILES), Tm = T - ntail;
                S.so.init(Tm, 4, F.G, bx); S.estride = (long)DM * DFFE;
                const bf16* w2p = (const bf16*)((const unsigned char*)(ws + WS_MW2) + (size_t)fi * NE * DM * DFFE);
                pg8::Gemm g{(const bf16*)(ws + WS_H), w2p, DFFE / 2, DFFE / 2, DFFE / 2, WSC8_E8M0, HSC8_E8M0};
                pg8::EpiBf16 E{(bf16*)(ws + WS_Y), DM};
                pg8::gemm_phase<pg8::EpiBf16, pg8::GroupedOrder, GALIGN, GSP2, true>(F.lds + RING_OFF, g, S, E, F.wave);
                { pg8::GroupedSplitKOrder S2; S2.S = SL_S; S2.Ks = DFFE / 2 / SL_S; S2.G = F.G; S2.c = bx; S2.pm0 = Tm; S2.ntail = ntail; S2.estride = (long)DM * DFFE;
#pragma unroll
                  for (int j = 0; j < 8; ++j) S2.seg[j] = S.seg[j];
                  pg8::Gemm g2{(const bf16*)(ws + WS_H), w2p, DFFE / 2 / SL_S, DFFE / 2, DFFE / 2, WSC8_E8M0, HSC8_E8M0};
                  pg8::EpiSlab E2{(bf16*)(ws + WS_SL), Tm, (long)SL_TILES * 256 * DM};
                  pg8::gemm_phase<pg8::EpiSlab, pg8::GroupedSplitKOrder, GALIGN, GSP2, true>(F.lds + RING_OFF, g2, S2, E2, F.wave); }
                SEAM();
            }
        } else {
            if (((PHMASK >> 8) & 1) && IN(pb + 8)) for (int rep_ = 0; rep_ < (((REPMASK >> 8) & 1) ? 2 : 1); ++rep_) { PHASE_VARS();
                pg8::Gemm g{(const bf16*)(ws + WS_XN), (const bf16*)((const unsigned char*)(ws + WS_W13) + (size_t)fi * 2 * DFF * DM), DM / 2, DM / 2, DM / 2}; pg8::StaticOrder S; S.init(nMt, 2 * DFF / 256, F.G, bx);
                pg8::EpiSwiGLUQ E{(bf16*)(ws + WS_H), DFF, (const float*)(ws + WS_XNS), (const float*)(ws + WS_W13S) + fi * 2 * DFF};
                pg8::gemm_phase<pg8::EpiSwiGLUQ, pg8::StaticOrder, GALIGN, GSP2, false, true>(F.lds + RING_OFF, g, S, E, F.wave);
                SEAM();
            }
            if (((PHMASK >> 9) & 1) && IN(pb + 9)) for (int rep_ = 0; rep_ < (((REPMASK >> 9) & 1) ? 2 : 1); ++rep_) { PHASE_VARS();
                pg8::Gemm g{(const bf16*)(ws + WS_H), (const bf16*)(ws + WS_W2) + (size_t)fi * DM * DFF, DFF, DFF, DFF}; pg8::StaticOrder S; S.init(64, 4, F.G, bx);
                pg8::EpiResid<false> E{nullptr, XR, MODl + 5 * DM};
                pg8::gemm_phase<pg8::EpiResid<false>, pg8::StaticOrder, GALIGN, GSP2>(F.lds + RING_OFF, g, S, E, F.wave);
                if (want_ctx) {
                    pg8::Gemm g2{(const bf16*)(ws + WS_H), (const bf16*)(ws + WS_W2) + (size_t)fi * DM * DFF, 256, DFF, DFF}; pg8::SplitKOrder S2{11, 256, F.G, bx, 64};
                    pg8::EpiPartial E2{(float*)(ws + WS_PART), MODl + 2 * 6144 + 5 * DM};
                    pg8::gemm_phase<pg8::EpiPartial, pg8::SplitKOrder, GALIGN, GSP2>(F.lds + RING_OFF, g2, S2, E2, F.wave);
                }
                SEAM();
            }
        }
    }
    if (((PHMASK >> 11) & 1) && IN(PH_FINAL)) {
        unsigned char* const ws = KWS(); MK_FRAME();
        RowIO io{KIN(I_X), KIN(I_CTX), (bf16*)(ws + WS_XR), 0, 0};
        norm_rows<true, false, true>(F, args, M_LAT, io, KIN(I_FING), nullptr, 0, 0, (const float*)(ws + WS_MOD) + (size_t)3 * 3 * 6144, nullptr, nullptr, KOUT());
    }
#undef IN
#undef SEAM
#undef PHASE_VARS
#undef MK_FRAME
}

#ifndef SINGLE_LAUNCH
#define SINGLE_LAUNCH 0
#endif
extern "C" void kernel_launch(void* const* d_in, const int* in_sizes, int n_in, void* d_out, int out_size, void* d_ws, size_t ws_size, hipStream_t stream) {
    static int grid = 0;
    if (grid == 0) {
        if (n_in != 27 || out_size != M_LAT * DM || ws_size < WS_END) { fprintf(stderr, "kernel_launch: unexpected shapes (n_in %d, out %d, ws %zu < %zu)\n", n_in, out_size, ws_size, (size_t)WS_END); grid = -1; return; }
        int dev = 0, cus = 0, per_cu = 0;
        if (hipGetDevice(&dev) != hipSuccess || hipDeviceGetAttribute(&cus, hipDeviceAttributeMultiprocessorCount, dev) != hipSuccess) { grid = -1; return; }
        if (hipFuncSetAttribute((const void*)fwd, hipFuncAttributeMaxDynamicSharedMemorySize, LDS_BYTES) != hipSuccess) { grid = -1; return; }
        if (hipOccupancyMaxActiveBlocksPerMultiprocessor(&per_cu, (const void*)fwd, NWAVES * 64, LDS_BYTES) != hipSuccess || per_cu < 1) { fprintf(stderr, "kernel_launch: occupancy query says %d\n", per_cu); }
        (void)hipGetLastError();
        grid = cus;
    }
    if (grid < 0) return;
    if (hipMemsetAsync((char*)d_ws + WS_CTL, 0, CTL_ZERO_BYTES, stream) != hipSuccess) return;
    Args a{};
    for (int i = 0; i < 27; ++i) a.in[i] = (const float*)d_in[i];
    a.out = (float*)d_out; a.ws = (unsigned char*)d_ws; a.pad = 0;
#if SINGLE_LAUNCH
    a.ph_lo = 0; a.ph_hi = PH_COUNT; a.single = 1;
    hipLaunchKernelGGL(fwd, dim3(grid), dim3(NWAVES * 64), LDS_BYTES, stream, a);
#else
    a.single = 0;
    for (int ph = 0; ph < PH_COUNT; ++ph) {
        if (ph >= 1 && ph < PH_FINAL) { const int l = (ph - 1) / PH_PER_LAYER, k = (ph - 1) % PH_PER_LAYER; if (k == 7 && !(l & 1)) continue; }
        a.ph_lo = ph; a.ph_hi = ph + 1;
        hipLaunchKernelGGL(fwd, dim3(grid), dim3(NWAVES * 64), LDS_BYTES, stream, a);
    }
#endif
}
```

```cpp
#include <hip/hip_runtime.h>
#include <hip/hip_bf16.h>
#include <cstdio>
#include <cstdint>
#include <cmath>
#define SINGLE_LAUNCH 1
namespace pg8 {
#define PG8_LAS __attribute__((address_space(3)))
typedef unsigned short bf16_t;
typedef short bf16x8 __attribute__((ext_vector_type(8)));
typedef float f32x4 __attribute__((ext_vector_type(4)));
typedef unsigned u32x4 __attribute__((ext_vector_type(4)));
constexpr int BM = 256, BK = 64, HALF = 128, HTB = HALF * BK * 2  , STAGE_BYTES = 8 * HTB, NXCD = 8, WGM = 4;

__host__ __device__ __forceinline__ int lds_byte(int r, int c) { const int st = (r >> 4) * 2 + (c >> 5), rr = r & 15, cc = c & 31, ob = rr * 64 + cc * 2; return st * 1024 + (ob ^ (((ob >> 9) & 1) << 5)); }
__host__ __device__ __forceinline__ void stage_rc(int b, int& R, int& C) { const int st = b / 1024, sb = b % 1024, swz = sb ^ (((sb >> 9) & 1) << 5); R = (st >> 1) * 16 + swz / 64; C = (st & 1) * 32 + (swz % 64) / 2; }
__host__ __device__ __forceinline__ int perm32(int rho) { const int n = rho >> 4, i = rho & 15; return 8 * (i >> 2) + 4 * n + (i & 3); }


struct Unit { int pm, pn, ks; long aofs, bofs; };
struct Gemm { const bf16_t* A; const bf16_t* Bt; int K, lda, ldb; int sw = 0x7F7F7F7F, sa = 0x7F7F7F7F; };

struct StaticOrder {
    int nM, nN, nwg, G, c;
    __device__ __forceinline__ void init(int nM_, int nN_, int G_, int c_) { nM = nM_; nN = nN_; nwg = nM * nN; G = G_; c = c_; }
    __device__ __forceinline__ bool next(int i, Unit& u) const {
        const long L = (long)i * G + c; if (L >= nwg) return false;
        int wgid = (int)L; { const int q = nwg / NXCD, r = nwg % NXCD, xcd = wgid % NXCD, off = wgid / NXCD; wgid = (xcd < r ? xcd * (q + 1) : r * (q + 1) + (xcd - r) * q) + off; }
        const int nig = WGM * nN, gid = wgid / nig, fm = gid * WGM, gsz = (nM - fm) < WGM ? (nM - fm) : WGM;
        u.pm = fm + ((wgid % nig) % gsz); u.pn = (wgid % nig) / gsz; u.ks = 0; u.aofs = 0; u.bofs = 0; return true;
    }
    __device__ __forceinline__ void a_ready(const Unit&) const {}
    __device__ __forceinline__ void done(const Unit&) const {}
};
struct SplitKOrder {
    int S, Ks, G, c, pm0;
    __device__ __forceinline__ bool next(int i, Unit& u) const {
        const int L = i * G + c; if (L >= 8 * S) return false;
        const int tile = L / S, s = L % S; u.pm = pm0 + (tile >> 2); u.pn = tile & 3; u.ks = s; u.aofs = (long)s * Ks * 2; u.bofs = (long)s * Ks * 2; return true;
    }
    __device__ __forceinline__ void a_ready(const Unit&) const {}
    __device__ __forceinline__ void done(const Unit&) const {}
};
struct GroupedSplitKOrder {
    int S, Ks, G, c, pm0, ntail; int seg[8]; long estride;
    __device__ __forceinline__ bool next(int i, Unit& u) const {
        const int L = i * G + c; if (L >= ntail * 4 * S) return false;
        const int tile = L / S, s = L % S; u.pm = pm0 + (tile >> 2); u.pn = tile & 3; u.ks = s; u.aofs = (long)s * Ks * 2;
        int e = 0;
#pragma unroll
        for (int j = 0; j < 7; ++j) e += (u.pm >= seg[j]) ? 1 : 0;
        u.bofs = (long)e * estride + (long)s * Ks * 2; return true;
    }
    __device__ __forceinline__ void a_ready(const Unit&) const {}
    __device__ __forceinline__ void done(const Unit&) const {}
};
struct GroupedOrder {
    StaticOrder so; int seg[8]; long estride;
    __device__ __forceinline__ bool next(int i, Unit& u) const {
        if (!so.next(i, u)) return false;
        int e = 0;
#pragma unroll
        for (int j = 0; j < 7; ++j) e += (u.pm >= seg[j]) ? 1 : 0;
        u.bofs = (long)e * estride; return true;
    }
    __device__ __forceinline__ void a_ready(const Unit&) const {}
    __device__ __forceinline__ void done(const Unit&) const {}
};

__device__ __forceinline__ unsigned cvt_pk_bf16(float lo, float hi) { unsigned r; asm volatile("v_cvt_pk_bf16_f32 %0, %1, %2" : "=v"(r) : "v"(lo), "v"(hi)); return r; }
typedef unsigned u32x2 __attribute__((ext_vector_type(2)));
__device__ __forceinline__ float bf_lo(unsigned w) { return __uint_as_float(w << 16); }
__device__ __forceinline__ float bf_hi(unsigned w) { return __uint_as_float(w & 0xffff0000u); }
__device__ __forceinline__ float sigmoidf_(float v) { return __builtin_amdgcn_rcpf(1.0f + __builtin_amdgcn_exp2f(-1.4426950408889634f * v)); }

struct EpiBf16 {
    static constexpr bool PERM = true, AFTER_DRAIN = false, MIDK = false;
    bf16_t* O; int ldc;
    __device__ __forceinline__ void operator()(const f32x4 (&acc)[2][2][4][2], const Unit& u, int wr, int wc, int fr, int fq) const {
        const int row0 = u.pm * BM + wr * 64 + fr; const int col0 = u.pn * BM + wc * 32 + 8 * fq;
#pragma unroll
        for (int ai = 0; ai < 2; ++ai)
#pragma unroll
            for (int m = 0; m < 4; ++m) { bf16_t* rowp = O + (size_t)(row0 + ai * HALF + m * 16) * ldc + col0;
#pragma unroll
                for (int bj = 0; bj < 2; ++bj) { const f32x4 v0 = acc[ai][bj][m][0], v1 = acc[ai][bj][m][1];
                    u32x4 w; w.x = cvt_pk_bf16(v0[0], v0[1]); w.y = cvt_pk_bf16(v0[2], v0[3]); w.z = cvt_pk_bf16(v1[0], v1[1]); w.w = cvt_pk_bf16(v1[2], v1[3]);
                    *(u32x4*)(rowp + bj * HALF) = w; } }
    }
};
struct EpiSwiGLU {
    static constexpr bool PERM = true, AFTER_DRAIN = false, MIDK = false;
    bf16_t* H; int ldc;
    __device__ __forceinline__ void operator()(const f32x4 (&acc)[2][2][4][2], const Unit& u, int wr, int wc, int fr, int fq) const {
        const int row0 = u.pm * BM + wr * 64 + fr; const int col0 = u.pn * (BM / 2) + wc * 32 + 8 * fq;
#pragma unroll
        for (int ai = 0; ai < 2; ++ai)
#pragma unroll
            for (int m = 0; m < 4; ++m) { bf16_t* rowp = H + (size_t)(row0 + ai * HALF + m * 16) * ldc + col0; float o[8];
#pragma unroll
                for (int n = 0; n < 2; ++n)
#pragma unroll
                    for (int j = 0; j < 4; ++j) { const float a = acc[ai][0][m][n][j], b = acc[ai][1][m][n][j]; o[4 * n + j] = a * sigmoidf_(a) * b; }
                u32x4 w; w.x = cvt_pk_bf16(o[0], o[1]); w.y = cvt_pk_bf16(o[2], o[3]); w.z = cvt_pk_bf16(o[4], o[5]); w.w = cvt_pk_bf16(o[6], o[7]);
                *(u32x4*)rowp = w;
                asm volatile("" ::: "memory"); }
    }
};
__device__ __forceinline__ unsigned pk_fp8x4(float a, float b, float c, float d) { unsigned w = 0u; w = __builtin_amdgcn_cvt_pk_fp8_f32(a, b, w, false); w = __builtin_amdgcn_cvt_pk_fp8_f32(c, d, w, true); return w; }
__device__ __forceinline__ float clamp448(float v) { return __builtin_fminf(__builtin_fmaxf(v, -448.f), 448.f); }
struct EpiSwiGLU8 {
    static constexpr bool PERM = true, AFTER_DRAIN = false, MIDK = false; static constexpr int NST = 8;
    unsigned char* H; int ldc; float hsc;
    __device__ __forceinline__ void operator()(const f32x4 (&acc)[2][2][4][2], const Unit& u, int wr, int wc, int fr, int fq) const {
        const int row0 = u.pm * BM + wr * 64 + fr; const int col0 = u.pn * (BM / 2) + wc * 32 + 8 * fq;
#pragma unroll
        for (int ai = 0; ai < 2; ++ai)
#pragma unroll
            for (int m = 0; m < 4; ++m) { unsigned char* rowp = H + (size_t)(row0 + ai * HALF + m * 16) * ldc + col0; float o[8];
#pragma unroll
                for (int n = 0; n < 2; ++n)
#pragma unroll
                    for (int j = 0; j < 4; ++j) { const float a = acc[ai][0][m][n][j], b = acc[ai][1][m][n][j]; o[4 * n + j] = clamp448(hsc * (a * sigmoidf_(a) * b)); }
                u32x2 w; w.x = pk_fp8x4(o[0], o[1], o[2], o[3]); w.y = pk_fp8x4(o[4], o[5], o[6], o[7]);
                *(u32x2*)rowp = w;
                asm volatile("" ::: "memory"); }
    }
};
struct EpiInProj {
    static constexpr bool PERM = true, AFTER_DRAIN = false, MIDK = false;
    bf16_t* O; int ldc; bf16_t* GF; int GT0;
    __device__ __forceinline__ void operator()(const f32x4 (&acc)[2][2][4][2], const Unit& u, int wr, int wc, int fr, int fq) const {
        if (u.pn < GT0) {
            const int row0 = u.pm * BM + wr * 64 + fr; const int col0 = u.pn * BM + wc * 32 + 8 * fq;
#pragma unroll
            for (int ai = 0; ai < 2; ++ai)
#pragma unroll
                for (int m = 0; m < 4; ++m) { bf16_t* rowp = O + (size_t)(row0 + ai * HALF + m * 16) * ldc + col0;
#pragma unroll
                    for (int bj = 0; bj < 2; ++bj) { const f32x4 v0 = acc[ai][bj][m][0], v1 = acc[ai][bj][m][1];
                        u32x4 w; w.x = cvt_pk_bf16(v0[0], v0[1]); w.y = cvt_pk_bf16(v0[2], v0[3]); w.z = cvt_pk_bf16(v1[0], v1[1]); w.w = cvt_pk_bf16(v1[2], v1[3]);
                        *(u32x4*)(rowp + bj * HALF) = w; } }
        } else {
            bf16_t* gb = GF + ((size_t)(u.pm * 12 + (u.pn - GT0)) * 128 + (size_t)(wr * 4 + wc) * 16) * 512 + (fq * 16 + fr) * 8;
#pragma unroll
            for (int ai = 0; ai < 2; ++ai)
#pragma unroll
                for (int m = 0; m < 4; ++m)
#pragma unroll
                    for (int bj = 0; bj < 2; ++bj) { const f32x4 v0 = acc[ai][bj][m][0], v1 = acc[ai][bj][m][1];
                        u32x4 w; w.x = cvt_pk_bf16(v0[0], v0[1]); w.y = cvt_pk_bf16(v0[2], v0[3]); w.z = cvt_pk_bf16(v1[0], v1[1]); w.w = cvt_pk_bf16(v1[2], v1[3]);
                        *(u32x4*)(gb + ((ai * 4 + m) * 2 + bj) * 512) = w; }
        }
    }
};
__device__ __forceinline__ float i2f(float bits) { return (float)__builtin_bit_cast(int, bits); }
typedef int v4i_e __attribute__((ext_vector_type(4)));
__device__ __forceinline__ f32x4 i2f4(f32x4 bits) { return __builtin_convertvector(__builtin_bit_cast(v4i_e, bits), f32x4); }
__device__ __forceinline__ f32x4 swiglu4(f32x4 ap, f32x4 bp) { f32x4 r;
#pragma unroll
    for (int j = 0; j < 4; ++j) r[j] = (ap[j] * bp[j]) * __builtin_amdgcn_rcpf(1.0f + __builtin_amdgcn_exp2f(ap[j]));
    return r; }
#define PG8_QSCALES(rs_, cs_, row0_, colb_) float rsv[2][4]; f32x4 csv[2][2]; \
    _Pragma("unroll") for (int ai = 0; ai < 2; ++ai) _Pragma("unroll") for (int m = 0; m < 4; ++m) rsv[ai][m] = (rs_)[(row0_) + ai * HALF + m * 16]; \
    _Pragma("unroll") for (int bj = 0; bj < 2; ++bj) { csv[bj][0] = *(const f32x4*)((cs_) + (colb_) + bj * HALF); csv[bj][1] = *(const f32x4*)((cs_) + (colb_) + bj * HALF + 4); }
struct EpiSwiGLUQ {
    static constexpr bool PERM = true, AFTER_DRAIN = false, MIDK = false;
    bf16_t* H; int ldc; const float* rs; const float* cs;
    __device__ __forceinline__ void operator()(const f32x4 (&acc)[2][2][4][2], const Unit& u, int wr, int wc, int fr, int fq) const {
        const int row0 = u.pm * BM + wr * 64 + fr; const int col0 = u.pn * (BM / 2) + wc * 32 + 8 * fq; const int colb = u.pn * BM + wc * 32 + 8 * fq;
        PG8_QSCALES(rs, cs, row0, colb)
        csv[0][0] = csv[0][0] * -1.4426950408889634f; csv[0][1] = csv[0][1] * -1.4426950408889634f; csv[1][0] = csv[1][0] * -0.6931471805599453f; csv[1][1] = csv[1][1] * -0.6931471805599453f;
#pragma unroll
        for (int ai = 0; ai < 2; ++ai)
#pragma unroll
            for (int m = 0; m < 4; ++m) { bf16_t* rowp = H + (size_t)(row0 + ai * HALF + m * 16) * ldc + col0; float o[8];
#pragma unroll
                for (int n = 0; n < 2; ++n) { const f32x4 r = swiglu4(i2f4(acc[ai][0][m][n]) * rsv[ai][m] * csv[0][n], i2f4(acc[ai][1][m][n]) * rsv[ai][m] * csv[1][n]);
                    o[4 * n] = r[0]; o[4 * n + 1] = r[1]; o[4 * n + 2] = r[2]; o[4 * n + 3] = r[3]; }
                u32x4 w; w.x = cvt_pk_bf16(o[0], o[1]); w.y = cvt_pk_bf16(o[2], o[3]); w.z = cvt_pk_bf16(o[4], o[5]); w.w = cvt_pk_bf16(o[6], o[7]);
                *(u32x4*)rowp = w;
                asm volatile("" ::: "memory"); }
    }
};
struct EpiSwiGLU8Q {
    static constexpr bool PERM = true, AFTER_DRAIN = false, MIDK = false;
    unsigned char* H; int ldc; float hsc; const float* rs; const float* cs;
    __device__ __forceinline__ void operator()(const f32x4 (&acc)[2][2][4][2], const Unit& u, int wr, int wc, int fr, int fq) const {
        const int row0 = u.pm * BM + wr * 64 + fr; const int col0 = u.pn * (BM / 2) + wc * 32 + 8 * fq; const int colb = (int)(u.bofs >> 10) + u.pn * BM + wc * 32 + 8 * fq;
        PG8_QSCALES(rs, cs, row0, colb)
        { const float k3 = -0.6931471805599453f * hsc; csv[0][0] = csv[0][0] * -1.4426950408889634f; csv[0][1] = csv[0][1] * -1.4426950408889634f; csv[1][0] = csv[1][0] * k3; csv[1][1] = csv[1][1] * k3; }
#pragma unroll
        for (int ai = 0; ai < 2; ++ai)
#pragma unroll
            for (int m = 0; m < 4; ++m) { unsigned char* rowp = H + (size_t)(row0 + ai * HALF + m * 16) * ldc + col0; float o[8];
#pragma unroll
                for (int n = 0; n < 2; ++n) { const f32x4 r = swiglu4(i2f4(acc[ai][0][m][n]) * rsv[ai][m] * csv[0][n], i2f4(acc[ai][1][m][n]) * rsv[ai][m] * csv[1][n]);
#pragma unroll
                    for (int j = 0; j < 4; ++j) o[4 * n + j] = __builtin_amdgcn_fmed3f(r[j], -448.f, 448.f); }
                u32x2 w; w.x = pk_fp8x4(o[0], o[1], o[2], o[3]); w.y = pk_fp8x4(o[4], o[5], o[6], o[7]);
                *(u32x2*)rowp = w;
                asm volatile("" ::: "memory"); }
    }
};
struct EpiInProjQ {
    static constexpr bool PERM = true, AFTER_DRAIN = false, MIDK = false;
    bf16_t* O; int ldc; bf16_t* GF; int GT0; const float* rs; const float* cs;
    __device__ __forceinline__ void operator()(const f32x4 (&acc)[2][2][4][2], const Unit& u, int wr, int wc, int fr, int fq) const {
        const int row0 = u.pm * BM + wr * 64 + fr; const int col0 = u.pn * BM + wc * 32 + 8 * fq;
        PG8_QSCALES(rs, cs, row0, col0)
        if (u.pn < GT0) {
#pragma unroll
            for (int ai = 0; ai < 2; ++ai)
#pragma unroll
                for (int m = 0; m < 4; ++m) { bf16_t* rowp = O + (size_t)(row0 + ai * HALF + m * 16) * ldc + col0;
#pragma unroll
                    for (int bj = 0; bj < 2; ++bj) { const f32x4 a0 = acc[ai][bj][m][0], a1 = acc[ai][bj][m][1]; f32x4 v0, v1;
#pragma unroll
                        for (int j = 0; j < 1; ++j) { v0 = i2f4(a0) * rsv[ai][m] * csv[bj][0]; v1 = i2f4(a1) * rsv[ai][m] * csv[bj][1]; }
                        u32x4 w; w.x = cvt_pk_bf16(v0[0], v0[1]); w.y = cvt_pk_bf16(v0[2], v0[3]); w.z = cvt_pk_bf16(v1[0], v1[1]); w.w = cvt_pk_bf16(v1[2], v1[3]);
                        *(u32x4*)(rowp + bj * HALF) = w; } }
        } else {
            f32x4 gsv[2][2];
#pragma unroll
            for (int bj = 0; bj < 2; ++bj) { gsv[bj][0] = csv[bj][0] * -1.4426950408889634f; gsv[bj][1] = csv[bj][1] * -1.4426950408889634f; }
            unsigned char* gb8 = (unsigned char*)GF + ((size_t)(u.pm * 12 + (u.pn - GT0)) * 128 + (size_t)(wr * 4 + wc) * 16) * 512 + (fq * 16 + fr) * 8;
#pragma unroll
            for (int ai = 0; ai < 2; ++ai)
#pragma unroll
                for (int m = 0; m < 4; ++m)
#pragma unroll
                    for (int bj = 0; bj < 2; ++bj) { const f32x4 a0 = acc[ai][bj][m][0], a1 = acc[ai][bj][m][1]; f32x4 v0, v1;
                        v0 = i2f4(a0) * rsv[ai][m] * gsv[bj][0]; v1 = i2f4(a1) * rsv[ai][m] * gsv[bj][1];
                        u32x2 w; w.x = 0u; w.y = 0u;
#pragma unroll
                        for (int j = 0; j < 4; ++j) {
                            const float q0 = __builtin_fmaxf(__builtin_rintf(255.0f * __builtin_amdgcn_rcpf(1.0f + __builtin_amdgcn_exp2f(__builtin_amdgcn_fmed3f(v0[j], -72.134752f, 72.134752f)))), 1.0f);
                            const float q1 = __builtin_fmaxf(__builtin_rintf(255.0f * __builtin_amdgcn_rcpf(1.0f + __builtin_amdgcn_exp2f(__builtin_amdgcn_fmed3f(v1[j], -72.134752f, 72.134752f)))), 1.0f);
                            w.x = __builtin_amdgcn_cvt_pk_u8_f32(q0, j, w.x); w.y = __builtin_amdgcn_cvt_pk_u8_f32(q1, j, w.y); }
                        *(u32x2*)(gb8 + ((ai * 4 + m) * 2 + bj) * 512) = w; }
        }
    }
};
template <bool F32B> struct EpiResid {
    static constexpr bool PERM = true, AFTER_DRAIN = false, MIDK = false;
    const float* basef; bf16_t* xr; const float* gate;
    __device__ __forceinline__ void operator()(const f32x4 (&acc)[2][2][4][2], const Unit& u, int wr, int wc, int fr, int fq) const {
        const int col0 = u.pn * BM + wc * 32 + 8 * fq; const float* gp = gate + (u.pm >> 5) * 6144 + col0;
        f32x4 gv[2][2];
#pragma unroll
        for (int bj = 0; bj < 2; ++bj)
#pragma unroll
            for (int n = 0; n < 2; ++n) gv[bj][n] = *(const f32x4*)(gp + bj * HALF + 4 * n);
        u32x4 bw[2][4][2];
        if (!F32B) {
#pragma unroll
            for (int ai = 0; ai < 2; ++ai)
#pragma unroll
                for (int m = 0; m < 4; ++m)
#pragma unroll
                    for (int bj = 0; bj < 2; ++bj) bw[ai][m][bj] = *(const u32x4*)(xr + (size_t)(u.pm * BM + wr * 64 + fr + ai * HALF + m * 16) * 1024 + col0 + bj * HALF);
            asm volatile("" ::: "memory"); }
#pragma unroll
        for (int ai = 0; ai < 2; ++ai) {
#pragma unroll
            for (int m = 0; m < 4; ++m) { const size_t off = (size_t)(u.pm * BM + wr * 64 + fr + ai * HALF + m * 16) * 1024 + col0;
#pragma unroll
                for (int bj = 0; bj < 2; ++bj) { f32x4 b0, b1;
                    if (F32B) { b0 = *(const f32x4*)(basef + off + bj * HALF); b1 = *(const f32x4*)(basef + off + bj * HALF + 4); }
                    else { const u32x4 w = bw[ai][m][bj]; b0[0] = bf_lo(w.x); b0[1] = bf_hi(w.x); b0[2] = bf_lo(w.y); b0[3] = bf_hi(w.y); b1[0] = bf_lo(w.z); b1[1] = bf_hi(w.z); b1[2] = bf_lo(w.w); b1[3] = bf_hi(w.w); }
                    const f32x4 v0 = b0 + gv[bj][0] * acc[ai][bj][m][0], v1 = b1 + gv[bj][1] * acc[ai][bj][m][1];
                    u32x4 o; o.x = cvt_pk_bf16(v0[0], v0[1]); o.y = cvt_pk_bf16(v0[2], v0[3]); o.z = cvt_pk_bf16(v1[0], v1[1]); o.w = cvt_pk_bf16(v1[2], v1[3]);
                    *(u32x4*)(xr + off + bj * HALF) = o; } }
            asm volatile("" ::: "memory"); }
    }
};
struct EpiSlab {
    static constexpr bool PERM = true, AFTER_DRAIN = false, MIDK = false;
    bf16_t* SL; int pm0; long sstride;
    __device__ __forceinline__ void operator()(const f32x4 (&acc)[2][2][4][2], const Unit& u, int wr, int wc, int fr, int fq) const {
        bf16_t* O = SL + (size_t)u.ks * sstride + (size_t)(u.pm - pm0) * BM * 1024;
        const int row0 = wr * 64 + fr; const int col0 = u.pn * BM + wc * 32 + 8 * fq;
#pragma unroll
        for (int ai = 0; ai < 2; ++ai)
#pragma unroll
            for (int m = 0; m < 4; ++m) { bf16_t* rowp = O + (size_t)(row0 + ai * HALF + m * 16) * 1024 + col0;
#pragma unroll
                for (int bj = 0; bj < 2; ++bj) { const f32x4 v0 = acc[ai][bj][m][0], v1 = acc[ai][bj][m][1];
                    u32x4 w; w.x = cvt_pk_bf16(v0[0], v0[1]); w.y = cvt_pk_bf16(v0[2], v0[3]); w.z = cvt_pk_bf16(v1[0], v1[1]); w.w = cvt_pk_bf16(v1[2], v1[3]);
                    *(u32x4*)(rowp + bj * HALF) = w; } }
    }
};
struct EpiPartial {
    static constexpr bool PERM = false, AFTER_DRAIN = false, MIDK = false;
    float* P; const float* gate;
    __device__ __forceinline__ void operator()(const f32x4 (&acc)[2][2][4][2], const Unit& u, int wr, int wc, int fr, int fq) const {
        const int col0 = u.pn * BM + wc * 32 + 4 * fq; float* os = P + ((size_t)u.ks * 512 + (size_t)(u.pm - 64) * BM) * 1024;
        f32x4 gv[2][2];
#pragma unroll
        for (int bj = 0; bj < 2; ++bj)
#pragma unroll
            for (int n = 0; n < 2; ++n) gv[bj][n] = *(const f32x4*)(gate + col0 + bj * HALF + n * 16);
#pragma unroll
        for (int ai = 0; ai < 2; ++ai)
#pragma unroll
            for (int m = 0; m < 4; ++m) { const size_t off = (size_t)(wr * 64 + fr + ai * HALF + m * 16) * 1024 + col0;
#pragma unroll
                for (int bj = 0; bj < 2; ++bj)
#pragma unroll
                    for (int n = 0; n < 2; ++n) *(f32x4*)(os + off + bj * HALF + n * 16) = gv[bj][n] * acc[ai][bj][m][n]; }
    }
};
struct EpiMergeR {
    static constexpr bool PERM = true, AFTER_DRAIN = false, MIDK = true;
    const bf16_t* GF; bf16_t* mb;
    static __device__ __forceinline__ float en(float g) { g = __builtin_fminf(__builtin_fmaxf(g, -50.f), 50.f); return __builtin_amdgcn_exp2f(-1.4426950408889634f * g); }
    static __device__ __forceinline__ float ratio(float q0, float q1) { return q0 * __builtin_amdgcn_rcpf(q1); }
    static __device__ __forceinline__ float ub(unsigned w, int k) { return (float)((w >> (8 * k)) & 0xffu); }
    __device__ __forceinline__ void mid(f32x4 (&acc)[2][2][4][2], const Unit& u, int t, int wr, int wc, int fr, int fq) const {
        const unsigned char* g0p = (const unsigned char*)GF + ((size_t)(u.pm * 12 + (t == 8 ? 0 : 4) + u.pn) * 128 + (size_t)(wr * 4 + wc) * 16) * 512 + (fq * 16 + fr) * 8;
        const unsigned char* g1p = g0p + (size_t)4 * 128 * 512;
        u32x2 g0[2][4][2], g1[2][4][2];
#pragma unroll
        for (int ai = 0; ai < 2; ++ai)
#pragma unroll
            for (int m = 0; m < 4; ++m)
#pragma unroll
                for (int bj = 0; bj < 2; ++bj) { g0[ai][m][bj] = *(const u32x2*)(g0p + ((ai * 4 + m) * 2 + bj) * 512); g1[ai][m][bj] = *(const u32x2*)(g1p + ((ai * 4 + m) * 2 + bj) * 512); }
#pragma unroll
        for (int ai = 0; ai < 2; ++ai)
#pragma unroll
            for (int m = 0; m < 4; ++m)
#pragma unroll
                for (int bj = 0; bj < 2; ++bj) { const u32x2 a = g0[ai][m][bj], b = g1[ai][m][bj]; f32x4 r0, r1;
#pragma unroll
                    for (int j = 0; j < 4; ++j) { r0[j] = ratio(ub(a.x, j), ub(b.x, j)); r1[j] = ratio(ub(a.y, j), ub(b.y, j)); }
                    acc[ai][bj][m][0] = acc[ai][bj][m][0] * r0; acc[ai][bj][m][1] = acc[ai][bj][m][1] * r1; }
        asm volatile("" ::: "memory");
    }
    __device__ __forceinline__ void operator()(const f32x4 (&acc)[2][2][4][2], const Unit& u, int wr, int wc, int fr, int fq) const {
        const unsigned char* gp = (const unsigned char*)GF + ((size_t)(u.pm * 12 + 8 + u.pn) * 128 + (size_t)(wr * 4 + wc) * 16) * 512 + (fq * 16 + fr) * 8;
        const int row0 = u.pm * BM + wr * 64 + fr; const int col0 = u.pn * BM + wc * 32 + 8 * fq;
        u32x2 gwa[2][4][2];
#pragma unroll
        for (int ai = 0; ai < 2; ++ai)
#pragma unroll
            for (int m = 0; m < 4; ++m)
#pragma unroll
                for (int bj = 0; bj < 2; ++bj) gwa[ai][m][bj] = *(const u32x2*)(gp + ((ai * 4 + m) * 2 + bj) * 512);
#pragma unroll
        for (int ai = 0; ai < 2; ++ai) {
#pragma unroll
            for (int m = 0; m < 4; ++m) { bf16_t* rowp = mb + (size_t)(row0 + ai * HALF + m * 16) * 1024 + col0;
#pragma unroll
                for (int bj = 0; bj < 2; ++bj) { const u32x2 g = gwa[ai][m][bj]; const f32x4 v0 = acc[ai][bj][m][0], v1 = acc[ai][bj][m][1]; float o[8];
#pragma unroll
                    for (int j = 0; j < 4; ++j) { o[j] = v0[j] * (ub(g.x, j) * (1.0f / 255.0f)); o[4 + j] = v1[j] * (ub(g.y, j) * (1.0f / 255.0f)); }
                    u32x4 w; w.x = cvt_pk_bf16(o[0], o[1]); w.y = cvt_pk_bf16(o[2], o[3]); w.z = cvt_pk_bf16(o[4], o[5]); w.w = cvt_pk_bf16(o[6], o[7]);
                    *(u32x4*)(rowp + bj * HALF) = w; } }
            asm volatile("" ::: "memory"); }
    }
};

typedef int v8i_t __attribute__((ext_vector_type(8)));
typedef int v4i_t __attribute__((ext_vector_type(4)));
__device__ __forceinline__ v8i_t cat8(bf16x8 lo, bf16x8 hi) { const v4i_t a = __builtin_bit_cast(v4i_t, lo), b = __builtin_bit_cast(v4i_t, hi); return __builtin_shufflevector(a, b, 0, 1, 2, 3, 4, 5, 6, 7); }
template <class Epi, class Sched, bool ALIGN_EPI = false, bool SP2 = false, bool FP8 = false, bool I8 = false>
__device__ __forceinline__ void gemm_phase(PG8_LAS unsigned char* lds, const Gemm g, const Sched& S, const Epi& E, const int wave_id) {
    int tid_; asm volatile("v_mbcnt_lo_u32_b32 %0, -1, 0\n\tv_mbcnt_hi_u32_b32 %0, -1, %0" : "=v"(tid_)); tid_ += wave_id * 64;
    const int tid = tid_, wid = __builtin_amdgcn_readfirstlane(tid >> 6), lane = tid & 63, wr = wid >> 2, wc = wid & 3, fr = lane & 15, fq = lane >> 4;
    const int K = g.K, nt = K / BK;
    unsigned voffA[2], voffB[2];
#pragma unroll
    for (int i = 0; i < 2; ++i) { int R, C; stage_rc(tid * 16 + i * 8192, R, C); const int Rb = Epi::PERM ? ((R & ~31) + perm32(R & 31)) : R;
        voffA[i] = (unsigned)(R * g.lda + C) * 2u; voffB[i] = (unsigned)(Rb * g.ldb + C) * 2u; }
    const size_t kstep = (size_t)(BK * 2);
    const size_t hstepA = (size_t)HALF * g.lda * 2, hstepB = (size_t)HALF * g.ldb * 2;
    const size_t tstepA = 2 * hstepA, tstepB = 2 * hstepB;
    const unsigned ldsw = (unsigned)wid * 1024u;
    const int aoff = lds_byte(wr * 64 + fr, fq * 8), boff = lds_byte(wc * 32 + fr, fq * 8);
#define PG8_SA(b, h) (((b) * 2 + (h)) * HTB)
#define PG8_SB(b, h) ((4 + (b) * 2 + (h)) * HTB)
#define PG8_STAGE(bufoff, gbase, voff) do { _Pragma("unroll") for (int _i = 0; _i < 2; ++_i) \
        __builtin_amdgcn_global_load_lds((const unsigned*)((const char*)(gbase) + (voff)[_i]), (PG8_LAS unsigned*)(lds + (bufoff) + ldsw + _i * 8192), 16, 0, 0); } while (0)
#define PG8_LDA(dst, b, h) do { if constexpr (FP8) { _Pragma("unroll") for (int m = 0; m < 4; ++m) { const v4i_t lo_ = *(const PG8_LAS v4i_t*)(lds + PG8_SA(b, h) + aoff + m * 2048), hi_ = *(const PG8_LAS v4i_t*)(lds + PG8_SA(b, h) + aoff + m * 2048 + 1024); dst##8[m] = __builtin_shufflevector(lo_, hi_, 0, 1, 2, 3, 4, 5, 6, 7); } } \
        else { _Pragma("unroll") for (int m = 0; m < 4; ++m) _Pragma("unroll") for (int k = 0; k < 2; ++k) dst[m][k] = *(const PG8_LAS bf16x8*)(lds + PG8_SA(b, h) + aoff + m * 2048 + k * 1024); } } while (0)
#define PG8_LDB(dst, b, h) do { if constexpr (FP8) { _Pragma("unroll") for (int n = 0; n < 2; ++n) { const v4i_t lo_ = *(const PG8_LAS v4i_t*)(lds + PG8_SB(b, h) + boff + n * 2048), hi_ = *(const PG8_LAS v4i_t*)(lds + PG8_SB(b, h) + boff + n * 2048 + 1024); dst##8[n] = __builtin_shufflevector(lo_, hi_, 0, 1, 2, 3, 4, 5, 6, 7); } } \
        else { _Pragma("unroll") for (int n = 0; n < 2; ++n) _Pragma("unroll") for (int k = 0; k < 2; ++k) dst[n][k] = *(const PG8_LAS bf16x8*)(lds + PG8_SB(b, h) + boff + n * 2048 + k * 1024); } } while (0)
#define PG8_MMA(ai, bj, At, Bt) do { if constexpr (FP8) __builtin_amdgcn_sched_barrier(0); __builtin_amdgcn_s_setprio(1); _Pragma("unroll") for (int m = 0; m < 4; ++m) _Pragma("unroll") for (int n = 0; n < 2; ++n) { \
        if constexpr (FP8) { asm volatile("s_nop 1\n\tv_mfma_scale_f32_16x16x128_f8f6f4 %0, %1, %2, %0, %3, %4 op_sel_hi:[0,0,0]" : "+v"(acc[ai][bj][m][n]) : "v"(Bt##8[n]), "v"(At##8[m]), "v"(sw_), "v"(sa_)); } \
        else if constexpr (I8) { _Pragma("unroll") for (int k = 0; k < 2; ++k) acc[ai][bj][m][n] = __builtin_bit_cast(f32x4, __builtin_amdgcn_mfma_i32_16x16x64_i8(__builtin_bit_cast(v4i_t, Bt[n][k]), __builtin_bit_cast(v4i_t, At[m][k]), __builtin_bit_cast(v4i_t, acc[ai][bj][m][n]), 0, 0, 0)); } \
        else { _Pragma("unroll") for (int k = 0; k < 2; ++k) acc[ai][bj][m][n] = __builtin_amdgcn_mfma_f32_16x16x32_bf16(Bt[n][k], At[m][k], acc[ai][bj][m][n], 0, 0, 0); } } \
        __builtin_amdgcn_s_setprio(0); if constexpr (FP8) __builtin_amdgcn_sched_barrier(0); } while (0)
#define PG8_WAIT_V(n) asm volatile("s_waitcnt vmcnt(" #n ")" ::: "memory")
#define PG8_WAIT_L(n) asm volatile("s_waitcnt lgkmcnt(" #n ")" ::: "memory")
#define PG8_BAR __builtin_amdgcn_s_barrier()
#define PG8_SCHED __builtin_amdgcn_sched_barrier(0)
    Unit cur, nxt; int ui = 0;
    if (!S.next(0, cur)) return;
    f32x4 acc[2][2][4][2];
#pragma unroll
    for (int a = 0; a < 2; ++a)
#pragma unroll
        for (int b = 0; b < 2; ++b)
#pragma unroll
            for (int m = 0; m < 4; ++m)
#pragma unroll
                for (int n = 0; n < 2; ++n) acc[a][b][m][n] = (f32x4){0.f, 0.f, 0.f, 0.f};
    int sw_ = g.sw, sa_ = g.sa; asm volatile("" : "+s"(sw_), "+s"(sa_)); (void)sw_; (void)sa_;
    bf16x8 At[4][2], B0[2][2], B1[2][2]; v8i_t At8[4], B08[2], B18[2];
    const char* cA = (const char*)g.A + cur.aofs + (size_t)cur.pm * tstepA; const char* cB = (const char*)g.Bt + cur.bofs + (size_t)cur.pn * tstepB;
    S.a_ready(cur);
    if constexpr (SP2) {
        PG8_STAGE(PG8_SB(0, 0), cB, voffB); PG8_STAGE(PG8_SB(0, 1), cB + hstepB, voffB); PG8_STAGE(PG8_SA(0, 0), cA, voffA); PG8_STAGE(PG8_SA(0, 1), cA + hstepA, voffA);
        if (wr == 1) PG8_BAR;
        PG8_WAIT_V(2); PG8_BAR;
        PG8_STAGE(PG8_SB(1, 0), cB + kstep, voffB); PG8_STAGE(PG8_SA(1, 0), cA + kstep, voffA); PG8_STAGE(PG8_SB(1, 1), cB + hstepB + kstep, voffB);
        PG8_WAIT_V(6); PG8_BAR;
    } else {
        PG8_STAGE(PG8_SB(0, 0), cB, voffB); PG8_STAGE(PG8_SA(0, 0), cA, voffA); PG8_STAGE(PG8_SB(0, 1), cB + hstepB, voffB); PG8_STAGE(PG8_SA(0, 1), cA + hstepA, voffA);
        if (wr == 1) PG8_BAR;
        PG8_WAIT_V(4); PG8_BAR;
        PG8_STAGE(PG8_SB(1, 0), cB + kstep, voffB); PG8_STAGE(PG8_SA(1, 0), cA + kstep, voffA); PG8_STAGE(PG8_SB(1, 1), cB + hstepB + kstep, voffB);
        PG8_WAIT_V(6); PG8_BAR;
    }
    for (;;) {
        const bool has_next = S.next(ui + 1, nxt);
        const char* nA = has_next ? (const char*)g.A + nxt.aofs + (size_t)nxt.pm * tstepA : cA; const char* nB = has_next ? (const char*)g.Bt + nxt.bofs + (size_t)nxt.pn * tstepB : cB;
        for (int t = 0; t < nt; t += 2) {
            if constexpr (Epi::MIDK) { if (t == 8 || t == 12) { int ln_; asm volatile("v_mbcnt_lo_u32_b32 %0, -1, 0\n\tv_mbcnt_hi_u32_b32 %0, -1, %0" : "=v"(ln_)); E.mid(acc, cur, t, wr, wc, ln_ & 15, ln_ >> 4); } }
            const bool last = (t == nt - 2);
            const char* a1 = cA + (size_t)(t + 1) * kstep;
            const char* a2 = last ? nA : cA + (size_t)(t + 2) * kstep; const char* b2 = last ? nB : cB + (size_t)(t + 2) * kstep;
            const char* a3 = a2 + kstep; const char* b3 = b2 + kstep;
            if (last && has_next) S.a_ready(nxt);
            if constexpr (SP2) {
            PG8_LDB(B0, 0, 0); PG8_LDB(B1, 0, 1); PG8_SCHED; PG8_LDA(At, 0, 0); PG8_STAGE(PG8_SA(1, 1), a1 + hstepA, voffA);
            PG8_WAIT_V(8); PG8_WAIT_L(0); PG8_BAR; PG8_MMA(0, 0, At, B0); PG8_MMA(0, 1, At, B1); PG8_BAR; PG8_SCHED;
            PG8_LDA(At, 0, 1); PG8_STAGE(PG8_SB(0, 0), b2, voffB); PG8_STAGE(PG8_SB(0, 1), b2 + hstepB, voffB); PG8_STAGE(PG8_SA(0, 0), a2, voffA);
            PG8_WAIT_V(8); PG8_WAIT_L(0); PG8_BAR; PG8_MMA(1, 0, At, B0); PG8_MMA(1, 1, At, B1); PG8_BAR; PG8_SCHED;
            PG8_LDB(B0, 1, 0); PG8_LDB(B1, 1, 1); PG8_SCHED; PG8_LDA(At, 1, 0); PG8_STAGE(PG8_SA(0, 1), a2 + hstepA, voffA);
            PG8_WAIT_V(8); PG8_WAIT_L(0); PG8_BAR; PG8_MMA(0, 0, At, B0); PG8_MMA(0, 1, At, B1); PG8_BAR; PG8_SCHED;
            PG8_LDA(At, 1, 1); PG8_STAGE(PG8_SB(1, 0), b3, voffB); PG8_STAGE(PG8_SB(1, 1), b3 + hstepB, voffB); PG8_STAGE(PG8_SA(1, 0), a3, voffA);
            PG8_WAIT_V(8); PG8_WAIT_L(0); PG8_BAR; PG8_MMA(1, 0, At, B0); PG8_MMA(1, 1, At, B1); PG8_BAR; PG8_SCHED;
            } else {
            PG8_LDB(B0, 0, 0); PG8_SCHED; PG8_LDA(At, 0, 0); PG8_STAGE(PG8_SA(1, 1), a1 + hstepA, voffA);
            PG8_WAIT_L(8); PG8_BAR; PG8_WAIT_L(0); PG8_MMA(0, 0, At, B0); PG8_BAR; PG8_SCHED;
            PG8_LDB(B1, 0, 1); PG8_STAGE(PG8_SB(0, 0), b2, voffB);
            PG8_BAR; PG8_WAIT_L(0); PG8_MMA(0, 1, At, B1); PG8_BAR;
            PG8_LDA(At, 0, 1); PG8_STAGE(PG8_SA(0, 0), a2, voffA);
            PG8_BAR; PG8_WAIT_L(0); PG8_MMA(1, 0, At, B0); PG8_BAR; PG8_SCHED;
            PG8_STAGE(PG8_SB(0, 1), b2 + hstepB, voffB);
            PG8_WAIT_V(6); PG8_BAR; PG8_MMA(1, 1, At, B1); PG8_BAR;
            PG8_LDB(B0, 1, 0); PG8_SCHED; PG8_LDA(At, 1, 0); PG8_STAGE(PG8_SA(0, 1), a2 + hstepA, voffA);
            PG8_WAIT_L(8); PG8_BAR; PG8_WAIT_L(0); PG8_MMA(0, 0, At, B0); PG8_BAR; PG8_SCHED;
            PG8_LDB(B1, 1, 1); PG8_STAGE(PG8_SB(1, 0), b3, voffB);
            PG8_BAR; PG8_WAIT_L(0); PG8_MMA(0, 1, At, B1); PG8_BAR;
            PG8_LDA(At, 1, 1); PG8_STAGE(PG8_SA(1, 0), a3, voffA);
            PG8_BAR; PG8_WAIT_L(0); PG8_MMA(1, 0, At, B0); PG8_BAR; PG8_SCHED;
            PG8_STAGE(PG8_SB(1, 1), b3 + hstepB, voffB);
            PG8_WAIT_V(6); PG8_BAR; PG8_MMA(1, 1, At, B1); PG8_BAR;
            }
        }
        if constexpr (ALIGN_EPI) { if (wr == 0) PG8_BAR; }
        if constexpr (FP8) { asm volatile("s_nop 15\n\ts_nop 15" ::: "memory"); }
        if constexpr (!Epi::AFTER_DRAIN) { int ln_; asm volatile("v_mbcnt_lo_u32_b32 %0, -1, 0\n\tv_mbcnt_hi_u32_b32 %0, -1, %0" : "=v"(ln_)); const int fr_ = ln_ & 15, fq_ = ln_ >> 4;
            E(acc, cur, wr, wc, fr_, fq_); S.done(cur); }
        if (!has_next) break;
#pragma unroll
        for (int a = 0; a < 2; ++a)
#pragma unroll
            for (int b = 0; b < 2; ++b)
#pragma unroll
                for (int m = 0; m < 4; ++m)
#pragma unroll
                    for (int n = 0; n < 2; ++n) acc[a][b][m][n] = (f32x4){0.f, 0.f, 0.f, 0.f};
        cur = nxt; cA = nA; cB = nB; ++ui;
        if constexpr (ALIGN_EPI) { if (wr == 1) PG8_BAR; }
    }
    PG8_WAIT_V(0);
    if constexpr (!ALIGN_EPI) { if (wr == 0) PG8_BAR; }
    PG8_BAR;
    if constexpr (Epi::AFTER_DRAIN) { E.fused(acc, cur, wr, wc, fr, fq, lds, wid, lane); S.done(cur); }
#undef PG8_SA
#undef PG8_SB
#undef PG8_STAGE
#undef PG8_LDA
#undef PG8_LDB
#undef PG8_MMA
#undef PG8_WAIT_V
#undef PG8_WAIT_L
#undef PG8_BAR
#undef PG8_SCHED
}
}
#ifndef ATTN_NEWPIPE
#define ATTN_NEWPIPE 1
#endif
#ifndef ATTN_QK8
#define ATTN_QK8 1
#endif
namespace attn_body {
using bf16=__hip_bfloat16;
using bf16x8=__attribute__((ext_vector_type(8)))short;
using s16x4=__attribute__((ext_vector_type(4)))short;
using f32x16=__attribute__((ext_vector_type(16)))float;
using u32x4=__attribute__((ext_vector_type(4)))unsigned;
constexpr int D=64;
constexpr int NW=8,QBLK=32,QB=QBLK*NW,KVBLK=64;
constexpr int ATTN_UNIT_ROWS=QB;
__device__ __forceinline__ int crow(int r,int hi){return (r&3)+8*(r>>2)+4*hi;}
#define SBAR() __builtin_amdgcn_sched_barrier(0)
constexpr int NSLOT=3, SLOTB=8192;
constexpr int LDS_K=0, LDS_V=NSLOT*SLOTB, LDS_WS=2*NSLOT*SLOTB, LDS_OST=LDS_WS+NW*64*4, LDS_BYTES=LDS_OST+NW*4096;
constexpr float C2=0.125f*1.4426950408889634f;
__device__ __forceinline__ void glds16(const void*gsrc,unsigned lds_dst){unsigned keep;
  asm volatile("s_mov_b32 %0, m0\n\ts_mov_b32 m0, %2\n\ts_nop 0\n\tglobal_load_lds_dwordx4 %1, off\n\ts_mov_b32 m0, %0":"=&s"(keep):"v"(gsrc),"s"(lds_dst):"memory");}
__device__ __forceinline__ void glds16h(const void*gsrc,unsigned lds_dst){unsigned keep; unsigned long long ex;
  asm volatile("s_mov_b64 %1, exec\n\ts_mov_b64 exec, 0xffffffff\n\ts_mov_b32 %0, m0\n\ts_mov_b32 m0, %3\n\ts_nop 0\n\tglobal_load_lds_dwordx4 %2, off\n\ts_mov_b32 m0, %0\n\ts_mov_b64 exec, %1":"=&s"(keep),"=&s"(ex):"v"(gsrc),"s"(lds_dst):"memory");}
__device__ __forceinline__ float max3f(float a,float b,float c){float r;asm("v_max3_f32 %0, %1, %2, %3":"=v"(r):"v"(a),"v"(b),"v"(c));return r;}
__device__ __forceinline__ float max2f(float a,float b){float r;asm("v_max_f32_e32 %0, %1, %2":"=v"(r):"v"(a),"v"(b));return r;}
__device__ __forceinline__ float fadd_s(float a,float b){float r;asm("v_add_f32_e32 %0, %1, %2":"=v"(r):"v"(a),"v"(b));return r;}
__device__ __forceinline__ float fsub_s(float a,float b){float r;asm("v_sub_f32_e32 %0, %1, %2":"=v"(r):"v"(a),"v"(b));return r;}
typedef float f32x2_t __attribute__((ext_vector_type(2))); typedef __bf16 bf16x2_t __attribute__((ext_vector_type(2)));
__device__ __forceinline__ unsigned cvtpk_s(float lo,float hi){f32x2_t v={lo,hi};bf16x2_t b=__builtin_convertvector(v,bf16x2_t);return __builtin_bit_cast(unsigned,b);}
#define WAIT_BAR(N) asm volatile("s_waitcnt vmcnt(" #N ") lgkmcnt(0)\n\ts_barrier":::"memory")

__device__ __forceinline__ void qkt(f32x16&p0,f32x16&p1,const char*Kslot,const bf16x8*qr,const f32x16&negm,int r32,int hi){
  const char*kb=Kslot+hi*1024+r32*16;
  #pragma unroll
  for(int d0=0;d0<4;++d0){
    const bf16x8 b0=*reinterpret_cast<const bf16x8*>(kb+d0*2048);
    const bf16x8 b1=*reinterpret_cast<const bf16x8*>(kb+d0*2048+512);
    if(d0==0){p0=__builtin_amdgcn_mfma_f32_32x32x16_bf16(b0,qr[0],negm,0,0,0);p1=__builtin_amdgcn_mfma_f32_32x32x16_bf16(b1,qr[0],negm,0,0,0);}
    else{p0=__builtin_amdgcn_mfma_f32_32x32x16_bf16(b0,qr[d0],p0,0,0,0);p1=__builtin_amdgcn_mfma_f32_32x32x16_bf16(b1,qr[d0],p1,0,0,0);}}
}
typedef __attribute__((address_space(3))) const char* lds_cptr;
typedef short v4i16_t __attribute__((ext_vector_type(4)));
__device__ __forceinline__ void kload8(bf16x8*kf,lds_cptr kp){
  kf[0]=*(const __attribute__((address_space(3))) bf16x8*)(kp);      kf[1]=*(const __attribute__((address_space(3))) bf16x8*)(kp+512);
  kf[2]=*(const __attribute__((address_space(3))) bf16x8*)(kp+2048); kf[3]=*(const __attribute__((address_space(3))) bf16x8*)(kp+2560);
  kf[4]=*(const __attribute__((address_space(3))) bf16x8*)(kp+4096); kf[5]=*(const __attribute__((address_space(3))) bf16x8*)(kp+4608);
  kf[6]=*(const __attribute__((address_space(3))) bf16x8*)(kp+6144); kf[7]=*(const __attribute__((address_space(3))) bf16x8*)(kp+6656);
}
__device__ __forceinline__ void kload2(bf16x8*kf,lds_cptr kp,int j){ kf[2*j]=*(const __attribute__((address_space(3))) bf16x8*)(kp+j*2048); kf[2*j+1]=*(const __attribute__((address_space(3))) bf16x8*)(kp+j*2048+512); }
__device__ __forceinline__ s16x4 vtr(lds_cptr p){ return __builtin_bit_cast(s16x4,__builtin_amdgcn_ds_read_tr16_b64_v4i16((__attribute__((address_space(3))) v4i16_t*)p)); }
__device__ __forceinline__ float rowmax(const f32x16&p0,const f32x16&p1){
  float a=max3f(p0[0],p0[1],p1[0]),b=max3f(p0[2],p0[3],p1[1]);a=max3f(a,p1[2],p1[3]);
  #pragma unroll
  for(int r=4;r<16;r+=4){a=max3f(a,p0[r],p0[r+1]);b=max3f(b,p0[r+2],p0[r+3]);a=max3f(a,p1[r],p1[r+1]);b=max3f(b,p1[r+2],p1[r+3]);}
  const float m=max2f(a,b);
  auto rr=__builtin_amdgcn_permlane32_swap(__float_as_uint(m),__float_as_uint(m),false,false);
  return max2f(__uint_as_float(rr[0]),__uint_as_float(rr[1]));
}
__device__ __forceinline__ void pv(f32x16*o,int vb,bf16x8 pa0,bf16x8 pa1,bf16x8 pa2,bf16x8 pa3){
  #pragma unroll
  for(int d0=0;d0<2;++d0){s16x4 lo[4],hi[4];
    #pragma unroll
    for(int ks=0;ks<4;++ks){
      asm volatile("ds_read_b64_tr_b16 %0,%1 offset:%c2":"=&v"(lo[ks]):"v"(vb),"i"(d0*4096+ks*1024):"memory");
      asm volatile("ds_read_b64_tr_b16 %0,%1 offset:%c2":"=&v"(hi[ks]):"v"(vb),"i"(d0*4096+ks*1024+512):"memory");}
    asm volatile("s_waitcnt lgkmcnt(0)":::"memory");SBAR();
    #define PK(k) (bf16x8){lo[k][0],lo[k][1],lo[k][2],lo[k][3],hi[k][0],hi[k][1],hi[k][2],hi[k][3]}
    o[d0]=__builtin_amdgcn_mfma_f32_32x32x16_bf16(pa0,PK(0),o[d0],0,0,0);
    o[d0]=__builtin_amdgcn_mfma_f32_32x32x16_bf16(pa1,PK(1),o[d0],0,0,0);
    o[d0]=__builtin_amdgcn_mfma_f32_32x32x16_bf16(pa2,PK(2),o[d0],0,0,0);
    o[d0]=__builtin_amdgcn_mfma_f32_32x32x16_bf16(pa3,PK(3),o[d0],0,0,0);
    #undef PK
  }
}


#ifndef AJ_QP
#define AJ_QP 1792
#endif
struct AttnJob { const bf16* Q; const bf16* K; const bf16* V; bf16* O; int base0, base1; int r0, rlo; const float* bias;
  int qt0; const float* gq; const float* rope; float mref; const unsigned char* K8; const unsigned char* VT8; };
__device__ __forceinline__ float bfl_(unsigned w){return __uint_as_float(w<<16);} __device__ __forceinline__ float bfh_(unsigned w){return __uint_as_float(w&0xffff0000u);}
constexpr int LDS_BTAB=LDS_BYTES, BTAB_BYTES=15*128*4, LDS_BYTES_ALL=LDS_BTAB+BTAB_BYTES;
typedef __attribute__((address_space(3))) const float* lds_fptr;
__device__ __forceinline__ void bmask(f32x16&p0,f32x16&p1,int w,int rlo,int qr,int rs,int cs,int hi,lds_fptr tp0){
  const float NEG=-INFINITY; const int kr=rlo+w;
  if(kr<rs||kr>rs+7){
    #pragma unroll
    for(int r=0;r<16;++r){p0[r]=NEG;p1[r]=NEG;}
  } else {
    const lds_fptr tp=tp0+(kr-qr+7)*128;
    #pragma unroll
    for(int r=0;r<16;++r){ const int kc0=(r&3)+8*(r>>2); const int kc=kc0+4*hi; const float b0=tp[kc0],b1=tp[kc0+32];
      p0[r]=((unsigned)(kc-cs)<16u)?p0[r]+b0:NEG; p1[r]=((unsigned)(kc+32-cs)<16u)?p1[r]+b1:NEG; }
  }
}
#ifndef ATTN_STORE16
#define ATTN_STORE16(p,v) (*(u32x4*)(p)=(v))
#endif
typedef int v8i_a __attribute__((ext_vector_type(8))); typedef int v4i_a __attribute__((ext_vector_type(4)));
__device__ __forceinline__ unsigned pk8a(float a,float b,float c,float d){ a=__builtin_fminf(__builtin_fmaxf(a,-448.f),448.f); b=__builtin_fminf(__builtin_fmaxf(b,-448.f),448.f); c=__builtin_fminf(__builtin_fmaxf(c,-448.f),448.f); d=__builtin_fminf(__builtin_fmaxf(d,-448.f),448.f);
  unsigned w=0u; w=__builtin_amdgcn_cvt_pk_fp8_f32(a,b,w,false); w=__builtin_amdgcn_cvt_pk_fp8_f32(c,d,w,true); return w; }
__device__ __forceinline__ int pkb8(float a,float b,float c,float d){ int w; asm volatile("":"=v"(w)); w=__builtin_amdgcn_cvt_pk_bf8_f32(a,b,w,false); w=__builtin_amdgcn_cvt_pk_bf8_f32(c,d,w,true); return w; }
template<int THRL,int KIND,int PV=0> __device__ __forceinline__ void attn_unit(const AttnJob&J,char*shm,const int wave_id){
  constexpr int QP_=AJ_QP, KP_=(KIND==0||KIND==2)?128:AJ_QP, VP_=AJ_QP, OP_=1024, NT_=(KIND==0)?132:(KIND==1)?16:4, N0_=(KIND==0)?128:4, QMODE_=(KIND==0)?1:(KIND==2)?2:0; constexpr bool BM_=(KIND==1);
  int tid_; asm volatile("v_mbcnt_lo_u32_b32 %0, -1, 0\n\tv_mbcnt_hi_u32_b32 %0, -1, %0":"=v"(tid_)); tid_+=wave_id*64; const int tid=tid_,lane=tid&63,r32=lane&31,hi=lane>>5; const int wid=__builtin_amdgcn_readfirstlane(tid>>6);
  constexpr int qp=QP_,kp=KP_,vp=VP_,op=OP_,n0=N0_; const int base0=J.base0,base1=J.base1;
  const bf16*Qw=J.Q+(long)(wid*QBLK)*qp;
  const bf16*Kh=J.K,*Vh=J.V;
  const unsigned lds0=(unsigned)(uintptr_t)shm;
  float*wsf=(float*)(shm+LDS_WS)+wid*64;
  const bf16*ksrc=Kh+(long)lane*kp+wid*8;
  const bf16*vsrc=Vh+(long)(16*(wid&3)+(lane>>2))*vp+(wid>>2)*32+(lane&3)*8;
  const unsigned kdst=lds0+LDS_K+wid*1024, vdst=lds0+LDS_V+wid*1024;
  #define KROW(t) (((t)<n0)?(base0+KVBLK*(t)):(base1+KVBLK*((t)-n0)))
  constexpr bool F8_=(KIND==0)&&(PV==7||PV==8)&&(ATTN_QK8!=0); constexpr bool P8_=(KIND==0)&&(PV==8);
  const unsigned char*ksrc8=J.K8+(long)(8*wid+((lane&31)>>2))*128+(((lane&3)^((2*wid+((lane>>4)&1))&3))*16);
  const unsigned kdst8=lds0+LDS_K+wid*512;
  #define DMA_K(t,slot) do{ if constexpr(F8_){ glds16h(ksrc8+(long)KROW(t)*128,(unsigned)__builtin_amdgcn_readfirstlane(kdst8+(slot))); } else { glds16(ksrc+(long)KROW(t)*kp,(unsigned)__builtin_amdgcn_readfirstlane(kdst+(slot))); } }while(0)
  const unsigned char*vsrc8=J.VT8+(long)(8*wid+((lane&31)>>2))*64+(((lane&3)^((2*wid+((lane>>4)&1))&3))*16);
  const unsigned vdst8=lds0+LDS_V+wid*512;
  #define DMA_V(t,slot) do{ if constexpr(P8_){ glds16h(vsrc8+(long)(KROW(t)>>6)*8192,(unsigned)__builtin_amdgcn_readfirstlane(vdst8+(slot))); } else { glds16(vsrc+(long)KROW(t)*vp,(unsigned)__builtin_amdgcn_readfirstlane(vdst+(slot))); } }while(0)
  const int vb0=(int)(lds0+LDS_V)+((lane>>4)&1)*32+(lane&3)*8+(4*hi+((lane&15)>>2))*64;
  const char*Kbase=shm+LDS_K; bf16x8 kf[8];
  const lds_cptr shm3=(lds_cptr)shm; const lds_cptr kp0=shm3+LDS_K+hi*1024+r32*16; const lds_cptr vp0=shm3+LDS_V+((lane>>4)&1)*32+(lane&3)*8+(4*hi+((lane&15)>>2))*64;
  constexpr int NT=NT_;
  constexpr int NTs=BM_?0:NT;
  const int qr_=J.r0+(wid>>1), qc_=32*(wid&1)+r32; const int rs_=min(max(qr_-4,0),120), cs_=min(max(qc_-8,0),48), rlo_=J.rlo; constexpr bool bm_=BM_;
  const lds_fptr btp_=(lds_fptr)((lds_cptr)shm+LDS_BTAB)+(63-qc_+4*hi);
  if(bm_){ __attribute__((address_space(3))) float*bt=(__attribute__((address_space(3))) float*)((__attribute__((address_space(3))) char*)shm+LDS_BTAB);
    for(int i=tid;i<15*128;i+=NW*64){const int dr=i>>7,dc=(i&127)-63; bt[i]=(dc>=-15&&dc<=15)?J.bias[dr*31+dc+15]*1.4426950408889634f:0.f;} }
  constexpr int K8OFF=0, V8OFF=92160; static_assert(V8OFF>=LDS_BYTES_ALL&&V8OFF+3*8192<=131072,"fp8 V pair ring");
  const unsigned char*ksrcP=J.K8+(long)(16*wid+(lane>>2))*128+(((lane&3)^((lane>>4)&3))*16); const unsigned kdstP=lds0+K8OFF+wid*1024;
  const unsigned char*vsrcP=J.VT8+(long)(wid>>2)*8192+(long)(16*(wid&3)+(lane>>2))*64+(((lane&3)^((lane>>4)&3))*16); const unsigned vdstP=lds0+V8OFF+(wid>>2)*4096+(wid&3)*1024;
  #define DMAP_K(u) glds16(ksrcP+(long)KROW(2*(u))*128,(unsigned)__builtin_amdgcn_readfirstlane(kdstP+((u)&3)*8192))
  #define DMAP_V(u) glds16(vsrcP+(long)(KROW(2*(u))>>6)*8192,(unsigned)__builtin_amdgcn_readfirstlane(vdstP+((u)%3)*8192))
  if constexpr(P8_){ DMAP_K(0);DMAP_V(0);DMAP_K(1); } else {
  DMA_K(0,0);DMA_V(0,0);DMA_K(1,SLOTB);
  }
  bf16x8 qr[4]; v8i_a q8;
  if constexpr(F8_){
    bf16x8 qv[4];
    #pragma unroll
    for(int i=0;i<4;++i)qv[i]=*reinterpret_cast<const bf16x8*>(&Qw[(long)r32*qp+32*hi+8*i]);
    float y[32]; float ss=0.f;
    #pragma unroll
    for(int i=0;i<4;++i){ const u32x4 w=__builtin_bit_cast(u32x4,qv[i]);
      y[8*i]=bfl_(w.x);y[8*i+1]=bfh_(w.x);y[8*i+2]=bfl_(w.y);y[8*i+3]=bfh_(w.y);y[8*i+4]=bfl_(w.z);y[8*i+5]=bfh_(w.z);y[8*i+6]=bfl_(w.w);y[8*i+7]=bfh_(w.w); }
    #pragma unroll
    for(int i=0;i<32;++i)ss+=y[i]*y[i];
    { auto rr=__builtin_amdgcn_permlane32_swap(__float_as_uint(ss),__float_as_uint(ss),false,false); ss=__uint_as_float(rr[0])+__uint_as_float(rr[1]); }
    const float rstd=16.0f*C2/sqrtf(ss*(1.0f/64.0f)+1e-6f);
    typedef float f4_ __attribute__((ext_vector_type(4)));
    #pragma unroll
    for(int i=0;i<8;++i){ const f4_ g=*(const f4_*)(J.gq+32*hi+4*i); y[4*i]*=rstd*g[0];y[4*i+1]*=rstd*g[1];y[4*i+2]*=rstd*g[2];y[4*i+3]*=rstd*g[3]; }
    { const int t=J.qt0+wid*QBLK+r32; const int pos=hi?(t&63):(t>>6); const float*rp=J.rope+pos*32;
      #pragma unroll
      for(int i=0;i<8;++i){ const f4_ tb=*(const f4_*)(rp+4*i);
        { const float a=y[2*i],b=y[2*i+16]; y[2*i]=a*tb[0]-b*tb[1]; y[2*i+16]=b*tb[0]+a*tb[1]; }
        { const float a=y[2*i+1],b=y[2*i+17]; y[2*i+1]=a*tb[2]-b*tb[3]; y[2*i+17]=b*tb[2]+a*tb[3]; } } }
    #pragma unroll
    for(int m=0;m<8;++m)q8[m]=(int)pk8a(y[4*m],y[4*m+1],y[4*m+2],y[4*m+3]);
    asm volatile("":"+v"(q8));
  } else {
  #pragma unroll
  for(int d0=0;d0<4;++d0)qr[d0]=*reinterpret_cast<const bf16x8*>(&Qw[(long)r32*qp+d0*16+hi*8]);
  }
  if(QMODE_!=0&&!F8_){
    float y[4][8]; float ss=0.f;
    #pragma unroll
    for(int d0=0;d0<4;++d0){ const u32x4 w=__builtin_bit_cast(u32x4,qr[d0]);
      y[d0][0]=bfl_(w.x);y[d0][1]=bfh_(w.x);y[d0][2]=bfl_(w.y);y[d0][3]=bfh_(w.y);y[d0][4]=bfl_(w.z);y[d0][5]=bfh_(w.z);y[d0][6]=bfl_(w.w);y[d0][7]=bfh_(w.w);
      #pragma unroll
      for(int j=0;j<8;++j)ss+=y[d0][j]*y[d0][j]; }
    { auto rr=__builtin_amdgcn_permlane32_swap(__float_as_uint(ss),__float_as_uint(ss),false,false); ss=__uint_as_float(rr[0])+__uint_as_float(rr[1]); }
    const float rstd=C2/sqrtf(ss*(1.0f/64.0f)+1e-6f);
    #pragma unroll
    for(int d0=0;d0<4;++d0){
      { typedef float f4_ __attribute__((ext_vector_type(4))); const f4_ g0=*(const f4_*)(J.gq+16*d0+8*hi),g1=*(const f4_*)(J.gq+16*d0+8*hi+4);
        y[d0][0]*=rstd*g0[0];y[d0][1]*=rstd*g0[1];y[d0][2]*=rstd*g0[2];y[d0][3]*=rstd*g0[3];y[d0][4]*=rstd*g1[0];y[d0][5]*=rstd*g1[1];y[d0][6]*=rstd*g1[2];y[d0][7]*=rstd*g1[3]; } }
    if(QMODE_==1){ const int t=J.qt0+wid*QBLK+r32, gr=t>>6, gc=t&63;
      typedef float f4_ __attribute__((ext_vector_type(4))); f4_ rr_[4],rc_[4];
      #pragma unroll
      for(int q=0;q<4;++q){ rr_[q]=*(const f4_*)(J.rope+(gr*16+8*hi)*2+4*q); rc_[q]=*(const f4_*)(J.rope+(gc*16+8*hi)*2+4*q); }
      #pragma unroll
      for(int j=0;j<8;++j){ const float cr=rr_[j>>1][2*(j&1)],sr=rr_[j>>1][2*(j&1)+1],cc=rc_[j>>1][2*(j&1)],sc=rc_[j>>1][2*(j&1)+1];
        const float a1=y[0][j],a2=y[1][j],b1=y[2][j],b2=y[3][j];
        y[0][j]=a1*cr-a2*sr; y[1][j]=a2*cr+a1*sr; y[2][j]=b1*cc-b2*sc; y[3][j]=b2*cc+b1*sc; } }
    #pragma unroll
    for(int d0=0;d0<4;++d0){ u32x4 w; w.x=cvtpk_s(y[d0][0],y[d0][1]); w.y=cvtpk_s(y[d0][2],y[d0][3]); w.z=cvtpk_s(y[d0][4],y[d0][5]); w.w=cvtpk_s(y[d0][6],y[d0][7]); qr[d0]=__builtin_bit_cast(bf16x8,w); }
  }
  constexpr bool MS_=(KIND!=1);
  float l_reg=0.f; float mhat=0.f;f32x16 o[2];o[0]=f32x16{};o[1]=f32x16{};f32x16 o2=f32x16{};
  int one2_=0x3f803f80; asm volatile("":"+s"(one2_)); const u32x4 ones4_={(unsigned)one2_,(unsigned)one2_,(unsigned)one2_,(unsigned)one2_}; bf16x8 ONES_=__builtin_bit_cast(bf16x8,ones4_); asm volatile("":"+v"(ONES_));
 f32x16 negm=f32x16{};asm volatile("":"+v"(negm));
  typedef float f32x4_ __attribute__((ext_vector_type(4))); f32x4_ o2s={0.f,0.f,0.f,0.f};
  int sb2_=(((lane&8)==0)==(((lane>>4)&1)==0))?0x3f803f80:0; asm volatile("":"+v"(sb2_)); const u32x4 sb4_={(unsigned)sb2_,(unsigned)sb2_,(unsigned)sb2_,(unsigned)sb2_}; const bf16x8 SUMB_=__builtin_bit_cast(bf16x8,sb4_);
  #define CMASK(P0,P1,t) do{ if(bm_&&(t)>=4)bmask(P0,P1,(t)-4,rlo_,qr_,rs_,cs_,hi,btp_); }while(0)
  bool resc=false;
  #define START(P0,P1) do{ const float rm=rowmax(P0,P1); resc=false; \
    { const float dl=rm; mhat=fadd_s(mhat,dl); \
      _Pragma("unroll") for(int r=0;r<16;++r){P0[r]=fsub_s(P0[r],dl);P1[r]=fsub_s(P1[r],dl);} \
      _Pragma("unroll") for(int r=0;r<16;++r)negm[r]=-mhat; asm volatile("":"+v"(negm)); } \
    _Pragma("unroll") for(int r=0;r<16;++r)P0[r]=__builtin_amdgcn_exp2f(P0[r]); }while(0)
  #define RESC() do{ if(resc){ asm volatile("s_waitcnt lgkmcnt(0)":::"memory"); \
      _Pragma("unroll") for(int r=0;r<16;++r){const float f_=wsf[crow(r,hi)];o[0][r]*=f_;o[1][r]*=f_;if constexpr(MS_)o2[r]*=f_;} } }while(0)
  f32x16 pA0,pA1,pB0,pB1; s16x4 vlo[8],vhi[8]; u32x4 pw0,pw1,pw2,pw3;
  int sl_prev=0,sl_cur=0,sl_next=SLOTB;
  #define ROT() do{sl_prev=sl_cur;sl_cur=sl_next;sl_next=(sl_next==(NSLOT-1)*SLOTB)?0:sl_next+SLOTB;}while(0)
  if constexpr(P8_){ DMAP_K(2); } else {
  DMA_K(2,2*SLOTB);
  }
  WAIT_BAR(3);
  constexpr bool NEWP_=(KIND==0)&&(ATTN_NEWPIPE!=0);
  if constexpr(!NEWP_){
  qkt(pA0,pA1,Kbase,qr,negm,r32,hi);asm volatile("s_nop 15\n\ts_nop 7":"+v"(pA0),"+v"(pA1));CMASK(pA0,pA1,0);
  START(pA0,pA1);
  _Pragma("unroll") for(int r=0;r<16;++r)pA1[r]=__builtin_amdgcn_exp2f(pA1[r]);
  WAIT_BAR(0);
  DMA_K(3,0);DMA_V(1,SLOTB);
  ROT();
  kload8(kf,kp0+sl_cur);
  WAIT_BAR(2);
  #define PKW(P,B) cvtpk_s(P[B],P[B+1])
  #define PAF(k) __builtin_bit_cast(bf16x8,pw##k)
  #define VFR(i) (bf16x8){vlo[i][0],vlo[i][1],vlo[i][2],vlo[i][3],vhi[i][0],vhi[i][1],vhi[i][2],vhi[i][3]}
  #define PIN(x) asm volatile("":"+v"(x))
  #define MX3(a,b,c) __builtin_fmaxf(__builtin_fmaxf((a),(b)),(c))
  #define GAPA(MF,A0,A1,A2,A3,W0,W1,PW) do{ MF; if constexpr(!MS_){ sacc+=A0; sacc+=A1; sacc+=A2; sacc+=A3; PIN(sacc); } W0; W1; PIN(PW); SBAR(); }while(0)
  #define SUMM(k) do{ if constexpr(MS_){ o2=__builtin_amdgcn_mfma_f32_32x32x16_bf16(PAF(k),ONES_,o2,0,0,0); SBAR(); } }while(0)
  #define EX(v) __builtin_amdgcn_exp2f(v)
  #define GAPB(MF,X,B) do{ MF; X[B]=EX(X[B]); X[B+1]=EX(X[B+1]); X[B+2]=EX(X[B+2]); X[B+3]=EX(X[B+3]); PIN(X); SBAR(); }while(0)
  #define VRD(i) do{ vlo[i]=vtr(vp_+(((i)>>2)*4096+((i)&3)*1024)); vhi[i]=vtr(vp_+(((i)>>2)*4096+((i)&3)*1024+512)); }while(0)
  #define KRD(G,j) do{ if(G){ kload2(kf,kp0+sl_next,j); SBAR(); } }while(0)
  #define STEP(C0,C1,P0,P1,t,GK,GV,GL) do{ SBAR(); \
    const lds_cptr vp_=vp0+sl_prev; \
    VRD(0); SBAR(); float sacc=MS_?0.f:(P0[0]+P0[1]); \
    GAPA(C0=__builtin_amdgcn_mfma_f32_32x32x16_bf16(kf[0],qr[0],negm,0,0,0), P0[2],P0[3],P0[4],P0[5],     pw0[0]=PKW(P0,0), pw0[1]=PKW(P0,2), pw0); \
    VRD(4); SBAR(); GAPA(C1=__builtin_amdgcn_mfma_f32_32x32x16_bf16(kf[1],qr[0],negm,0,0,0), P0[6],P0[7],P0[8],P0[9],     pw0[2]=PKW(P0,4), pw0[3]=PKW(P0,6), pw0); \
    VRD(1); SBAR(); GAPA(C0=__builtin_amdgcn_mfma_f32_32x32x16_bf16(kf[2],qr[1],C0,0,0,0),   P0[10],P0[11],P0[12],P0[13], pw1[0]=PKW(P0,8), pw1[1]=PKW(P0,10), pw1); \
    VRD(5); SBAR(); GAPA(C1=__builtin_amdgcn_mfma_f32_32x32x16_bf16(kf[3],qr[1],C1,0,0,0),   P0[14],P0[15],P1[0],P1[1],   pw1[2]=PKW(P0,12),pw1[3]=PKW(P0,14), pw1); \
    VRD(2); SBAR(); GAPA(C0=__builtin_amdgcn_mfma_f32_32x32x16_bf16(kf[4],qr[2],C0,0,0,0),   P1[2],P1[3],P1[4],P1[5],     pw2[0]=PKW(P1,0), pw2[1]=PKW(P1,2), pw2); \
    VRD(6); SBAR(); GAPA(C1=__builtin_amdgcn_mfma_f32_32x32x16_bf16(kf[5],qr[2],C1,0,0,0),   P1[6],P1[7],P1[8],P1[9],     pw2[2]=PKW(P1,4), pw2[3]=PKW(P1,6), pw2); \
    VRD(3); SBAR(); GAPA(C0=__builtin_amdgcn_mfma_f32_32x32x16_bf16(kf[6],qr[3],C0,0,0,0),   P1[10],P1[11],P1[12],P1[13], pw3[0]=PKW(P1,8), pw3[1]=PKW(P1,10), pw3); \
    VRD(7); SBAR(); GAPA(C1=__builtin_amdgcn_mfma_f32_32x32x16_bf16(kf[7],qr[3],C1,0,0,0),   P1[14],P1[15],0.f,0.f,       pw3[2]=PKW(P1,12),pw3[3]=PKW(P1,14), pw3); \
    if constexpr(!MS_) l_reg+=sacc; \
    if(GK){DMA_K((t)+3,sl_cur);} if(GV){DMA_V((t)+1,sl_next);} \
    CMASK(C0,C1,t); \
    { float a=MX3(C0[0],C0[1],C1[0]),b=MX3(C0[2],C0[3],C1[1]); a=MX3(a,C1[2],C1[3]); \
      _Pragma("unroll") for(int r=4;r<16;r+=4){a=MX3(a,C0[r],C0[r+1]);b=MX3(b,C0[r+2],C0[r+3]);a=MX3(a,C1[r],C1[r+1]);b=MX3(b,C1[r+2],C1[r+3]);} \
      float rm=__builtin_fmaxf(a,b); { auto rr=__builtin_amdgcn_permlane32_swap(__float_as_uint(rm),__float_as_uint(rm),false,false); rm=__builtin_fmaxf(__uint_as_float(rr[0]),__uint_as_float(rr[1])); } \
      resc=false; \
      if(__builtin_expect(__any(rm>(float)THRL),0)){ const float dl=__builtin_fmaxf(rm,0.f); mhat+=dl; \
        _Pragma("unroll") for(int r=0;r<16;++r){C0[r]-=dl;C1[r]-=dl;} \
        _Pragma("unroll") for(int r=0;r<16;++r)negm[r]=-mhat; asm volatile("":"+v"(negm)); \
        const float f=__builtin_amdgcn_exp2f(-dl); if constexpr(!MS_) l_reg*=f; if(hi==0)wsf[r32]=f; resc=true; } } \
    SBAR(); \
    GAPB(o[0]=__builtin_amdgcn_mfma_f32_32x32x16_bf16(PAF(0),VFR(0),o[0],0,0,0), C0,0); \
    GAPB(o[1]=__builtin_amdgcn_mfma_f32_32x32x16_bf16(PAF(0),VFR(4),o[1],0,0,0), C0,4); SUMM(0); \
    KRD(GL,0); GAPB(o[0]=__builtin_amdgcn_mfma_f32_32x32x16_bf16(PAF(1),VFR(1),o[0],0,0,0), C0,8); \
    KRD(GL,1); GAPB(o[1]=__builtin_amdgcn_mfma_f32_32x32x16_bf16(PAF(1),VFR(5),o[1],0,0,0), C0,12); SUMM(1); \
    KRD(GL,2); GAPB(o[0]=__builtin_amdgcn_mfma_f32_32x32x16_bf16(PAF(2),VFR(2),o[0],0,0,0), C1,0); \
    KRD(GL,3); GAPB(o[1]=__builtin_amdgcn_mfma_f32_32x32x16_bf16(PAF(2),VFR(6),o[1],0,0,0), C1,4); SUMM(2); \
    GAPB(o[0]=__builtin_amdgcn_mfma_f32_32x32x16_bf16(PAF(3),VFR(3),o[0],0,0,0), C1,8); \
    GAPB(o[1]=__builtin_amdgcn_mfma_f32_32x32x16_bf16(PAF(3),VFR(7),o[1],0,0,0), C1,12); SUMM(3); \
    }while(0)
  int t=1;
  #undef CMASK
  #define CMASK(P0,P1,t) do{}while(0)
  for(;t+5<NTs;t+=2){
    STEP(pB0,pB1,pA0,pA1,t,true,true,true);     WAIT_BAR(2); RESC(); ROT();
    STEP(pA0,pA1,pB0,pB1,t+1,true,true,true);   WAIT_BAR(2); RESC(); ROT();
  }
  #undef CMASK
  #define CMASK(P0,P1,t) do{ if(bm_&&(t)>=4)bmask(P0,P1,(t)-4,rlo_,qr_,rs_,cs_,hi,btp_); }while(0)
  #define ENDW(tt) do{ if((tt)+3<NT){WAIT_BAR(2);} else if((tt)+2<NT){WAIT_BAR(1);} else {WAIT_BAR(0);} }while(0)
  for(;t+1<NT;t+=2){
    STEP(pB0,pB1,pA0,pA1,t,(t+3<NT),(t+1<NT),(t+1<NT));       ENDW(t);   RESC(); ROT();
    STEP(pA0,pA1,pB0,pB1,t+1,(t+4<NT),(t+2<NT),(t+2<NT));     ENDW(t+1); RESC(); ROT();
  }
  STEP(pB0,pB1,pA0,pA1,NT-1,false,false,false); RESC();
  { if constexpr(!MS_){ float sacc=pB0[0]+pB0[1]; _Pragma("unroll") for(int r=2;r<16;++r)sacc+=pB0[r]; _Pragma("unroll") for(int r=0;r<16;++r)sacc+=pB1[r]; l_reg+=sacc; }
    pw0=(u32x4){PKW(pB0,0),PKW(pB0,2),PKW(pB0,4),PKW(pB0,6)};pw1=(u32x4){PKW(pB0,8),PKW(pB0,10),PKW(pB0,12),PKW(pB0,14)};pw2=(u32x4){PKW(pB1,0),PKW(pB1,2),PKW(pB1,4),PKW(pB1,6)};pw3=(u32x4){PKW(pB1,8),PKW(pB1,10),PKW(pB1,12),PKW(pB1,14)};
    SBAR(); pv(o,vb0+sl_cur,PAF(0),PAF(1),PAF(2),PAF(3)); SUMM(0); SUMM(1); SUMM(2); SUMM(3); }
  } else if constexpr(PV==8) {
  { float nm_=-J.mref; asm volatile("":"+v"(nm_)); _Pragma("unroll") for(int r=0;r<16;++r)negm[r]=nm_; asm volatile("":"+v"(negm)); }
  v8i_a kf8[2],vf8[2],pw8; int sca_=0x7F7F7F7F, scb_=0x7B7B7B7B, scv_=0x7C7C7C7C; asm volatile("":"+v"(sca_),"+v"(scb_),"+v"(scv_));
  int sb8_=(((lane&8)==0)==(((lane>>4)&1)==0))?0x38383838:0; asm volatile("":"+v"(sb8_)); const v8i_a SUMB8={sb8_,sb8_,sb8_,sb8_,sb8_,sb8_,sb8_,sb8_};
  const int ko0_=r32*64+(((2*hi)^((r32>>2)&3))*16); const lds_cptr kp8a=shm3+K8OFF+ko0_, kp8b=shm3+K8OFF+(ko0_^16), vq8a=shm3+V8OFF+ko0_, vq8b=shm3+V8OFF+(ko0_^16);
  #define KLD8(n,slot) do{ const v4i_a lo_=*(const __attribute__((address_space(3))) v4i_a*)(kp8a+(slot)+(n)*2048), hi_=*(const __attribute__((address_space(3))) v4i_a*)(kp8b+(slot)+(n)*2048); kf8[n]=__builtin_shufflevector(lo_,hi_,0,1,2,3,4,5,6,7); }while(0)
  #define VLD8(n,slot) do{ const v4i_a lo_=*(const __attribute__((address_space(3))) v4i_a*)(vq8a+(slot)+(n)*2048), hi_=*(const __attribute__((address_space(3))) v4i_a*)(vq8b+(slot)+(n)*2048); vf8[n]=__builtin_shufflevector(lo_,hi_,0,1,2,3,4,5,6,7); }while(0)
  #define MFQ8(G,C,n) do{ if(G){ asm volatile("s_nop 1\n\tv_mfma_scale_f32_32x32x64_f8f6f4 %0, %1, %2, %3, %4, %5 op_sel_hi:[0,0,0]" : "=&v"(C) : "v"(kf8[n]), "v"(q8), "v"(negm), "v"(sca_), "v"(scb_)); } }while(0)
  #define MFP8(d) asm volatile("s_nop 1\n\tv_mfma_scale_f32_32x32x64_f8f6f4 %0, %1, %2, %0, %3, %4 op_sel_hi:[0,0,0] cbsz:1" : "+v"(o[d]) : "v"(pw8), "v"(vf8[d]), "v"(sca_), "v"(scv_))
  #define MFS8() asm volatile("s_nop 1\n\tv_mfma_scale_f32_16x16x128_f8f6f4 %0, %1, %2, %0, %3, %4 op_sel_hi:[0,0,0] cbsz:1" : "+v"(o2s) : "v"(pw8), "v"(SUMB8), "v"(sca_), "v"(sca_))
  #define PKP8(C0,C1) do{ pw8[0]=pkb8(C0[0],C0[1],C0[2],C0[3]); pw8[1]=pkb8(C0[4],C0[5],C0[6],C0[7]); pw8[2]=pkb8(C0[8],C0[9],C0[10],C0[11]); pw8[3]=pkb8(C0[12],C0[13],C0[14],C0[15]); \
      pw8[4]=pkb8(C1[0],C1[1],C1[2],C1[3]); pw8[5]=pkb8(C1[4],C1[5],C1[6],C1[7]); pw8[6]=pkb8(C1[8],C1[9],C1[10],C1[11]); pw8[7]=pkb8(C1[12],C1[13],C1[14],C1[15]); PIN(pw8); }while(0)
  #define NOPS5(a,b) asm volatile("s_nop 15\n\ts_nop 15\n\ts_nop 15\n\ts_nop 15\n\ts_nop 15":"+v"(a),"+v"(b))
  #define KSL(j) ((((j)>>1)&3)*8192+((j)&1)*4096)
  #define VSL(j) ((((j)>>1)%3)*8192+((j)&1)*4096)
  KLD8(0,KSL(0)); KLD8(1,KSL(0)); MFQ8(true,pA0,0); MFQ8(true,pA1,1); NOPS5(pA0,pA1);
  _Pragma("unroll") for(int r=0;r<16;++r){pA0[r]=__builtin_amdgcn_exp2f(pA0[r]);pA1[r]=__builtin_amdgcn_exp2f(pA1[r]);}
  PKP8(pA0,pA1);
  KLD8(0,KSL(1)); KLD8(1,KSL(1)); MFQ8(true,pB0,0); MFQ8(true,pB1,1); NOPS5(pB0,pB1);
  WAIT_BAR(1);
  DMAP_K(3);DMAP_V(1);
  KLD8(0,KSL(2)); KLD8(1,KSL(2));
  WAIT_BAR(2);
  #define EXS(X,i) X[i]=EX(X[i])
  #define EX4(X,i) do{ EXS(X,i); EXS(X,(i)+1); EXS(X,(i)+2); EXS(X,(i)+3); PIN(X); SBAR(); }while(0)
  #define STEP8(N0,N1,C0,C1,t,DI,GK,KU,GV,VU,GL,GQ) do{ SBAR(); \
    { const int vo_=VSL((t)-1); VLD8(0,vo_); VLD8(1,vo_); } SBAR(); \
    MFQ8(GQ,N0,0); EX4(C0,0); EX4(C0,4); \
    MFQ8(GQ,N1,1); EX4(C0,8); EX4(C0,12); \
    if(DI){ if(GK){DMAP_K(KU);} if(GV){DMAP_V(VU);} } SBAR(); \
    MFP8(0); EX4(C1,0); \
    MFP8(1); EX4(C1,4); \
    MFS8();  EX4(C1,8); \
    if(GL){ const int ko_=KSL((t)+2); KLD8(0,ko_); KLD8(1,ko_); } SBAR(); \
    EX4(C1,12); \
    PKP8(C0,C1); SBAR(); \
    }while(0)
  constexpr int NP=NT/2;
  int m=0;
  for(;m+4<NP;++m){ const int t=2*m+1;
    STEP8(pA0,pA1,pB0,pB1,t,  true, true,m+4,true,m+2,true,true);
    STEP8(pB0,pB1,pA0,pA1,t+1,false,false,0,false,0,true,true);
    WAIT_BAR(2);
  }
  for(;m+1<NP;++m){ const int t=2*m+1; const bool gk=(m+4<NP), gv=(m+2<NP);
    STEP8(pA0,pA1,pB0,pB1,t,  true, gk,m+4,gv,m+2,(t+2<NT),(t+1<NT));
    STEP8(pB0,pB1,pA0,pA1,t+1,false,false,0,false,0,(t+3<NT),(t+2<NT));
    if(gv){WAIT_BAR(1);} else {WAIT_BAR(0);}
  }
  STEP8(pA0,pA1,pB0,pB1,NT-1,false,false,0,false,0,false,false);
  SBAR(); VLD8(0,VSL(NT-1)); VLD8(1,VSL(NT-1)); SBAR(); MFP8(0); MFP8(1); MFS8(); NOPS5(o[0],o[1]);
  #undef KSL
  #undef VSL
  #undef KLD8
  #undef VLD8
  #undef MFQ8
  #undef MFP8
  #undef MFS8
  #undef PKP8
  #undef NOPS5
  #undef EXS
  #undef EX4
  #undef STEP8
  } else if constexpr(PV==7) {
  { float nm_=-J.mref; asm volatile("":"+v"(nm_)); _Pragma("unroll") for(int r=0;r<16;++r)negm[r]=nm_; asm volatile("":"+v"(negm)); }
  v8i_a kf8[2]; int sca_=0x7F7F7F7F, scb_=0x7B7B7B7B; asm volatile("":"+v"(sca_),"+v"(scb_));
  const int ko0_=r32*64+(((2*hi)^((r32>>2)&3))*16); const lds_cptr kp8a=shm3+LDS_K+ko0_, kp8b=shm3+LDS_K+(ko0_^16);
  #define KLD8(n,slot) do{ const v4i_a lo_=*(const __attribute__((address_space(3))) v4i_a*)(kp8a+(slot)+(n)*2048), hi_=*(const __attribute__((address_space(3))) v4i_a*)(kp8b+(slot)+(n)*2048); kf8[n]=__builtin_shufflevector(lo_,hi_,0,1,2,3,4,5,6,7); }while(0)
  #define MFQ8(G,C,n) do{ if(G){ asm volatile("s_nop 1\n\tv_mfma_scale_f32_32x32x64_f8f6f4 %0, %1, %2, %3, %4, %5 op_sel_hi:[0,0,0]" : "=&v"(C) : "v"(kf8[n]), "v"(q8), "v"(negm), "v"(sca_), "v"(scb_)); } }while(0)
  if constexpr(F8_){ KLD8(0,0); KLD8(1,0); MFQ8(true,pA0,0); MFQ8(true,pA1,1); asm volatile("s_nop 15\n\ts_nop 15\n\ts_nop 15\n\ts_nop 15\n\ts_nop 15":"+v"(pA0),"+v"(pA1)); }
  else { qkt(pA0,pA1,Kbase,qr,negm,r32,hi); }
  _Pragma("unroll") for(int r=0;r<16;++r){pA0[r]=__builtin_amdgcn_exp2f(pA0[r]);pA1[r]=__builtin_amdgcn_exp2f(pA1[r]);}
  pw0=(u32x4){PKW(pA0,0),PKW(pA0,2),PKW(pA0,4),PKW(pA0,6)};pw1=(u32x4){PKW(pA0,8),PKW(pA0,10),PKW(pA0,12),PKW(pA0,14)};pw2=(u32x4){PKW(pA1,0),PKW(pA1,2),PKW(pA1,4),PKW(pA1,6)};pw3=(u32x4){PKW(pA1,8),PKW(pA1,10),PKW(pA1,12),PKW(pA1,14)};
  WAIT_BAR(0);
  DMA_K(3,0);DMA_V(1,SLOTB);
  ROT();
  if constexpr(F8_){ KLD8(0,SLOTB); KLD8(1,SLOTB); MFQ8(true,pB0,0); MFQ8(true,pB1,1); asm volatile("s_nop 15\n\ts_nop 15\n\ts_nop 15\n\ts_nop 15\n\ts_nop 15":"+v"(pB0),"+v"(pB1)); KLD8(0,2*SLOTB); KLD8(1,2*SLOTB); }
  else { qkt(pB0,pB1,Kbase+SLOTB,qr,negm,r32,hi); kload8(kf,kp0+2*SLOTB); }
  WAIT_BAR(1);
  DMA_K(4,SLOTB);
  #define MFQ(G,C,k,q,ACC) do{ if constexpr(F8_){ if((k)==0){ MFQ8(G,C,0); } else if((k)==5){ MFQ8(G,C,1); } } else { if(G){ C=__builtin_amdgcn_mfma_f32_32x32x16_bf16(kf[k],qr[q],ACC,0,0,0); } } }while(0)
  #define MFP(d,k,v) o[d]=__builtin_amdgcn_mfma_f32_32x32x16_bf16(PAF(k),VFR(v),o[d],0,0,0)
  #define MFS(k) o2s=__builtin_amdgcn_mfma_f32_16x16x32_bf16(PAF(k),SUMB_,o2s,0,0,0)
  #define EXS(X,i) X[i]=EX(X[i])
  #define KRDN(G,j) do{ if(G){ if constexpr(F8_){ if((j)==0){ KLD8(0,sl_prev); } else if((j)==1){ KLD8(1,sl_prev); } } else { kload2(kf,kp0+sl_prev,j); } SBAR(); } }while(0)
  #define STEPF(N0,N1,C0,C1,t,GK,GV,GL,GQ) do{ SBAR(); \
    const lds_cptr vp_=vp0+sl_prev; \
    VRD(0); SBAR(); MFQ(GQ,N0,0,0,negm); EXS(C0,0);  EXS(C0,1);  PIN(C0); SBAR(); \
    VRD(4); SBAR(); MFQ(GQ,N1,1,0,negm); EXS(C0,2);  EXS(C0,3);  PIN(C0); SBAR(); \
    VRD(1); SBAR(); MFQ(GQ,N0,2,1,N0);   EXS(C0,4);  EXS(C0,5);  PIN(C0); SBAR(); \
    VRD(5); SBAR(); MFQ(GQ,N1,3,1,N1);   EXS(C0,6);  EXS(C0,7);  PIN(C0); SBAR(); \
    VRD(2); SBAR(); MFQ(GQ,N0,4,2,N0);   EXS(C0,8);  EXS(C0,9);  PIN(C0); SBAR(); \
    VRD(6); SBAR(); MFQ(GQ,N1,5,2,N1);   EXS(C0,10); EXS(C0,11); PIN(C0); SBAR(); \
    VRD(3); SBAR(); MFQ(GQ,N0,6,3,N0);   EXS(C0,12); EXS(C0,13); PIN(C0); SBAR(); \
    VRD(7); SBAR(); MFQ(GQ,N1,7,3,N1);   EXS(C0,14); EXS(C0,15); PIN(C0); SBAR(); \
    if(GK){DMA_K((t)+4,sl_next);} if(GV){DMA_V((t)+1,sl_next);} SBAR(); \
    MFP(0,0,0); EXS(C1,0); EXS(C1,1); PIN(C1); SBAR(); \
    MFP(1,0,4); EXS(C1,2); EXS(C1,3); PIN(C1); SBAR(); \
    MFS(0);     EXS(C1,4); EXS(C1,5); PIN(C1); SBAR(); \
    MFP(0,1,1); pw0[0]=PKW(C0,0); pw0[1]=PKW(C0,2); pw0[2]=PKW(C0,4); pw0[3]=PKW(C0,6); PIN(pw0); SBAR(); \
    KRDN(GL,0); MFP(1,1,5); EXS(C1,6); EXS(C1,7); PIN(C1); SBAR(); \
    KRDN(GL,1); MFS(1);     EXS(C1,8); EXS(C1,9); PIN(C1); SBAR(); \
    MFP(0,2,2); pw1[0]=PKW(C0,8); pw1[1]=PKW(C0,10); pw1[2]=PKW(C0,12); pw1[3]=PKW(C0,14); PIN(pw1); SBAR(); \
    KRDN(GL,2); MFP(1,2,6); EXS(C1,10); EXS(C1,11); PIN(C1); SBAR(); \
    KRDN(GL,3); MFS(2);     EXS(C1,12); EXS(C1,13); PIN(C1); SBAR(); \
    MFP(0,3,3); pw2[0]=PKW(C1,0); pw2[1]=PKW(C1,2); pw2[2]=PKW(C1,4); pw2[3]=PKW(C1,6); PIN(pw2); SBAR(); \
    MFP(1,3,7); EXS(C1,14); EXS(C1,15); PIN(C1); SBAR(); \
    MFS(3);     SBAR(); \
    pw3[0]=PKW(C1,8); pw3[1]=PKW(C1,10); pw3[2]=PKW(C1,12); pw3[3]=PKW(C1,14); PIN(pw3); SBAR(); \
    }while(0)
  #define ENDWN(tt) do{ if((tt)+4<NT){WAIT_BAR(2);} else if((tt)+2<NT){WAIT_BAR(1);} else {WAIT_BAR(0);} }while(0)
  int t=1;
  for(;t+5<NT;t+=2){
    STEPF(pA0,pA1,pB0,pB1,t,true,true,true,true);     WAIT_BAR(2); ROT();
    STEPF(pB0,pB1,pA0,pA1,t+1,true,true,true,true);   WAIT_BAR(2); ROT();
  }
  for(;t+1<NT;t+=2){
    STEPF(pA0,pA1,pB0,pB1,t,(t+4<NT),(t+1<NT),(t+2<NT),(t+1<NT));       ENDWN(t);   ROT();
    STEPF(pB0,pB1,pA0,pA1,t+1,(t+5<NT),(t+2<NT),(t+3<NT),(t+2<NT));     ENDWN(t+1); ROT();
  }
  STEPF(pA0,pA1,pB0,pB1,NT-1,false,false,false,false);
  SBAR(); pv(o,vb0+sl_cur,PAF(0),PAF(1),PAF(2),PAF(3)); MFS(0); MFS(1); MFS(2); MFS(3);
  #undef MFQ
  #undef MFP
  #undef MFS
  #undef EXS
  #undef KRDN
  #undef STEPF
  #undef KLD8
  #undef MFQ8
  #undef ENDWN
  } else {
  qkt(pA0,pA1,Kbase,qr,negm,r32,hi);asm volatile("s_nop 15\n\ts_nop 7":"+v"(pA0),"+v"(pA1));
  START(pA0,pA1);
  _Pragma("unroll") for(int r=0;r<16;++r)pA1[r]=__builtin_amdgcn_exp2f(pA1[r]);
  pw0=(u32x4){PKW(pA0,0),PKW(pA0,2),PKW(pA0,4),PKW(pA0,6)};pw1=(u32x4){PKW(pA0,8),PKW(pA0,10),PKW(pA0,12),PKW(pA0,14)};pw2=(u32x4){PKW(pA1,0),PKW(pA1,2),PKW(pA1,4),PKW(pA1,6)};pw3=(u32x4){PKW(pA1,8),PKW(pA1,10),PKW(pA1,12),PKW(pA1,14)};
  WAIT_BAR(0);
  DMA_K(3,0);DMA_V(1,SLOTB);
  ROT();
  qkt(pB0,pB1,Kbase+SLOTB,qr,negm,r32,hi);asm volatile("s_nop 15\n\ts_nop 7":"+v"(pB0),"+v"(pB1));
  kload8(kf,kp0+2*SLOTB);
  WAIT_BAR(1);
  DMA_K(4,SLOTB);
  #define MFQ(G,C,k,q,ACC) do{ if(G){ C=__builtin_amdgcn_mfma_f32_32x32x16_bf16(kf[k],qr[q],ACC,0,0,0); } }while(0)
  #define MFP(d,k,v) o[d]=__builtin_amdgcn_mfma_f32_32x32x16_bf16(PAF(k),VFR(v),o[d],0,0,0)
  #define MFS(k) o2=__builtin_amdgcn_mfma_f32_32x32x16_bf16(PAF(k),ONES_,o2,0,0,0)
  #define EXS(X,i) X[i]=EX(X[i])
  #define KRDN(G,j) do{ if(G){ kload2(kf,kp0+sl_prev,j); SBAR(); } }while(0)
  #define STEPN(N0,N1,C0,C1,t,GK,GV,GL,GQ) do{ SBAR(); \
    const lds_cptr vp_=vp0+sl_prev; float a_,b_,rm_; \
    VRD(0); SBAR(); MFQ(GQ,N0,0,0,negm); a_=MX3(C0[0],C0[1],C1[0]); b_=MX3(C0[2],C0[3],C1[1]); a_=MX3(a_,C1[2],C1[3]); a_=MX3(a_,C0[4],C0[5]); PIN(a_); PIN(b_); SBAR(); \
    VRD(4); SBAR(); MFQ(GQ,N1,1,0,negm); b_=MX3(b_,C0[6],C0[7]); a_=MX3(a_,C1[4],C1[5]); b_=MX3(b_,C1[6],C1[7]); a_=MX3(a_,C0[8],C0[9]); PIN(a_); PIN(b_); SBAR(); \
    VRD(1); SBAR(); MFQ(GQ,N0,2,1,N0);   b_=MX3(b_,C0[10],C0[11]); a_=MX3(a_,C1[8],C1[9]); b_=MX3(b_,C1[10],C1[11]); a_=MX3(a_,C0[12],C0[13]); PIN(a_); PIN(b_); SBAR(); \
    VRD(5); SBAR(); MFQ(GQ,N1,3,1,N1);   b_=MX3(b_,C0[14],C0[15]); a_=MX3(a_,C1[12],C1[13]); b_=MX3(b_,C1[14],C1[15]); rm_=__builtin_fmaxf(a_,b_); PIN(rm_); SBAR(); \
    VRD(2); SBAR(); MFQ(GQ,N0,4,2,N0); \
    { auto rr=__builtin_amdgcn_permlane32_swap(__float_as_uint(rm_),__float_as_uint(rm_),false,false); rm_=__builtin_fmaxf(__uint_as_float(rr[0]),__uint_as_float(rr[1])); } \
    resc=false; \
    if(__builtin_expect(__any(rm_>(float)THRL),0)){ const float dl=__builtin_fmaxf(rm_,0.f); mhat+=dl; \
      _Pragma("unroll") for(int r=0;r<16;++r){C0[r]-=dl;C1[r]-=dl;} \
      if(GQ){ _Pragma("unroll") for(int r=0;r<16;++r){N0[r]-=dl;N1[r]-=dl;} }                      \
      _Pragma("unroll") for(int r=0;r<16;++r)negm[r]=-mhat; asm volatile("":"+v"(negm)); \
      const float f=__builtin_amdgcn_exp2f(-dl); if(hi==0)wsf[r32]=f; resc=true; } \
    SBAR(); \
    VRD(6); SBAR(); MFQ(GQ,N1,5,2,N1); EXS(C0,0); EXS(C0,1); PIN(C0); SBAR(); \
    VRD(3); SBAR(); MFQ(GQ,N0,6,3,N0); EXS(C0,2); EXS(C0,3); PIN(C0); SBAR(); \
    VRD(7); SBAR(); MFQ(GQ,N1,7,3,N1); EXS(C0,4); EXS(C0,5); PIN(C0); SBAR(); \
    if(GK){DMA_K((t)+4,sl_next);} if(GV){DMA_V((t)+1,sl_next);} SBAR(); \
    MFP(0,0,0); EXS(C0,6); EXS(C0,7); EXS(C0,8); PIN(C0); SBAR(); \
    MFP(1,0,4); EXS(C0,9); EXS(C0,10); EXS(C0,11); PIN(C0); SBAR(); \
    MFS(0);     EXS(C0,12); EXS(C0,13); EXS(C0,14); PIN(C0); SBAR(); \
    MFP(0,1,1); pw0[0]=PKW(C0,0); pw0[1]=PKW(C0,2); pw0[2]=PKW(C0,4); pw0[3]=PKW(C0,6); EXS(C0,15); PIN(pw0); PIN(C0); SBAR(); \
    KRDN(GL,0); MFP(1,1,5); EXS(C1,0); EXS(C1,1); PIN(C1); SBAR(); \
    KRDN(GL,1); MFS(1);     EXS(C1,2); EXS(C1,3); PIN(C1); SBAR(); \
    MFP(0,2,2); pw1[0]=PKW(C0,8); pw1[1]=PKW(C0,10); pw1[2]=PKW(C0,12); pw1[3]=PKW(C0,14); EXS(C1,4); PIN(pw1); PIN(C1); SBAR(); \
    KRDN(GL,2); MFP(1,2,6); EXS(C1,5); EXS(C1,6); PIN(C1); SBAR(); \
    KRDN(GL,3); MFS(2);     EXS(C1,7); EXS(C1,8); PIN(C1); SBAR(); \
    MFP(0,3,3); pw2[0]=PKW(C1,0); pw2[1]=PKW(C1,2); pw2[2]=PKW(C1,4); pw2[3]=PKW(C1,6); EXS(C1,9); PIN(pw2); PIN(C1); SBAR(); \
    MFP(1,3,7); EXS(C1,10); EXS(C1,11); EXS(C1,12); PIN(C1); SBAR(); \
    MFS(3);     EXS(C1,13); EXS(C1,14); EXS(C1,15); PIN(C1); SBAR(); \
    pw3[0]=PKW(C1,8); pw3[1]=PKW(C1,10); pw3[2]=PKW(C1,12); pw3[3]=PKW(C1,14); PIN(pw3); SBAR(); \
    }while(0)
  #define ENDWN(tt) do{ if((tt)+4<NT){WAIT_BAR(2);} else if((tt)+2<NT){WAIT_BAR(1);} else {WAIT_BAR(0);} }while(0)
  int t=1;
  for(;t+5<NT;t+=2){
    STEPN(pA0,pA1,pB0,pB1,t,true,true,true,true);     WAIT_BAR(2); RESC(); ROT();
    STEPN(pB0,pB1,pA0,pA1,t+1,true,true,true,true);   WAIT_BAR(2); RESC(); ROT();
  }
  for(;t+1<NT;t+=2){
    STEPN(pA0,pA1,pB0,pB1,t,(t+4<NT),(t+1<NT),(t+2<NT),(t+1<NT));       ENDWN(t);   RESC(); ROT();
    STEPN(pB0,pB1,pA0,pA1,t+1,(t+5<NT),(t+2<NT),(t+3<NT),(t+2<NT));     ENDWN(t+1); RESC(); ROT();
  }
  STEPN(pA0,pA1,pB0,pB1,NT-1,false,false,false,false); RESC();
  SBAR(); pv(o,vb0+sl_cur,PAF(0),PAF(1),PAF(2),PAF(3)); SUMM(0); SUMM(1); SUMM(2); SUMM(3);
  #undef MFQ
  #undef MFP
  #undef MFS
  #undef EXS
  #undef KRDN
  #undef STEPN
  #undef ENDWN
  }
  #undef PKW
  #undef PAF
  #undef VFR
  #undef PIN
  #undef MX3
  #undef GAPA
  #undef SUMM
  #undef GAPB
  #undef EX
  #undef VRD
  #undef KRD
  #undef STEP
  #undef ENDW
  constexpr bool S16_=(KIND==0)&&(ATTN_NEWPIPE!=0)&&(PV==7||PV==8);
  if constexpr(S16_){ asm volatile("s_nop 15\n\ts_nop 7":"+v"(o2s));
    if((lane&7)==0){ const int qb=((lane&8)?16:0)+4*(lane>>4); _Pragma("unroll") for(int j=0;j<4;++j)wsf[32+qb+j]=o2s[j]; }
    asm volatile("s_waitcnt lgkmcnt(0)":::"memory"); }
  else if constexpr(MS_){ asm volatile("s_nop 15\n\ts_nop 7":"+v"(o2)); }
  else { auto rr=__builtin_amdgcn_permlane32_swap(__float_as_uint(l_reg),__float_as_uint(l_reg),false,false);l_reg=__uint_as_float(rr[0])+__uint_as_float(rr[1]); if(hi==0)wsf[32+r32]=l_reg;asm volatile("s_waitcnt lgkmcnt(0)":::"memory"); }
  float rli[16];
  #pragma unroll
  for(int r=0;r<16;++r)rli[r]=__builtin_amdgcn_rcpf((MS_&&!S16_)?o2[r]:wsf[32+crow(r,hi)]);
  bf16*Ow=J.O+(long)(wid*QBLK)*op;
  { bf16*stg=(bf16*)(shm+LDS_OST)+wid*2048;
    #pragma unroll
    for(int r=0;r<16;++r){const int orow=crow(r,hi);
      #pragma unroll
      for(int d0=0;d0<2;++d0)stg[orow*64+d0*32+r32]=__float2bfloat16(o[d0][r]*rli[r]);}
    asm volatile("s_waitcnt lgkmcnt(0)":::"memory");
    #pragma unroll
    for(int i=0;i<4;++i){const int row=i*8+(lane>>3),ch=lane&7; const u32x4 v=*(const u32x4*)(stg+row*64+ch*8); ATTN_STORE16(Ow+(long)row*op+ch*8,v);} }
  asm volatile("s_waitcnt lgkmcnt(0)\n\ts_barrier":::"memory");
  #undef DMA_K
  #undef KROW
  #undef DMA_V
  #undef CMASK
  #undef START
  #undef RESC
  #undef ROT
}
constexpr int ATTN_LDS_BYTES=92160+3*8192;
#undef SBAR
#undef WAIT_BAR
}

constexpr int NWAVES = 8;
constexpr int DM = 1024, NB = 2, SEQ = 8192, DEPTH = 4, CTXL = 256;
constexpr int M_LAT = NB * SEQ, M_CTX = NB * CTXL, M_ALL = M_LAT + M_CTX;
constexpr int INC = 4864;
constexpr int PXW = 1792;
constexpr int C_AQ = 0, C_AK = 512, C_AV = 640, C_BQ = 768, C_BK = 1024, C_BV = 1280, C_CU = 1536, C_G = 1792;
constexpr int DFF = 2816, DFFE = 3584, NE = 8;
constexpr int KVR = SEQ + CTXL;
constexpr int XG_ROWS = 36352;
constexpr float EPS = 1e-6f;
constexpr float C2F = 0.125f * 1.4426950408889634f;
constexpr float LOG2E = 1.4426950408889634f;

constexpr size_t MiB = 1u << 20;
constexpr size_t WS_CTL = 0, CTL_ZERO_BYTES = 32 * 1024;
constexpr size_t WS_MOD = 1 * MiB;
constexpr size_t WS_ROPE = WS_MOD + 512 * 1024;
constexpr size_t WS_CNT = WS_ROPE + 64 * 1024;
constexpr size_t WS_SEG = WS_CNT + 64 * 1024;
constexpr size_t WS_ROUTE = 2 * MiB;
constexpr size_t WS_SLOT = WS_ROUTE + 512 * 1024;
constexpr size_t WS_XC = 4 * MiB;
constexpr size_t WS_WINS = WS_XC;
constexpr size_t WS_W13S = WS_XC + 128 * 1024;
constexpr size_t WS_MW13S = WS_XC + 256 * 1024;
constexpr size_t WS_XNS = WS_XC + 768 * 1024;
constexpr size_t WS_XGS = WS_XC + 896 * 1024;
constexpr size_t WS_WIN = 6 * MiB;
constexpr size_t WS_WCAT = WS_WIN + (size_t)4 * INC * DM * 2;
constexpr size_t WS_WOUT = WS_WCAT + (size_t)4 * DM * DM * 2;
constexpr size_t WS_W13 = WS_WOUT + (size_t)4 * DM * DM * 2;
constexpr size_t WS_W2 = WS_W13 + (size_t)2 * 2 * DFF * DM * 2;
constexpr size_t WS_MW13 = WS_W2 + (size_t)2 * DM * DFF * 2;
constexpr size_t WS_MW2 = WS_MW13 + (size_t)2 * NE * 2 * DFFE * DM * 2;
constexpr size_t WS_XN = WS_MW2 + (size_t)2 * NE * DM * DFFE * 2;
constexpr size_t WS_XG = WS_XN + (size_t)M_ALL * DM * 2;
constexpr size_t WS_SL = WS_XG;
constexpr int SL_TILES = 10, SL_S = 7;
constexpr size_t WS_Y = WS_XG + (size_t)XG_ROWS * DM * 2;
constexpr size_t WS_XR = WS_Y + (size_t)XG_ROWS * DM * 2;
constexpr size_t WS_R = WS_XR + (size_t)M_ALL * DM * 2;
constexpr size_t WS_PX = WS_R;
constexpr size_t WS_GF = WS_PX + (size_t)M_ALL * PXW * 2;
constexpr size_t WS_KA = WS_GF + (size_t)66 * 12 * 131072;
constexpr size_t WS_KA8 = WS_KA + (size_t)M_ALL * 128 * 2;
constexpr size_t WS_VT8 = WS_KA8 + (size_t)M_ALL * 128;
constexpr size_t WS_YCAT = WS_VT8 + (size_t)264 * 2 * 4096;
constexpr size_t WS_MB = WS_YCAT + (size_t)M_ALL * DM * 2;
constexpr size_t WS_PART = WS_MB + (size_t)M_ALL * DM * 2;
constexpr size_t WS_END0 = WS_PART + (size_t)11 * M_CTX * DM * 4;
constexpr size_t WS_H = WS_R;
constexpr size_t WS_END = (WS_H + (size_t)XG_ROWS * DFFE * 2 > WS_END0) ? WS_H + (size_t)XG_ROWS * DFFE * 2 : WS_END0;
static_assert(WS_SEG + 64 <= WS_ROUTE && WS_SLOT + (size_t)M_ALL * 8 <= WS_XC && WS_XGS + (size_t)XG_ROWS * 4 <= WS_WIN && WS_MW13S + (size_t)16 * 7168 * 4 <= WS_XNS && WS_XNS + (size_t)M_ALL * 4 <= WS_XGS, "small tables");
constexpr int CW_BAR = 4096;
static_assert((CW_BAR + 3456) * 4 <= (int)CTL_ZERO_BYTES, "barrier words inside the per-call memset");

constexpr int RING_OFF = 0, RING_BYTES = 131072;
constexpr int LDSCTL_OFF = RING_BYTES, MISC_OFF = LDSCTL_OFF + 320;
constexpr int LDS_BYTES = 147456;
static_assert(attn_body::ATTN_LDS_BYTES <= RING_BYTES, "attention LDS");

#define GAS __attribute__((address_space(1)))
#define LAS __attribute__((address_space(3)))
typedef unsigned short bf16;
typedef unsigned v4u __attribute__((ext_vector_type(4)));
typedef unsigned v2u __attribute__((ext_vector_type(2)));
typedef float f32x4 __attribute__((ext_vector_type(4)));
typedef GAS unsigned gu32;
#define RLX_AGENT __ATOMIC_RELAXED, __HIP_MEMORY_SCOPE_AGENT
#define LDS_WAIT() asm volatile("s_waitcnt lgkmcnt(0)" ::: "memory")
#define VM_WAIT() asm volatile("s_waitcnt vmcnt(0)" ::: "memory")
__device__ __forceinline__ unsigned f2bf(float f) { unsigned u = __builtin_bit_cast(unsigned, f); return (u + 0x7fffu + ((u >> 16) & 1u)) >> 16; }
__device__ __forceinline__ unsigned pk2(float lo, float hi) { return f2bf(lo) | (f2bf(hi) << 16); }
__device__ __forceinline__ float bflo(unsigned w) { return __uint_as_float(w << 16); }
__device__ __forceinline__ float bfhi(unsigned w) { return __uint_as_float(w & 0xffff0000u); }
__device__ __forceinline__ unsigned ldu(const unsigned* p) { return __hip_atomic_load(p, RLX_AGENT); }
__device__ __forceinline__ float ldf(const float* p) { return __uint_as_float(__hip_atomic_load((const unsigned*)p, RLX_AGENT)); }
#define XB_TMO      128
#define XB_XCNT(j)  (256  + 64 * (j))
#define XB_XSUB(j)  (1280 + 64 * (j))
#define XB_XGEN(j)  (2304 + 64 * (j))
#define XB_TOP      3328
#define XB_TOPGEN   3392
#define XCD_BAR_WORDS 3456
#define XB_SPIN_CAP (1u << 18)

__device__ __forceinline__ unsigned xb_ld(unsigned* p)              { return __hip_atomic_load(p, __ATOMIC_RELAXED, __HIP_MEMORY_SCOPE_AGENT); }
__device__ __forceinline__ unsigned xb_add(unsigned* p, unsigned v) { return __hip_atomic_fetch_add(p, v, __ATOMIC_RELAXED, __HIP_MEMORY_SCOPE_AGENT); }
__device__ __forceinline__ unsigned xb_xcc_id() { return (unsigned)__builtin_amdgcn_s_getreg((3 << 11) | 20) & 0xFu; }
#define XB_SPIN(cond, bar) do { unsigned _sp = 0; while (cond) { \
    if ((++_sp & 255u) == 0u) { if (xb_ld(&(bar)[XB_TMO])) break; if (_sp > XB_SPIN_CAP) { atomicAdd(&(bar)[XB_TMO], 1u); break; } } } } while (0)

struct XcdBarrier {
    int w;
    unsigned* bar; unsigned x;
    volatile LAS unsigned* st;
};

__device__ __forceinline__ XcdBarrier xcd_barrier_post(unsigned* bar, volatile LAS unsigned* st) {
    XcdBarrier b; b.bar = bar; b.x = xb_xcc_id(); b.st = st; b.w = 0;
    if (threadIdx.x == 0) (void)xb_add(&bar[XB_XCNT(b.x)], 1u);
    return b;
}
__device__ __forceinline__ void xcd_barrier_complete(unsigned* bar, unsigned x, unsigned& nloc, unsigned& nx) {
    const unsigned G = gridDim.x * gridDim.y * gridDim.z;
    unsigned sum, cnt, mine, sp = 0u;
    for (;;) {
        sum = 0u; cnt = 0u; mine = 0u;
#pragma unroll
        for (unsigned j = 0; j < 16; ++j) { const unsigned c = xb_ld(&bar[XB_XCNT(j)]); sum += c; cnt += (c > 0u) ? 1u : 0u; mine = (j == x) ? c : mine; }
        if (sum == G) break;
        __builtin_amdgcn_s_sleep(1);
        if ((++sp & 255u) == 0u) { if (xb_ld(&bar[XB_TMO])) break; if (sp > XB_SPIN_CAP) { atomicAdd(&bar[XB_TMO], 1u); break; } }
    }
    nloc = mine > 0u ? mine : 1u; nx = cnt > 0u ? cnt : 1u;
}

__device__ __forceinline__ void xcd_barrier(const XcdBarrier& b) {
    asm volatile("s_waitcnt vmcnt(0)" ::: "memory");
    __syncthreads();
    int lane0_; asm volatile("v_mbcnt_lo_u32_b32 %0, -1, 0\n\tv_mbcnt_hi_u32_b32 %0, -1, %0" : "=v"(lane0_));
    if (b.w == 0 && lane0_ == 0) {
        unsigned* bar = b.bar;
        __builtin_amdgcn_s_waitcnt(0);
        unsigned nloc = b.st[0], nx = b.st[1];
        if (nloc == 0u) { xcd_barrier_complete(bar, b.x, nloc, nx); b.st[0] = nloc; b.st[1] = nx; }
        const unsigned old = xb_add(&bar[XB_XSUB(b.x)], 1u);
        const unsigned gen = old / nloc;
        if (old + 1u == (gen + 1u) * nloc) {
            __builtin_amdgcn_fence(__ATOMIC_RELEASE, "agent");
            asm volatile("s_waitcnt vmcnt(0)" ::: "memory");
            const unsigned og = xb_add(&bar[XB_TOP], 1u);
            const unsigned tg = og / nx;
            if (og + 1u == (tg + 1u) * nx) xb_add(&bar[XB_TOPGEN], 1u);
            else XB_SPIN(xb_ld(&bar[XB_TOPGEN]) == tg, bar);
            __builtin_amdgcn_fence(__ATOMIC_ACQUIRE, "agent");
            xb_add(&bar[XB_XGEN(b.x)], 1u);
            asm volatile("s_waitcnt vmcnt(0)" ::: "memory");
        } else {
            XB_SPIN(xb_ld(&bar[XB_XGEN(b.x)]) == gen, bar);
            __builtin_amdgcn_fence(__ATOMIC_ACQUIRE, "agent");
            asm volatile("s_waitcnt vmcnt(0)" ::: "memory");
        }
    }
    __syncthreads();
}

struct Args { const float* in[27]; float* out; unsigned char* ws; int ph_lo, ph_hi, single, pad; };
enum { I_X = 0, I_C, I_CTX, I_CCTX, I_WMOD, I_BMOD, I_N1G, I_N2G, I_WIN, I_QG, I_KG, I_RELB, I_POOLW, I_POOLS, I_WPA, I_WPB, I_WPC, I_WOUT,
       I_FW1, I_FW3, I_FW2, I_RW, I_RB, I_MW1, I_MW3, I_MW2, I_FING };

typedef __attribute__((address_space(4))) const unsigned char* karg_t;
__device__ __forceinline__ unsigned long long karg_u64(int off) { karg_t kp = (karg_t)__builtin_amdgcn_kernarg_segment_ptr(); return *(volatile __attribute__((address_space(4))) const unsigned long long*)(kp + off); }
#define KIN(i) ((const float*)karg_u64(8 * (i)))
#define KOUT() ((float*)karg_u64(8 * 27))
#define KWS() ((unsigned char*)karg_u64(8 * 28))

struct Frame {
    LAS unsigned char* lds;
    volatile LAS unsigned* MISC;
    int wave, vcu, G;
};
__device__ __forceinline__ int lane_id_l() { int l; asm volatile("v_mbcnt_lo_u32_b32 %0, -1, 0\n\tv_mbcnt_hi_u32_b32 %0, -1, %0" : "=v"(l)); return l; }

template <int M> __device__ __forceinline__ float xshfl(float v) { return __int_as_float(__builtin_amdgcn_ds_swizzle(__float_as_int(v), 0x1f | (M << 10))); }
__device__ __forceinline__ float silu_f(float v) { return v / (1.0f + __expf(-v)); }

__device__ __forceinline__ unsigned cvtpk(float lo, float hi) { unsigned r; asm volatile("v_cvt_pk_bf16_f32 %0, %1, %2" : "=v"(r) : "v"(lo), "v"(hi)); return r; }
__device__ __forceinline__ void p0_transpose_item(const float* W, int K, int N, bf16* WT, int ldt, int koff, int mode, int item, int lane, int sc_lo = 0, int sc_hi = 0) {
    const int nblk = N / 64, kb = item / nblk, nb = item % nblk, k0 = 64 * kb, n0 = 64 * nb;
    const int ng = lane & 15, kg = lane >> 4;
    const float* src = W + (size_t)(k0 + 16 * kg) * N + n0 + 4 * ng;
    f32x4 v[16];
#pragma unroll
    for (int j = 0; j < 16; ++j) v[j] = __builtin_nontemporal_load((const GAS f32x4*)(src + (size_t)j * N));
    const int nbase = n0 + 4 * ng; const int drow = mode == 0 ? nbase : ((nbase >> 7) * 256 + (mode == 2 ? 128 : 0) + (nbase & 127));
    if (nbase >= sc_lo && nbase < sc_hi) {
#pragma unroll
        for (int j = 0; j < 16; ++j) v[j] = v[j] * C2F; }
    bf16* dst = WT + (size_t)drow * ldt + koff + k0 + 16 * kg;
#pragma unroll
    for (int c = 0; c < 4; ++c) {
        v4u o0, o1;
        o0.x = cvtpk(v[0][c], v[1][c]); o0.y = cvtpk(v[2][c], v[3][c]); o0.z = cvtpk(v[4][c], v[5][c]); o0.w = cvtpk(v[6][c], v[7][c]);
        o1.x = cvtpk(v[8][c], v[9][c]); o1.y = cvtpk(v[10][c], v[11][c]); o1.z = cvtpk(v[12][c], v[13][c]); o1.w = cvtpk(v[14][c], v[15][c]);
        *(GAS v4u*)(dst + (size_t)c * ldt) = o0; *(GAS v4u*)(dst + (size_t)c * ldt + 8) = o1; }
}
constexpr float WSC8 = 64.0f; constexpr int WSC8_E8M0 = 0x79797979;
constexpr float HSC8 = 4.0f;  constexpr int HSC8_E8M0 = 0x7D7D7D7D;
__device__ __forceinline__ float c448(float v) { return __builtin_fminf(__builtin_fmaxf(v, -448.f), 448.f); }
__device__ __forceinline__ unsigned pk8(float a, float b, float c, float d) { a = c448(a); b = c448(b); c = c448(c); d = c448(d); unsigned w = 0u; w = __builtin_amdgcn_cvt_pk_fp8_f32(a, b, w, false); w = __builtin_amdgcn_cvt_pk_fp8_f32(c, d, w, true); return w; }
__device__ __forceinline__ void p0_transpose8_item(const float* W, int K, int N, unsigned char* W8, int ldt, int mode, int item, int lane) {
    const int nblk = N / 64, kb = item / nblk, nb = item % nblk, k0 = 64 * kb, n0 = 64 * nb;
    const int ng = lane & 15, kg = lane >> 4;
    const float* src = W + (size_t)(k0 + 16 * kg) * N + n0 + 4 * ng;
    f32x4 v[16];
#pragma unroll
    for (int j = 0; j < 16; ++j) v[j] = __builtin_nontemporal_load((const GAS f32x4*)(src + (size_t)j * N)) * WSC8;
    const int nbase = n0 + 4 * ng; const int drow = mode == 0 ? nbase : ((nbase >> 7) * 256 + (mode == 2 ? 128 : 0) + (nbase & 127));
    unsigned char* dst = W8 + (size_t)drow * ldt + k0 + 16 * kg;
#pragma unroll
    for (int c = 0; c < 4; ++c) {
        v4u o; o.x = pk8(v[0][c], v[1][c], v[2][c], v[3][c]); o.y = pk8(v[4][c], v[5][c], v[6][c], v[7][c]); o.z = pk8(v[8][c], v[9][c], v[10][c], v[11][c]); o.w = pk8(v[12][c], v[13][c], v[14][c], v[15][c]);
        *(GAS v4u*)(dst + (size_t)c * ldt) = o; }
}
__device__ __forceinline__ unsigned pk_i8(float a, float b, float c, float d) { const int ia = (int)__builtin_rintf(a), ib = (int)__builtin_rintf(b), ic = (int)__builtin_rintf(c), id = (int)__builtin_rintf(d);
    return ((unsigned)ia & 0xffu) | (((unsigned)ib & 0xffu) << 8) | (((unsigned)ic & 0xffu) << 16) | ((unsigned)id << 24); }
__device__ __forceinline__ float xmax32(float v) { auto rr = __builtin_amdgcn_permlane32_swap(__float_as_uint(v), __float_as_uint(v), false, false); return __builtin_fmaxf(__uint_as_float(rr[0]), __uint_as_float(rr[1])); }
__device__ __forceinline__ void p0_quant_strip(Frame& F, const float* W, int N, unsigned char* W8, float* WSc, int mode, int strip, int lane, int par, int sc_lo = 0, int sc_hi = 0) {
    const int n0 = 64 * strip, ng = lane & 15, kg = lane >> 4;
    f32x4 v[2][16];
#pragma unroll
    for (int jb = 0; jb < 2; ++jb) { const float* src = W + (size_t)(64 * (2 * F.wave + jb) + 16 * kg) * N + n0 + 4 * ng;
#pragma unroll
        for (int j = 0; j < 16; ++j) v[jb][j] = __builtin_nontemporal_load((const GAS f32x4*)(src + (size_t)j * N)); }
    f32x4 mx = (f32x4){0.f, 0.f, 0.f, 0.f};
#pragma unroll
    for (int jb = 0; jb < 2; ++jb)
#pragma unroll
        for (int j = 0; j < 16; ++j)
#pragma unroll
            for (int c = 0; c < 4; ++c) mx[c] = __builtin_fmaxf(mx[c], __builtin_fabsf(v[jb][j][c]));
#pragma unroll
    for (int c = 0; c < 4; ++c) { mx[c] = __builtin_fmaxf(mx[c], xshfl<16>(mx[c])); mx[c] = xmax32(mx[c]); }
    LAS float* red = (LAS float*)(F.lds + RING_OFF) + (par & 1) * 512;
    if (kg == 0) *(LAS f32x4*)(red + F.wave * 64 + 4 * ng) = mx;
    __syncthreads();
    f32x4 m = *(const LAS f32x4*)(red + 4 * ng);
#pragma unroll
    for (int w = 1; w < 8; ++w) { const f32x4 t = *(const LAS f32x4*)(red + w * 64 + 4 * ng);
#pragma unroll
        for (int c = 0; c < 4; ++c) m[c] = __builtin_fmaxf(m[c], t[c]); }
    f32x4 inv;
#pragma unroll
    for (int c = 0; c < 4; ++c) inv[c] = m[c] > 0.f ? 127.0f / m[c] : 0.f;
    const int nbase = n0 + 4 * ng; const int drow = mode == 0 ? nbase : ((nbase >> 7) * 256 + (mode == 2 ? 128 : 0) + (nbase & 127));
#pragma unroll
    for (int jb = 0; jb < 2; ++jb) { unsigned char* dst = W8 + (size_t)drow * DM + 64 * (2 * F.wave + jb) + 16 * kg;
#pragma unroll
        for (int c = 0; c < 4; ++c) { v4u o;
            o.x = pk_i8(v[jb][0][c] * inv[c], v[jb][1][c] * inv[c], v[jb][2][c] * inv[c], v[jb][3][c] * inv[c]);    o.y = pk_i8(v[jb][4][c] * inv[c], v[jb][5][c] * inv[c], v[jb][6][c] * inv[c], v[jb][7][c] * inv[c]);
            o.z = pk_i8(v[jb][8][c] * inv[c], v[jb][9][c] * inv[c], v[jb][10][c] * inv[c], v[jb][11][c] * inv[c]); o.w = pk_i8(v[jb][12][c] * inv[c], v[jb][13][c] * inv[c], v[jb][14][c] * inv[c], v[jb][15][c] * inv[c]);
            *(GAS v4u*)(dst + (size_t)c * DM) = o; } }
    if (F.wave == 0 && kg == 0) { const float f = (nbase >= sc_lo && nbase < sc_hi) ? C2F * (1.0f / 127.0f) : (1.0f / 127.0f);
        f32x4 sc; sc[0] = m[0] * f; sc[1] = m[1] * f; sc[2] = m[2] * f; sc[3] = m[3] * f; *(GAS f32x4*)(WSc + drow) = sc; }
}
__device__ __forceinline__ void p0_prologue(Frame& F, const Args& a) {
    unsigned char* ws = KWS(); const int lane = lane_id_l(), tid = F.wave * 64 + lane; (void)tid;
    const int gw = F.vcu * NWAVES + F.wave, NGW = F.G * NWAVES;
    { LAS float* red = (LAS float*)(F.lds + RING_OFF);
      LAS float* SL = (LAS float*)(F.lds + RING_OFF + 8192);
      for (int i = tid; i < 3 * DM; i += NWAVES * 64) SL[i] = silu_f(i < 2 * DM ? KIN(I_C)[i] : KIN(I_CCTX)[i - 2 * DM]);
      for (int it = F.vcu; it < 4 * 96; it += F.G) {
          __syncthreads();
          const int l = it / 96, n = (it % 96) * 64 + lane;
          const float* wm = KIN(I_WMOD) + (size_t)l * DM * 6144 + n;
          float a0 = 0.f, a1 = 0.f, a2 = 0.f;
          const int k0 = F.wave * 128;
#pragma unroll 8
          for (int k = k0; k < k0 + 128; k += 4) { const f32x4 s0 = *(const LAS f32x4*)(SL + k), s1 = *(const LAS f32x4*)(SL + DM + k), s2 = *(const LAS f32x4*)(SL + 2 * DM + k);
#pragma unroll
              for (int q = 0; q < 4; ++q) { const float w = wm[(size_t)(k + q) * 6144]; a0 += s0[q] * w; a1 += s1[q] * w; a2 += s2[q] * w; } }
          red[(F.wave * 3 + 0) * 64 + lane] = a0; red[(F.wave * 3 + 1) * 64 + lane] = a1; red[(F.wave * 3 + 2) * 64 + lane] = a2;
          __syncthreads();
          if (F.wave < 3) { float s = 0.f;
#pragma unroll
              for (int w = 0; w < 8; ++w) s += red[(w * 3 + F.wave) * 64 + lane];
              ((float*)(ws + WS_MOD))[((size_t)l * 3 + F.wave) * 6144 + n] = s + KIN(I_BMOD)[l * 6144 + n]; }
      }
      __syncthreads(); }
    { constexpr int S0 = INC / 64, S4 = DFF / 64, S7 = DFFE / 64;
      constexpr int NSTRIPS = 4 * S0 + 2 * 2 * S4 + 8 * 2 * S7;
      __syncthreads();
      int par = 0;
      for (int st = F.G - 1 - F.vcu; st < NSTRIPS; st += F.G, ++par) {
          int r = st;
          if (r < 4 * S0) { const int l = r / S0; p0_quant_strip(F, KIN(I_WIN) + (size_t)l * DM * INC, INC, (unsigned char*)(ws + WS_WIN) + (size_t)l * INC * DM, (float*)(ws + WS_WINS) + l * INC, 0, r % S0, lane, par, C_BQ, C_BK); continue; } r -= 4 * S0;
          if (r < 2 * S4) { const int l = r / S4; p0_quant_strip(F, KIN(I_FW1) + (size_t)l * DM * DFF, DFF, (unsigned char*)(ws + WS_W13) + (size_t)l * 2 * DFF * DM, (float*)(ws + WS_W13S) + l * 2 * DFF, 1, r % S4, lane, par); continue; } r -= 2 * S4;
          if (r < 2 * S4) { const int l = r / S4; p0_quant_strip(F, KIN(I_FW3) + (size_t)l * DM * DFF, DFF, (unsigned char*)(ws + WS_W13) + (size_t)l * 2 * DFF * DM, (float*)(ws + WS_W13S) + l * 2 * DFF, 2, r % S4, lane, par); continue; } r -= 2 * S4;
          if (r < 8 * S7) { const int l = r / S7; p0_quant_strip(F, KIN(I_MW1) + (size_t)l * DM * DFFE, DFFE, (unsigned char*)(ws + WS_MW13) + (size_t)l * 2 * DFFE * DM, (float*)(ws + WS_MW13S) + l * 2 * DFFE, 1, r % S7, lane, par); continue; } r -= 8 * S7;
          { const int l = r / S7; p0_quant_strip(F, KIN(I_MW3) + (size_t)l * DM * DFFE, DFFE, (unsigned char*)(ws + WS_MW13) + (size_t)l * 2 * DFFE * DM, (float*)(ws + WS_MW13S) + l * 2 * DFFE, 2, r % S7, lane, par); }
      }
      __syncthreads(); }
    constexpr int I1 = (512 / 64) * (DM / 64), I2 = (256 / 64) * (DM / 64), I3 = (DM / 64) * (DM / 64), I6 = (DFF / 64) * (DM / 64), I9 = (DFFE / 64) * (DM / 64);
    constexpr int NITEMS = 4 * (I1 + I2 + I3) + 2 * I6 + 8 * I9;
    for (int it = (gw + NGW / 2) % NGW; it < NITEMS; it += NGW) {
        int r = it;
        if (r < 4 * I1) { const int l = r / I1; p0_transpose_item(KIN(I_WPA) + (size_t)l * 512 * DM, 512, DM, (bf16*)(ws + WS_WCAT) + (size_t)l * DM * DM, DM, 0, 0, r % I1, lane); continue; } r -= 4 * I1;
        if (r < 4 * I2) { const int l = r / I2; p0_transpose_item(KIN(I_WPB) + (size_t)l * 256 * DM, 256, DM, (bf16*)(ws + WS_WCAT) + (size_t)l * DM * DM, DM, 512, 0, r % I2, lane); continue; } r -= 4 * I2;
        if (r < 4 * I3) { const int l = r / I3; p0_transpose_item(KIN(I_WOUT) + (size_t)l * DM * DM, DM, DM, (bf16*)(ws + WS_WOUT) + (size_t)l * DM * DM, DM, 0, 0, r % I3, lane); continue; } r -= 4 * I3;
        if (r < 2 * I6) { const int l = r / I6; p0_transpose8_item(KIN(I_FW2) + (size_t)l * DFF * DM, DFF, DM, (unsigned char*)(ws + WS_W2) + (size_t)l * DM * DFF, DFF, 0, r % I6, lane); continue; } r -= 2 * I6;
        { const int l = r / I9; p0_transpose8_item(KIN(I_MW2) + (size_t)l * DFFE * DM, DFFE, DM, (unsigned char*)(ws + WS_MW2) + (size_t)l * DM * DFFE, DFFE, 0, r % I9, lane); }
    }
    for (int it = gw; it < 4 * 4 * 8 * 16; it += NGW) {
        const int nchunk = it & 15, c8 = (it >> 4) & 7, g = (it >> 7) & 3, l = it >> 9;
        const int n = nchunk * 64 + lane;
        const float* pw = KIN(I_POOLW) + ((size_t)(l * 4 + g) * 64 + c8 * 8) * 64;
        const float* ps = KIN(I_POOLS) + l * 256 + g * 64;
        const float* wc = KIN(I_WPC) + ((size_t)l * 256 + g * 64) * DM + n;
        float acc[8];
#pragma unroll
        for (int cc = 0; cc < 8; ++cc) acc[cc] = 0.f;
        for (int j = 0; j < 64; ++j) { const float s = ps[j] * wc[(size_t)j * DM];
#pragma unroll
            for (int cc = 0; cc < 8; ++cc) acc[cc] += pw[cc * 64 + j] * s; }
        v4u o; o.x = pk2(acc[0], acc[1]); o.y = pk2(acc[2], acc[3]); o.z = pk2(acc[4], acc[5]); o.w = pk2(acc[6], acc[7]);
        *(GAS v4u*)((bf16*)(ws + WS_WCAT) + (size_t)l * DM * DM + (size_t)n * DM + 768 + g * 64 + c8 * 8) = o;
    }
    { const int gt = gw * 64 + lane;
      if (gt < 128 * 16) { const int pos = gt >> 4, i = gt & 15; const float inv = powf(10000.0f, -(float)(2 * i) / 32.0f); const float ang = (float)pos * inv;
          float* rp = (float*)(ws + WS_ROPE) + gt * 2; rp[0] = cosf(ang); rp[1] = sinf(ang); } }
}

constexpr int MOE2_STRIPS = 8 * 2 * (DFFE / 64), MOE2_ITEMS = 8 * (DFFE / 64) * (DM / 64);
__device__ __forceinline__ void moe2_convert(Frame& F, const Args& a, int wgslot, int nwgslots) {
    unsigned char* ws = KWS(); const int lane = lane_id_l();
    constexpr int S7 = DFFE / 64, I9 = (DFFE / 64) * (DM / 64);
    __syncthreads();
    int par = 0;
    for (int st = wgslot; st < MOE2_STRIPS; st += nwgslots, ++par) {
        int r = st;
        if (r < 8 * S7) { const int l = 8 + r / S7; p0_quant_strip(F, KIN(I_MW1) + (size_t)l * DM * DFFE, DFFE, (unsigned char*)(ws + WS_MW13) + (size_t)l * 2 * DFFE * DM, (float*)(ws + WS_MW13S) + l * 2 * DFFE, 1, r % S7, lane, par); continue; } r -= 8 * S7;
        { const int l = 8 + r / S7; p0_quant_strip(F, KIN(I_MW3) + (size_t)l * DM * DFFE, DFFE, (unsigned char*)(ws + WS_MW13) + (size_t)l * 2 * DFFE * DM, (float*)(ws + WS_MW13S) + l * 2 * DFFE, 2, r % S7, lane, par); }
    }
    __syncthreads();
    const int sbase = MOE2_STRIPS / nwgslots, sextra = MOE2_STRIPS % nwgslots;
    const bool heavy_full = sextra > 0 && (sbase + 1) * 16 * nwgslots >= MOE2_STRIPS * 16 + MOE2_ITEMS;
    int k = wgslot, cnt = nwgslots;
    if (heavy_full) { if (wgslot < sextra) return; k = wgslot - sextra; cnt = nwgslots - sextra; }
    for (int J = k * NWAVES + F.wave; J < MOE2_ITEMS; J += cnt * NWAVES) { const int l = 8 + J / I9;
        p0_transpose8_item(KIN(I_MW2) + (size_t)l * DFFE * DM, DFFE, DM, (unsigned char*)(ws + WS_MW2) + (size_t)l * DM * DFFE, DFFE, 0, J % I9, lane); }
}

struct RowIO { const float* flat; const float* fctx; bf16* xr; int lat_f32, ctx_f32; };
template <bool COMBINE, bool ROUTER, bool FINAL>
__device__ __forceinline__ void norm_rows(Frame& F, const Args& a, int nrows, RowIO io, const float* ng, const float* modl, int seg_sh, int seg_sc,
                                          const float* modprev, const float* rw, const float* rb, float* fout, const float* part = nullptr, int nparts = 0) {
    unsigned char* ws = KWS();
    const int lane = lane_id_l(), tid = F.wave * 64 + lane; (void)tid; const int gw = F.vcu * NWAVES + F.wave, NGW = F.G * NWAVES;
    const int hl = lane & 31, hh = lane >> 5;
    bf16* XN = (bf16*)(ws + WS_XN); const bf16* Y = (const bf16*)(ws + WS_Y);
    LAS unsigned* cntL = (LAS unsigned*)(F.lds + RING_OFF);
    int tm = 0; if (COMBINE) { const int T = (int)ldu((const unsigned*)(ws + WS_SEG) + 7); const int nt_ = min(max(T - 128, 0), SL_TILES); tm = T - nt_; }
    LAS float* rwL = (LAS float*)(F.lds + RING_OFF + 4096);
    LAS float* GSl = (LAS float*)(F.lds + RING_OFF + 40960); LAS float* SHl = (LAS float*)(F.lds + RING_OFF + 53248); LAS float* G2l = (LAS float*)(F.lds + RING_OFF + 65536);
    v2u pre[5][8]; bool use_pre = false;
    if constexpr (!COMBINE && !FINAL) { if (io.lat_f32 == 0 && io.ctx_f32 == 0 && nrows <= 10 * NGW) { use_pre = true;
#pragma unroll
        for (int k = 0; k < 5; ++k) { const int p = gw + k * NGW; if (2 * p < nrows) { const bf16* s__ = io.xr + (size_t)(2 * p + hh) * DM;
#pragma unroll
            for (int j = 0; j < 8; ++j) pre[k][j] = *(const GAS v2u*)(s__ + 4 * hl + 128 * j); } } } }
    __syncthreads();
    for (int i = tid; i < 3 * DM; i += NWAVES * 64) { const int m_ = i >> 10, c_ = i & 1023;
        if (FINAL) { GSl[i] = ng[c_]; } else { GSl[i] = ng[c_] * (1.0f + modl[m_ * 6144 + seg_sc * DM + c_]); SHl[i] = modl[m_ * 6144 + seg_sh * DM + c_]; }
        if (COMBINE) G2l[i] = modprev[m_ * 6144 + 5 * DM + c_]; }
    __syncthreads();
    if (ROUTER) { __syncthreads(); if (tid < 64) cntL[tid] = 0u;
        for (int i = tid; i < DM * 8 / 4; i += NWAVES * 64) *(LAS f32x4*)(rwL + 4 * i) = *(const GAS f32x4*)(rw + 4 * i);
        __syncthreads(); }
    f32x4 vnf[8]; v2u vnh[8];
#define NR_LOAD(rr) do { const int r__ = (rr); const bool lat__ = r__ < M_LAT; const bool f32__ = lat__ ? (io.lat_f32 != 0) : (io.ctx_f32 != 0); \
        if (f32__) { const float* s__ = lat__ ? io.flat + (size_t)r__ * DM : io.fctx + (size_t)(r__ - M_LAT) * DM; \
            _Pragma("unroll") for (int j = 0; j < 8; ++j) vnf[j] = *(const GAS f32x4*)(s__ + 4 * hl + 128 * j); } \
        else { const bf16* s__ = io.xr + (size_t)r__ * DM; \
            _Pragma("unroll") for (int j = 0; j < 8; ++j) vnh[j] = *(const GAS v2u*)(s__ + 4 * hl + 128 * j); } } while (0)
#define NR_TAIL() \
        if (!COMBINE && !FINAL) { if (nparts > 0 && !lat) { \
            for (int s = 0; s < nparts; ++s) { \
_Pragma("unroll") \
                for (int j = 0; j < 8; ++j) v[j] = v[j] + *(const GAS f32x4*)(part + ((size_t)s * M_CTX + (r - M_LAT)) * DM + 4 * hl + 128 * j); } \
            bf16* dst = io.xr + (size_t)r * DM; \
_Pragma("unroll") \
            for (int j = 0; j < 8; ++j) { v2u o; o.x = pk2(v[j][0], v[j][1]); o.y = pk2(v[j][2], v[j][3]); *(GAS v2u*)(dst + 4 * hl + 128 * j) = o; } } } \
        float ss = 0.f; \
_Pragma("unroll") \
        for (int j = 0; j < 8; ++j) ss += (v[j][0] * v[j][0] + v[j][1] * v[j][1]) + (v[j][2] * v[j][2] + v[j][3] * v[j][3]); \
        ss += xshfl<1>(ss); ss += xshfl<2>(ss); ss += xshfl<4>(ss); ss += xshfl<8>(ss); ss += xshfl<16>(ss); \
        const float rstd = 1.0f / sqrtf(ss * (1.0f / DM) + EPS); \
        if (FINAL) { \
_Pragma("unroll") \
            for (int j = 0; j < 8; ++j) { const int c = 4 * hl + 128 * j; const f32x4 g = *(const LAS f32x4*)(GSl + c); *(GAS f32x4*)(fout + (size_t)r * DM + c) = v[j] * rstd * g; } \
            continue; \
        } \
        float lg[8]; \
        if (ROUTER) { \
_Pragma("unroll") \
            for (int e = 0; e < 8; ++e) lg[e] = 0.f; } \
        if constexpr (ROUTER) { \
_Pragma("unroll") \
            for (int j = 0; j < 8; ++j) { const int c = 4 * hl + 128 * j; \
                const f32x4 gs = *(const LAS f32x4*)(GSl + mrow * DM + c), s0 = *(const LAS f32x4*)(SHl + mrow * DM + c); \
                f32x4 h = v[j] * rstd * gs + s0; \
                v2u o; o.x = pk2(h[0], h[1]); o.y = pk2(h[2], h[3]); \
                *(GAS v2u*)(XN + (size_t)r * DM + c) = o; \
_Pragma("unroll") \
                for (int q = 0; q < 4; ++q) { const f32x4 wa = *(const LAS f32x4*)(rwL + (c + q) * 8), wb = *(const LAS f32x4*)(rwL + (c + q) * 8 + 4); \
                    lg[0] += h[q] * wa[0]; lg[1] += h[q] * wa[1]; lg[2] += h[q] * wa[2]; lg[3] += h[q] * wa[3]; \
                    lg[4] += h[q] * wb[0]; lg[5] += h[q] * wb[1]; lg[6] += h[q] * wb[2]; lg[7] += h[q] * wb[3]; } } \
        } else { \
        float mxh = 0.f; \
_Pragma("unroll") \
        for (int j = 0; j < 8; ++j) { const int c = 4 * hl + 128 * j; \
            const f32x4 gs = *(const LAS f32x4*)(GSl + mrow * DM + c), s0 = *(const LAS f32x4*)(SHl + mrow * DM + c); \
            const f32x4 h = v[j] * rstd * gs + s0; \
            mxh = __builtin_fmaxf(__builtin_fmaxf(mxh, __builtin_fmaxf(__builtin_fabsf(h[0]), __builtin_fabsf(h[1]))), __builtin_fmaxf(__builtin_fabsf(h[2]), __builtin_fabsf(h[3]))); } \
        mxh = __builtin_fmaxf(mxh, xshfl<1>(mxh)); mxh = __builtin_fmaxf(mxh, xshfl<2>(mxh)); mxh = __builtin_fmaxf(mxh, xshfl<4>(mxh)); mxh = __builtin_fmaxf(mxh, xshfl<8>(mxh)); mxh = __builtin_fmaxf(mxh, xshfl<16>(mxh)); \
        { const float qi = mxh > 0.f ? 127.0f / mxh : 0.f; unsigned char* XN8 = (unsigned char*)XN + (size_t)r * DM; \
_Pragma("unroll") \
          for (int j = 0; j < 8; ++j) { int c = 4 * hl + 128 * j; asm volatile("" : "+v"(c)); \
              const f32x4 gs = *(const LAS f32x4*)(GSl + mrow * DM + c), s0 = *(const LAS f32x4*)(SHl + mrow * DM + c); const f32x4 h = v[j] * rstd * gs + s0; \
              *(GAS unsigned*)(XN8 + c) = pk_i8(h[0] * qi, h[1] * qi, h[2] * qi, h[3] * qi); } \
          if (hl == 0) ((float*)(ws + WS_XNS))[r] = mxh * (1.0f / 127.0f); } \
        } \
        if (ROUTER) { \
_Pragma("unroll") \
            for (int e = 0; e < 8; ++e) { \
                lg[e] += xshfl<1>(lg[e]); lg[e] += xshfl<2>(lg[e]); lg[e] += xshfl<4>(lg[e]); lg[e] += xshfl<8>(lg[e]); lg[e] += xshfl<16>(lg[e]); \
                lg[e] += rb[e]; } \
            int e0 = 0; float v0 = lg[0]; \
_Pragma("unroll") \
            for (int e = 1; e < 8; ++e) if (lg[e] > v0) { v0 = lg[e]; e0 = e; } \
            int e1 = -1; float v1 = -INFINITY; \
_Pragma("unroll") \
            for (int e = 0; e < 8; ++e) if (e != e0 && lg[e] > v1) { v1 = lg[e]; e1 = e; } \
            const float p0 = 1.0f / (1.0f + __expf(v1 - v0)), p1 = 1.0f - p0; \
            if (hl == 0) { v4u o; o.x = (unsigned)e0 | ((unsigned)e1 << 8); o.y = __float_as_uint(p0); o.z = __float_as_uint(p1); o.w = 0u; \
                *(GAS v4u*)((unsigned*)(ws + WS_ROUTE) + 4 * r) = o; \
                __hip_atomic_fetch_add(cntL + F.wave * 8 + e0, 1u, __ATOMIC_RELAXED, __HIP_MEMORY_SCOPE_WORKGROUP); __hip_atomic_fetch_add(cntL + F.wave * 8 + e1, 1u, __ATOMIC_RELAXED, __HIP_MEMORY_SCOPE_WORKGROUP); } \
        }
    if (use_pre) {
#pragma unroll
        for (int k = 0; k < 5; ++k) { const int p = gw + k * NGW; if (2 * p >= nrows) continue;
            const int r = 2 * p + hh; const bool lat = r < M_LAT; const int mrow = lat ? (r >> 13) : 2;
            f32x4 v[8];
#pragma unroll
            for (int j = 0; j < 8; ++j) { v[j][0] = bflo(pre[k][j].x); v[j][1] = bfhi(pre[k][j].x); v[j][2] = bflo(pre[k][j].y); v[j][3] = bfhi(pre[k][j].y); }
            NR_TAIL()
        }
    } else {
    if (2 * gw < nrows) NR_LOAD(2 * gw + hh);
    for (int p = gw; 2 * p < nrows; p += NGW) {
        const int r = 2 * p + hh;
        const bool lat = r < M_LAT; const int mrow = lat ? (r >> 13) : 2;
        f32x4 v[8];
        if (lat ? (io.lat_f32 != 0) : (io.ctx_f32 != 0)) {
#pragma unroll
            for (int j = 0; j < 8; ++j) v[j] = vnf[j]; }
        else {
#pragma unroll
            for (int j = 0; j < 8; ++j) { v[j][0] = bflo(vnh[j].x); v[j][1] = bfhi(vnh[j].x); v[j][2] = bflo(vnh[j].y); v[j][3] = bfhi(vnh[j].y); } }
        if (2 * (p + NGW) < nrows) NR_LOAD(2 * (p + NGW) + hh);
        if (COMBINE) {
            const unsigned p0 = ldu((const unsigned*)(ws + WS_SLOT) + 2 * r), p1 = ldu((const unsigned*)(ws + WS_SLOT) + 2 * r + 1);
            const float w0 = ldf((const float*)(ws + WS_ROUTE) + 4 * r + 1), w1 = ldf((const float*)(ws + WS_ROUTE) + 4 * r + 2);
            const bool t0 = (int)(p0 >> 8) >= tm, t1 = (int)(p1 >> 8) >= tm;
            const bf16* SL = (const bf16*)(ws + WS_SL);
            v2u ya[8], yb[8];
#pragma unroll
            for (int j = 0; j < 8; ++j) { ya[j] = *(const GAS v2u*)(Y + (size_t)p0 * DM + 4 * hl + 128 * j); yb[j] = *(const GAS v2u*)(Y + (size_t)p1 * DM + 4 * hl + 128 * j); }
            f32x4 fa[8], fb[8];
#pragma unroll
            for (int j = 0; j < 8; ++j) { fa[j][0] = bflo(ya[j].x); fa[j][1] = bfhi(ya[j].x); fa[j][2] = bflo(ya[j].y); fa[j][3] = bfhi(ya[j].y);
                                          fb[j][0] = bflo(yb[j].x); fb[j][1] = bfhi(yb[j].x); fb[j][2] = bflo(yb[j].y); fb[j][3] = bfhi(yb[j].y); }
            if (t0) {
#pragma unroll
                for (int j = 0; j < 8; ++j) { fa[j] = (f32x4){0.f, 0.f, 0.f, 0.f};
                    for (int s = 0; s < SL_S; ++s) { const v2u y = *(const GAS v2u*)(SL + ((size_t)s * SL_TILES * 256 + (p0 - (unsigned)tm * 256u)) * DM + 4 * hl + 128 * j); fa[j][0] += bflo(y.x); fa[j][1] += bfhi(y.x); fa[j][2] += bflo(y.y); fa[j][3] += bfhi(y.y); } } }
            if (t1) {
#pragma unroll
                for (int j = 0; j < 8; ++j) { fb[j] = (f32x4){0.f, 0.f, 0.f, 0.f};
                    for (int s = 0; s < SL_S; ++s) { const v2u y = *(const GAS v2u*)(SL + ((size_t)s * SL_TILES * 256 + (p1 - (unsigned)tm * 256u)) * DM + 4 * hl + 128 * j); fb[j][0] += bflo(y.x); fb[j][1] += bfhi(y.x); fb[j][2] += bflo(y.y); fb[j][3] += bfhi(y.y); } } }
#pragma unroll
            for (int j = 0; j < 8; ++j) { const f32x4 g = *(const LAS f32x4*)(G2l + mrow * DM + 4 * hl + 128 * j);
                v[j] = v[j] + g * (fa[j] * w0 + fb[j] * w1); }
            if (!FINAL) { bf16* dst = io.xr + (size_t)r * DM;
#pragma unroll
                for (int j = 0; j < 8; ++j) { v2u o; o.x = pk2(v[j][0], v[j][1]); o.y = pk2(v[j][2], v[j][3]); *(GAS v2u*)(dst + 4 * hl + 128 * j) = o; } }
        }
        NR_TAIL()
    }
    }
    if (ROUTER) { __syncthreads(); if (tid < 64) ((unsigned*)(ws + WS_CNT))[F.vcu * 64 + tid] = cntL[tid]; __syncthreads(); }
#undef NR_LOAD
#undef NR_TAIL
}

__device__ __forceinline__ void moe_gather(Frame& F, const Args& a, int nrows) {
    unsigned char* ws = KWS();
    const int lane = lane_id_l(), tid = F.wave * 64 + lane; (void)tid; const int gw = F.vcu * NWAVES + F.wave, NGW = F.G * NWAVES;
    v4u xpa[10], xpb[10]; unsigned eep[10]; const bool pre_ok = nrows <= 10 * NGW;
    if (pre_ok) {
#pragma unroll
        for (int k = 0; k < 5; ++k) { const int r2 = 2 * (gw + k * NGW); if (r2 < nrows) {
#pragma unroll
            for (int q = 0; q < 2; ++q) { const int r = r2 + q; eep[2 * k + q] = ldu((const unsigned*)(ws + WS_ROUTE) + 4 * r);
                xpa[2 * k + q] = *(const GAS v4u*)((const bf16*)(ws + WS_XN) + (size_t)r * DM + 8 * lane); xpb[2 * k + q] = *(const GAS v4u*)((const bf16*)(ws + WS_XN) + (size_t)r * DM + 512 + 8 * lane); } } } }
    unsigned cvp[32]; const bool cnt_ok = NGW * 8 <= 32 * NWAVES * 64;
    if (cnt_ok) {
#pragma unroll
        for (int q = 0; q < 32; ++q) { const int idx = tid + q * NWAVES * 64; cvp[q] = idx < NGW * 8 ? ldu((const unsigned*)(ws + WS_CNT) + idx) : 0u; } }
    LAS unsigned* L = (LAS unsigned*)(F.lds + RING_OFF);
    __syncthreads();
    for (int i = tid; i < 208; i += NWAVES * 64) L[i] = 0u;
    __syncthreads();
    if (cnt_ok) {
        unsigned tot = 0u, low = 0u; const int e = tid & 7;
#pragma unroll
        for (int q = 0; q < 32; ++q) { const int idx = tid + q * NWAVES * 64; const unsigned v = cvp[q]; const int g = idx >> 3;
            tot += v; if (g < F.vcu * NWAVES) low += v;
            if (idx < NGW * 8 && (g >> 3) == F.vcu) L[16 + (g & 7) * 8 + e] = v; }
        __hip_atomic_fetch_add(L + e, tot, __ATOMIC_RELAXED, __HIP_MEMORY_SCOPE_WORKGROUP);
        __hip_atomic_fetch_add(L + 8 + e, low, __ATOMIC_RELAXED, __HIP_MEMORY_SCOPE_WORKGROUP);
    } else
    for (int idx = tid; idx < NGW * 8; idx += NWAVES * 64) { const unsigned v = ldu((const unsigned*)(ws + WS_CNT) + idx); const int g = idx >> 3, e = idx & 7;
        __hip_atomic_fetch_add(L + e, v, __ATOMIC_RELAXED, __HIP_MEMORY_SCOPE_WORKGROUP);
        if (g < F.vcu * NWAVES) __hip_atomic_fetch_add(L + 8 + e, v, __ATOMIC_RELAXED, __HIP_MEMORY_SCOPE_WORKGROUP);
        if ((g >> 3) == F.vcu) L[16 + (g & 7) * 8 + e] = v; }
    __syncthreads();
    if (tid == 0) { unsigned t0 = 0u;
        for (int e = 0; e < 8; ++e) { unsigned base = t0 * 256u + L[8 + e];
            for (int w = 0; w < NWAVES; ++w) { L[80 + w * 8 + e] = base; base += L[16 + w * 8 + e]; }
            t0 += (L[e] + 255u) >> 8; if (F.vcu == 0) ((unsigned*)(ws + WS_SEG))[e] = t0; } }
    __syncthreads();
    const bf16* XN = (const bf16*)(ws + WS_XN); bf16* XG = (bf16*)(ws + WS_XG);
    auto copy_row = [&](const int r, const unsigned ee, const v4u x0, const v4u x1) {
        const int e0 = ee & 0xff, e1 = (ee >> 8) & 0xff;
        unsigned p0 = 0u, p1 = 0u;
        if (lane == 0) { const unsigned c0 = L[144 + F.wave * 8 + e0], c1 = L[144 + F.wave * 8 + e1];
                         p0 = L[80 + F.wave * 8 + e0] + c0; p1 = L[80 + F.wave * 8 + e1] + c1; L[144 + F.wave * 8 + e0] = c0 + 1u; L[144 + F.wave * 8 + e1] = c1 + 1u;
                         v2u o; o.x = p0; o.y = p1; *(GAS v2u*)((unsigned*)(ws + WS_SLOT) + 2 * r) = o; }
        LDS_WAIT(); asm volatile("" ::: "memory");
        p0 = __builtin_amdgcn_readfirstlane(p0); p1 = __builtin_amdgcn_readfirstlane(p1);
        float f[16]; f[0] = bflo(x0.x); f[1] = bfhi(x0.x); f[2] = bflo(x0.y); f[3] = bfhi(x0.y); f[4] = bflo(x0.z); f[5] = bfhi(x0.z); f[6] = bflo(x0.w); f[7] = bfhi(x0.w);
        f[8] = bflo(x1.x); f[9] = bfhi(x1.x); f[10] = bflo(x1.y); f[11] = bfhi(x1.y); f[12] = bflo(x1.z); f[13] = bfhi(x1.z); f[14] = bflo(x1.w); f[15] = bfhi(x1.w);
        float mx = 0.f;
#pragma unroll
        for (int i = 0; i < 16; ++i) mx = __builtin_fmaxf(mx, __builtin_fabsf(f[i]));
        mx = __builtin_fmaxf(mx, xshfl<1>(mx)); mx = __builtin_fmaxf(mx, xshfl<2>(mx)); mx = __builtin_fmaxf(mx, xshfl<4>(mx)); mx = __builtin_fmaxf(mx, xshfl<8>(mx)); mx = __builtin_fmaxf(mx, xshfl<16>(mx)); mx = xmax32(mx);
        const float qi = mx > 0.f ? 127.0f / mx : 0.f;
        v2u y0, y1; y0.x = pk_i8(f[0] * qi, f[1] * qi, f[2] * qi, f[3] * qi); y0.y = pk_i8(f[4] * qi, f[5] * qi, f[6] * qi, f[7] * qi);
        y1.x = pk_i8(f[8] * qi, f[9] * qi, f[10] * qi, f[11] * qi); y1.y = pk_i8(f[12] * qi, f[13] * qi, f[14] * qi, f[15] * qi);
        unsigned char* XG8 = (unsigned char*)XG;
        *(GAS v2u*)(XG8 + (size_t)p0 * DM + 8 * lane) = y0; *(GAS v2u*)(XG8 + (size_t)p0 * DM + 512 + 8 * lane) = y1;
        *(GAS v2u*)(XG8 + (size_t)p1 * DM + 8 * lane) = y0; *(GAS v2u*)(XG8 + (size_t)p1 * DM + 512 + 8 * lane) = y1;
        if (lane == 0) { const float sc = mx * (1.0f / 127.0f); ((float*)(ws + WS_XGS))[p0] = sc; ((float*)(ws + WS_XGS))[p1] = sc; }
    };
    if (pre_ok) {
#pragma unroll
        for (int kk = 0; kk < 10; ++kk) { const int r = 2 * (gw + (kk >> 1) * NGW) + (kk & 1); if (r < nrows) copy_row(r, eep[kk], xpa[kk], xpb[kk]); }
    } else {
        for (int r2 = 2 * gw; r2 < nrows; r2 += 2 * NGW) for (int r = r2; r < r2 + 2; ++r)
            copy_row(r, ldu((const unsigned*)(ws + WS_ROUTE) + 4 * r), *(const GAS v4u*)(XN + (size_t)r * DM + 8 * lane), *(const GAS v4u*)(XN + (size_t)r * DM + 512 + 8 * lane));
    }
    __syncthreads();
}

__device__ __forceinline__ void prep_rows(Frame& F, const Args& a, int layer) {
    unsigned char* ws = KWS();
    const int lane = lane_id_l(); const int gw = F.vcu * NWAVES + F.wave, NGW = F.G * NWAVES;
    const bf16* PX = (const bf16*)(ws + WS_PX); bf16* KA = (bf16*)(ws + WS_KA); bf16* YC = (bf16*)(ws + WS_YCAT);
    const float* rope = (const float*)(ws + WS_ROPE);
    const float* kg = KIN(I_KG) + layer * 64;
    v4u st0[6]; constexpr int PCH0 = 66, PHALO0 = 8, PPIECES0 = (PCH0 + 2 * PHALO0) * 32;
    { const int i8 = lane & 7, sub = lane >> 4, l16 = lane & 15;
      float gk[8];
#pragma unroll
      for (int j = 0; j < 8; ++j) gk[j] = kg[8 * i8 + j];
      if (F.vcu < 256) {
#pragma unroll
          for (int k = 0; k < 6; ++k) { const int pc = F.wave * 64 + lane + 512 * k; const int rr = min(max(F.vcu * PCH0 - PHALO0 + (pc >> 5), 0), M_ALL - 1);
              if (pc < PPIECES0) st0[k] = *(const GAS v4u*)(PX + (size_t)rr * PXW + C_CU + 8 * (pc & 31)); } }
      v4u rawp[3];
#pragma unroll
      for (int it = 0; it < 3; ++it) { const int r4 = 4 * gw + it * 4 * NGW; if (r4 < M_ALL) rawp[it] = *(const GAS v4u*)(PX + (size_t)(r4 + sub) * PXW + C_AK + 8 * l16); }
      int itn = 0;
      for (int r4 = 4 * gw; r4 < M_ALL; r4 += 4 * NGW, ++itn) {
          const int r = r4 + sub; const bool lat = r < M_LAT; const int s = lat ? (r & 8191) : ((r - M_LAT) & 255);
          v4u raw; if (itn == 0) raw = rawp[0]; else if (itn == 1) raw = rawp[1]; else if (itn == 2) raw = rawp[2]; else raw = *(const GAS v4u*)(PX + (size_t)r * PXW + C_AK + 8 * l16);
          float x[8]; x[0] = bflo(raw.x); x[1] = bfhi(raw.x); x[2] = bflo(raw.y); x[3] = bfhi(raw.y); x[4] = bflo(raw.z); x[5] = bfhi(raw.z); x[6] = bflo(raw.w); x[7] = bfhi(raw.w);
          float ss = 0.f;
#pragma unroll
          for (int j = 0; j < 8; ++j) ss += x[j] * x[j];
          ss += xshfl<1>(ss); ss += xshfl<2>(ss); ss += xshfl<4>(ss);
          const float rstd = 1.0f / sqrtf(ss * (1.0f / 64.0f) + EPS);
          const int pos = (i8 < 4) ? (s >> 6) : (s & 63);
          float y[8];
#pragma unroll
          for (int j = 0; j < 8; ++j) { y[j] = x[j] * rstd * gk[j]; const float o = xshfl<2>(y[j]);
              if (lat) { const int i = 8 * (i8 & 1) + j; const float cs = rope[(pos * 16 + i) * 2], sn = rope[(pos * 16 + i) * 2 + 1]; y[j] = (i8 & 2) ? (y[j] * cs + o * sn) : (y[j] * cs - o * sn); } }
          v4u o; o.x = pk2(y[0], y[1]); o.y = pk2(y[2], y[3]); o.z = pk2(y[4], y[5]); o.w = pk2(y[6], y[7]);
          *(GAS v4u*)(KA + (size_t)r * 128 + 8 * l16) = o;
          { v2u o8; o8.x = pk8(y[0], y[1], y[2], y[3]); o8.y = pk8(y[4], y[5], y[6], y[7]); *(GAS v2u*)((unsigned char*)(ws + WS_KA8) + (size_t)r * 128 + 8 * l16) = o8; }
      } }
    { LAS unsigned char* tl = F.lds + RING_OFF + 49152 + F.wave * 4096; unsigned char* VT8 = (unsigned char*)(ws + WS_VT8);
      for (int it = gw; it < 264 * 2; it += NGW) { const int T = it >> 1, kvh = it & 1;
          v4u xv[8];
#pragma unroll
          for (int i = 0; i < 8; ++i) xv[i] = *(const GAS v4u*)(PX + (size_t)(64 * T + 8 * i + (lane >> 3)) * PXW + C_AV + kvh * 64 + 8 * (lane & 7));
#pragma unroll
          for (int i = 0; i < 8; ++i) { const int k = 8 * i + (lane >> 3); const int pp = 32 * ((k >> 2) & 1) + 16 * (k >> 5) + 4 * ((k >> 3) & 3) + (k & 3);
              const unsigned w0 = pk8(8.f * bflo(xv[i].x), 8.f * bfhi(xv[i].x), 8.f * bflo(xv[i].y), 8.f * bfhi(xv[i].y)), w1 = pk8(8.f * bflo(xv[i].z), 8.f * bfhi(xv[i].z), 8.f * bflo(xv[i].w), 8.f * bfhi(xv[i].w));
              LAS unsigned char* q = tl + (8 * (lane & 7)) * 64 + pp;
              q[0] = (unsigned char)w0; q[64] = (unsigned char)(w0 >> 8); q[128] = (unsigned char)(w0 >> 16); q[192] = (unsigned char)(w0 >> 24);
              q[256] = (unsigned char)w1; q[320] = (unsigned char)(w1 >> 8); q[384] = (unsigned char)(w1 >> 16); q[448] = (unsigned char)(w1 >> 24); }
          LDS_WAIT(); asm volatile("" ::: "memory");
#pragma unroll
          for (int i = 0; i < 4; ++i) { const int d = 16 * i + (lane >> 2), ch = lane & 3; const v4u o = *(const LAS v4u*)(tl + d * 64 + ch * 16);
              *(GAS v4u*)(VT8 + ((size_t)it * 64 + d) * 64 + ch * 16) = o; }
          LDS_WAIT(); asm volatile("" ::: "memory"); } }
    { constexpr int PCH = 66, PHALO = 8, PROWS = PCH + 2 * PHALO, PPIECES = PROWS * 32; static_assert(PCH * 256 == M_ALL, "pool chunks");
      const int tid = F.wave * 64 + lane;
      for (int c = F.vcu; c < 256; c += F.G) {
          const int r0 = c * PCH;
          v4u st[6]; static_assert(PCH == PCH0 && PHALO == PHALO0, "prefetched chunk geometry");
#pragma unroll
          for (int k = 0; k < 6; ++k) { const int pc = tid + 512 * k; const int rr = min(max(r0 - PHALO + (pc >> 5), 0), M_ALL - 1);
              if (c == F.vcu) st[k] = st0[k]; else if (pc < PPIECES) st[k] = *(const GAS v4u*)(PX + (size_t)rr * PXW + C_CU + 8 * (pc & 31)); }
          __syncthreads();
#pragma unroll
          for (int k = 0; k < 6; ++k) { const int pc = tid + 512 * k; if (pc < PPIECES) *(LAS v4u*)(F.lds + RING_OFF + 16 * pc) = st[k]; }
          __syncthreads();
          for (int rl = F.wave; rl < PCH; rl += NWAVES) {
              const int r = r0 + rl; const bool lat = r < M_LAT; const int s = lat ? (r & 8191) : ((r - M_LAT) & 255);
              const int g = lane >> 4, w = 2 << g, N = lat ? SEQ : CTXL;
              const int lo = max(s - (w >> 1), 0), hi = min(s - (w >> 1) + w, N), cnt = hi - lo;
              LAS const unsigned char* pb = F.lds + RING_OFF + (rl + PHALO - s + lo) * 512 + 8 * lane;
              float s0 = 0.f, s1 = 0.f, s2 = 0.f, s3 = 0.f;
#pragma unroll
              for (int i = 0; i < 16; ++i) { if (i < cnt) { const v2u u = *(LAS const v2u*)(pb + i * 512); s0 += bflo(u.x); s1 += bfhi(u.x); s2 += bflo(u.y); s3 += bfhi(u.y); } }
              const v2u u = *(LAS const v2u*)(F.lds + RING_OFF + (rl + PHALO) * 512 + 8 * lane); const float inv = 1.0f / (float)cnt;
              v2u o; o.x = pk2(s0 * inv - bflo(u.x), s1 * inv - bfhi(u.x)); o.y = pk2(s2 * inv - bflo(u.y), s3 * inv - bfhi(u.y));
              *(GAS v2u*)(YC + (size_t)r * DM + 768 + 4 * lane) = o;
          }
      }
      __syncthreads(); }
}

#ifndef XTRA_BAR
#define XTRA_BAR 0
#endif
#ifndef GALIGN
#define GALIGN true
#endif
#ifndef GSP2
#define GSP2 true
#endif
#ifndef REPMASK
#define REPMASK 0
#endif
#ifndef PHMASK
#define PHMASK 0xfff
#endif
#ifndef NAIVE_ATTN
#define NAIVE_ATTN 0
#endif
#ifndef ATTN_PV
#define ATTN_PV 0
#endif
template <int PV> __device__ __forceinline__ void attn_phase_all(Frame& F, const Args& a, int layer, bool want_ctx, char* lds) {
    unsigned char* ws = KWS();
    typedef attn_body::bf16 abf;
    static_assert(AJ_QP == PXW, "attention q/k/v pitch");
    const abf* PX = (const abf*)(ws + WS_PX); const abf* KA = (const abf*)(ws + WS_KA); abf* YC = (abf*)(ws + WS_YCAT);
    const float* relb = KIN(I_RELB) + (size_t)layer * 4 * 15 * 31; const float* gq = KIN(I_QG) + layer * 64; const float* rope = (const float*)(ws + WS_ROPE);
    float mref; bool fixm, p8ok;
    { const int ln = lane_id_l(); float gqm = __builtin_fabsf(gq[ln]), gkm = __builtin_fabsf((KIN(I_KG) + layer * 64)[ln]);
      gqm = __builtin_fmaxf(gqm, xshfl<1>(gqm)); gqm = __builtin_fmaxf(gqm, xshfl<2>(gqm)); gqm = __builtin_fmaxf(gqm, xshfl<4>(gqm)); gqm = __builtin_fmaxf(gqm, xshfl<8>(gqm)); gqm = __builtin_fmaxf(gqm, xshfl<16>(gqm)); gqm = xmax32(gqm);
      gkm = __builtin_fmaxf(gkm, xshfl<1>(gkm)); gkm = __builtin_fmaxf(gkm, xshfl<2>(gkm)); gkm = __builtin_fmaxf(gkm, xshfl<4>(gkm)); gkm = __builtin_fmaxf(gkm, xshfl<8>(gkm)); gkm = __builtin_fmaxf(gkm, xshfl<16>(gkm)); gkm = xmax32(gkm);
      const float bnd = __uint_as_float(__builtin_amdgcn_readfirstlane(__float_as_uint(C2F * 64.0f * gqm * gkm)));
      mref = 1.02f * bnd; fixm = __builtin_amdgcn_readfirstlane((mref <= 30.0f && gqm <= 15.0f && gkm <= 50.0f) ? 1 : 0) != 0;
      p8ok = fixm && bnd <= 13.5f; if (p8ok) mref = 1.13f * bnd - 15.5f; }
    for (int ua = F.vcu; ua < 512; ua += F.G) {
        const int k = ua >> 8, x = (ua & 255) >> 5, i = ua & 31; const int bk = x >> 1, b = bk >> 1, kvh = bk & 1, h = kvh * 4 + (x & 1) * 2 + k;
        const size_t row = (size_t)b * SEQ + (size_t)i * 256;
        attn_body::AttnJob J; J.Q = PX + row * PXW + C_AQ + h * 64; J.K = KA + kvh * 64; J.V = PX + C_AV + kvh * 64;
        J.O = YC + row * 1024 + h * 64; J.base0 = b * SEQ; J.base1 = M_LAT + b * CTXL; J.r0 = 0; J.rlo = 0; J.bias = relb; J.qt0 = i * 256; J.gq = gq; J.rope = rope;
        J.K8 = (const unsigned char*)(ws + WS_KA8) + kvh * 64; J.VT8 = (const unsigned char*)(ws + WS_VT8) + kvh * 4096; J.mref = mref;
        if (p8ok) attn_body::attn_unit<8, 0, 8>(J, lds, F.wave); else if (fixm) attn_body::attn_unit<8, 0, 7>(J, lds, F.wave); else attn_body::attn_unit<8, 0, 0>(J, lds, F.wave);
    }
    for (int ub = F.vcu; ub < 256; ub += F.G) {
        const int b = ub >> 7, h = (ub >> 5) & 3, blk = ub & 31; const int r0 = 4 * blk, rlo = min(max(r0 - 4, 0), 116);
        const size_t row = (size_t)b * SEQ + (size_t)blk * 256;
        attn_body::AttnJob J; J.mref = 0.f; J.Q = PX + row * PXW + C_BQ + h * 64; J.K = PX + C_BK + h * 64; J.V = PX + C_BV + h * 64;
        J.O = YC + row * 1024 + 512 + h * 64; J.base0 = M_LAT + b * CTXL; J.base1 = b * SEQ + rlo * 64; J.r0 = r0; J.rlo = rlo; J.bias = relb + h * 15 * 31; J.qt0 = 0; J.gq = gq; J.rope = rope;
        attn_body::attn_unit<8, 1>(J, lds, F.wave);
    }
    if (want_ctx) {
        for (int uc = F.vcu; uc < 16; uc += F.G) { const int b = uc >> 3, h = uc & 7; const size_t row = (size_t)M_LAT + (size_t)b * CTXL;
            attn_body::AttnJob J; J.mref = 0.f; J.base0 = M_LAT + b * CTXL; J.base1 = 0; J.r0 = 0; J.rlo = 0; J.bias = relb; J.qt0 = 0; J.gq = gq; J.rope = rope;
            J.Q = PX + row * PXW + C_AQ + h * 64; J.K = KA + (h >> 2) * 64; J.V = PX + C_AV + (h >> 2) * 64; J.O = YC + row * 1024 + h * 64;
            attn_body::attn_unit<8, 2>(J, lds, F.wave); }
        for (int u2 = F.vcu; u2 < 24; u2 += F.G) if (u2 >= 16) { const int uc = u2 - 16, b = uc >> 2, h = uc & 3; const size_t row = (size_t)M_LAT + (size_t)b * CTXL;
            attn_body::AttnJob J; J.mref = 0.f; J.base0 = M_LAT + b * CTXL; J.base1 = 0; J.r0 = 0; J.rlo = 0; J.bias = relb; J.qt0 = 0; J.gq = gq; J.rope = rope;
            J.Q = PX + row * PXW + C_BQ + h * 64; J.K = PX + C_BK + h * 64; J.V = PX + C_BV + h * 64; J.O = YC + row * 1024 + 512 + h * 64;
            attn_body::attn_unit<8, 3>(J, lds, F.wave); }
    }
}

constexpr int PH_PER_LAYER = 10, PH_FINAL = 1 + DEPTH * PH_PER_LAYER, PH_COUNT = PH_FINAL + 1;
__global__ void __launch_bounds__(NWAVES * 64, 2) fwd(Args args) {
    extern __shared__ __attribute__((aligned(16))) unsigned char lds[];
    const int wave0 = __builtin_amdgcn_readfirstlane(threadIdx.x >> 6);
    for (int u = threadIdx.x; u < (LDS_BYTES - LDSCTL_OFF) / 4; u += NWAVES * 64) ((LAS unsigned*)((LAS unsigned char*)lds + LDSCTL_OFF))[u] = 0u;
    __syncthreads();
#define KARG_I(off) ((int)(unsigned)karg_u64(off))
#define SINGLE() (KARG_I(240) != 0)
    if (SINGLE()) { XcdBarrier b0 = xcd_barrier_post((unsigned*)(KWS() + WS_CTL) + CW_BAR, (volatile LAS unsigned*)((LAS unsigned char*)lds + MISC_OFF) + 8); (void)b0; }
#define SEAM() do { if (SINGLE()) { XcdBarrier b_; b_.bar = (unsigned*)(KWS() + WS_CTL) + CW_BAR; b_.x = xb_xcc_id(); b_.st = (volatile LAS unsigned*)((LAS unsigned char*)lds + MISC_OFF) + 8; b_.w = wave0; \
        asm volatile("" : "+s"(b_.bar), "+s"(b_.x)); xcd_barrier(b_); } } while (0)
#define IN(k) (KARG_I(232) <= (k) && (k) < (int)(karg_u64(232) >> 32))
#define MK_FRAME() Frame F; F.lds = (LAS unsigned char*)lds; F.MISC = (volatile LAS unsigned*)(F.lds + MISC_OFF); F.wave = wave0; F.G = (int)gridDim.x; \
        { int bxv = (int)blockIdx.x; asm volatile("" : "+s"(bxv), "+s"(F.wave), "+s"(F.G)); F.vcu = (F.G % 8 == 0) ? (bxv % 8) * (F.G / 8) + bxv / 8 : bxv; }
#define PHASE_VARS() int l = l_; asm volatile("" : "+s"(l)); unsigned char* const ws = KWS(); int bx = (int)blockIdx.x; asm volatile("" : "+s"(bx)); MK_FRAME(); \
        const bool want_ctx = l < DEPTH - 1; const int fi = l >> 1; const int nMt = want_ctx ? 66 : 64, nrows = want_ctx ? M_ALL : M_LAT; \
        const float* const MODl = (const float*)(ws + WS_MOD) + (size_t)l * 3 * 6144; bf16* const XR = (bf16*)(ws + WS_XR); \
        (void)bx; (void)fi; (void)nMt; (void)nrows; (void)MODl; (void)XR

    if (((PHMASK >> 10) & 1) && IN(0)) for (int rep_ = 0; rep_ < (((REPMASK >> 10) & 1) ? 2 : 1); ++rep_) { MK_FRAME(); p0_prologue(F, args); SEAM(); for (int xb_ = 0; xb_ < XTRA_BAR; ++xb_) SEAM(); }

    for (int l_ = 0; l_ < DEPTH; ++l_) {
        const int pb = 1 + l_ * PH_PER_LAYER;
        const bool moe = (l_ & 1) != 0;
        if (((PHMASK >> 0) & 1) && IN(pb + 0)) for (int rep_ = 0; rep_ < (((REPMASK >> 0) & 1) ? 2 : 1); ++rep_) { PHASE_VARS();
            RowIO io{KIN(I_X), KIN(I_CTX), XR, l == 0, l == 0};
            if (l == 2) norm_rows<true, false, false>(F, args, M_ALL, io, KIN(I_N1G) + l * DM, MODl, 0, 1, MODl - 3 * 6144, nullptr, nullptr, nullptr);
            else norm_rows<false, false, false>(F, args, M_ALL, io, KIN(I_N1G) + l * DM, MODl, 0, 1, nullptr, nullptr, nullptr, nullptr, (const float*)(ws + WS_PART), (l & 1) ? 11 : 0);
            SEAM();
        }
        if (((PHMASK >> 1) & 1) && IN(pb + 1)) for (int rep_ = 0; rep_ < (((REPMASK >> 1) & 1) ? 2 : 1); ++rep_) { PHASE_VARS();
            pg8::Gemm g{(const bf16*)(ws + WS_XN), (const bf16*)((const unsigned char*)(ws + WS_WIN) + (size_t)l * INC * DM), DM / 2, DM / 2, DM / 2}; pg8::StaticOrder S; S.init(66, INC / 256, F.G, bx);
            pg8::EpiInProjQ E{(bf16*)(ws + WS_PX), PXW, (bf16*)(ws + WS_GF), PXW / 256, (const float*)(ws + WS_XNS), (const float*)(ws + WS_WINS) + l * INC};
            pg8::gemm_phase<pg8::EpiInProjQ, pg8::StaticOrder, GALIGN, GSP2, false, true>(F.lds + RING_OFF, g, S, E, F.wave);
            SEAM();
        }
        if (((PHMASK >> 2) & 1) && IN(pb + 2)) for (int rep_ = 0; rep_ < (((REPMASK >> 2) & 1) ? 2 : 1); ++rep_) { PHASE_VARS(); prep_rows(F, args, l); SEAM(); }
        if (((PHMASK >> 3) & 1) && IN(pb + 3)) for (int rep_ = 0; rep_ < (((REPMASK >> 3) & 1) ? 2 : 1); ++rep_) { PHASE_VARS(); attn_phase_all<0>(F, args, l, want_ctx, (char*)lds + RING_OFF); SEAM(); }
        if (((PHMASK >> 4) & 1) && IN(pb + 4)) for (int rep_ = 0; rep_ < (((REPMASK >> 4) & 1) ? 2 : 1); ++rep_) { PHASE_VARS();
            const bf16* wc = (const bf16*)(ws + WS_WCAT) + (size_t)l * DM * DM; const bf16* YC = (const bf16*)(ws + WS_YCAT);
            bf16* MB = (bf16*)(ws + WS_MB);
            pg8::StaticOrder S; S.init(nMt, 4, F.G, bx);
            pg8::Gemm g{YC, wc, DM, DM, DM}; pg8::EpiMergeR E{(const bf16*)(ws + WS_GF), MB};
            pg8::gemm_phase<pg8::EpiMergeR, pg8::StaticOrder, GALIGN, GSP2>(F.lds + RING_OFF, g, S, E, F.wave);
            if (l < 3) {
                const int nidle = (nMt * 4 > F.G) ? 2 * F.G - nMt * 4 : 0;
                if (nidle > 0 && bx >= F.G - nidle) moe2_convert(F, args, l * nidle + (bx - (F.G - nidle)), 3 * nidle);
                else if (nidle == 0 && l == 0) moe2_convert(F, args, bx, F.G);
            }
            SEAM();
        }
        if (((PHMASK >> 5) & 1) && IN(pb + 5)) for (int rep_ = 0; rep_ < ((((REPMASK >> 5) & 1) && l_ == 0) ? 9 : 1); ++rep_) { PHASE_VARS();
            pg8::Gemm g{(const bf16*)(ws + WS_MB), (const bf16*)(ws + WS_WOUT) + (size_t)l * DM * DM, DM, DM, DM}; pg8::StaticOrder S; S.init(64, 4, F.G, bx);
            if (l == 0) { pg8::EpiResid<true> E{KIN(I_X), XR, MODl + 2 * DM}; pg8::gemm_phase<pg8::EpiResid<true>, pg8::StaticOrder, GALIGN, GSP2>(F.lds + RING_OFF, g, S, E, F.wave); }
            else { pg8::EpiResid<false> E{nullptr, XR, MODl + 2 * DM}; pg8::gemm_phase<pg8::EpiResid<false>, pg8::StaticOrder, GALIGN, GSP2>(F.lds + RING_OFF, g, S, E, F.wave); }
            if (want_ctx) {
                pg8::Gemm g2{(const bf16*)(ws + WS_MB), (const bf16*)(ws + WS_WOUT) + (size_t)l * DM * DM, 256, DM, DM}; pg8::SplitKOrder S2{4, 256, F.G, bx, 64};
                pg8::EpiPartial E2{(float*)(ws + WS_PART), MODl + 2 * 6144 + 2 * DM};
                pg8::gemm_phase<pg8::EpiPartial, pg8::SplitKOrder, GALIGN, GSP2>(F.lds + RING_OFF, g2, S2, E2, F.wave);
            }
            SEAM();
        }
        if (((PHMASK >> 6) & 1) && IN(pb + 6)) for (int rep_ = 0; rep_ < (((REPMASK >> 6) & 1) ? 2 : 1); ++rep_) { PHASE_VARS();
            RowIO io{KIN(I_X), KIN(I_CTX), XR, 0, l == 0};
            if (moe) norm_rows<false, true, false>(F, args, nrows, io, KIN(I_N2G) + l * DM, MODl, 3, 4, nullptr, KIN(I_RW) + (size_t)fi * DM * 8, KIN(I_RB) + fi * 8, nullptr, (const float*)(ws + WS_PART), want_ctx ? 4 : 0);
            else norm_rows<false, false, false>(F, args, nrows, io, KIN(I_N2G) + l * DM, MODl, 3, 4, nullptr, nullptr, nullptr, nullptr, (const float*)(ws + WS_PART), want_ctx ? 4 : 0);
            SEAM();
        }
        if (moe) {
            if (((PHMASK >> 7) & 1) && IN(pb + 7)) for (int rep_ = 0; rep_ < (((REPMASK >> 7) & 1) ? 2 : 1); ++rep_) { PHASE_VARS(); moe_gather(F, args, nrows); SEAM(); }
            if (((PHMASK >> 8) & 1) && IN(pb + 8)) for (int rep_ = 0; rep_ < (((REPMASK >> 13) & 1) ? 2 : 1); ++rep_) { PHASE_VARS();
                pg8::GroupedOrder S;
#pragma unroll
                for (int j = 0; j < 8; ++j) S.seg[j] = __builtin_amdgcn_readfirstlane((int)ldu((const unsigned*)(ws + WS_SEG) + j));
                S.so.init(S.seg[7], 2 * DFFE / 256, F.G, bx); S.estride = (long)2 * DFFE * DM;
                pg8::Gemm g{(const bf16*)(ws + WS_XG), (const bf16*)((const unsigned char*)(ws + WS_MW13) + (size_t)fi * NE * 2 * DFFE * DM), DM / 2, DM / 2, DM / 2};
                pg8::EpiSwiGLU8Q E{(unsigned char*)(ws + WS_H), DFFE, HSC8, (const float*)(ws + WS_XGS), (const float*)(ws + WS_MW13S) + (size_t)fi * NE * 2 * DFFE};
                pg8::gemm_phase<pg8::EpiSwiGLU8Q, pg8::GroupedOrder, GALIGN, GSP2, false, true>(F.lds + RING_OFF, g, S, E, F.wave);
                SEAM();
            }
            if (((PHMASK >> 9) & 1) && IN(pb + 9)) for (int rep_ = 0; rep_ < (((REPMASK >> 12) & 1) ? 2 : 1); ++rep_) { PHASE_VARS();
                pg8::GroupedOrder S;
#pragma unroll
                for (int j = 0; j < 8; ++j) S.seg[j] = __builtin_amdgcn_readfirstlane((int)ldu((const unsigned*)(ws + WS_SEG) + j));
                const int T = S.seg[7], ntail = min(max(T - 128, 0), SL_TILES), Tm = T - ntail;
                S.so.init(Tm, 4, F.G, bx); S.estride = (long)DM * DFFE;
                const bf16* w2p = (const bf16*)((const unsigned char*)(ws + WS_MW2) + (size_t)fi * NE * DM * DFFE);
                pg8::Gemm g{(const bf16*)(ws + WS_H), w2p, DFFE / 2, DFFE / 2, DFFE / 2, WSC8_E8M0, HSC8_E8M0};
                pg8::EpiBf16 E{(bf16*)(ws + WS_Y), DM};
                pg8::gemm_phase<pg8::EpiBf16, pg8::GroupedOrder, GALIGN, GSP2, true>(F.lds + RING_OFF, g, S, E, F.wave);
                { pg8::GroupedSplitKOrder S2; S2.S = SL_S; S2.Ks = DFFE / 2 / SL_S; S2.G = F.G; S2.c = bx; S2.pm0 = Tm; S2.ntail = ntail; S2.estride = (long)DM * DFFE;
#pragma unroll
                  for (int j = 0; j < 8; ++j) S2.seg[j] = S.seg[j];
                  pg8::Gemm g2{(const bf16*)(ws + WS_H), w2p, DFFE / 2 / SL_S, DFFE / 2, DFFE / 2, WSC8_E8M0, HSC8_E8M0};
                  pg8::EpiSlab E2{(bf16*)(ws + WS_SL), Tm, (long)SL_TILES * 256 * DM};
                  pg8::gemm_phase<pg8::EpiSlab, pg8::GroupedSplitKOrder, GALIGN, GSP2, true>(F.lds + RING_OFF, g2, S2, E2, F.wave); }
                SEAM();
            }
        } else {
            if (((PHMASK >> 8) & 1) && IN(pb + 8)) for (int rep_ = 0; rep_ < (((REPMASK >> 8) & 1) ? 2 : 1); ++rep_) { PHASE_VARS();
                pg8::Gemm g{(const bf16*)(ws + WS_XN), (const bf16*)((const unsigned char*)(ws + WS_W13) + (size_t)fi * 2 * DFF * DM), DM / 2, DM / 2, DM / 2}; pg8::StaticOrder S; S.init(nMt, 2 * DFF / 256, F.G, bx);
                pg8::EpiSwiGLU8Q E{(unsigned char*)(ws + WS_H), DFF, HSC8, (const float*)(ws + WS_XNS), (const float*)(ws + WS_W13S) + fi * 2 * DFF};
                pg8::gemm_phase<pg8::EpiSwiGLU8Q, pg8::StaticOrder, GALIGN, GSP2, false, true>(F.lds + RING_OFF, g, S, E, F.wave);
                SEAM();
            }
            if (((PHMASK >> 9) & 1) && IN(pb + 9)) for (int rep_ = 0; rep_ < (((REPMASK >> 9) & 1) ? 2 : 1); ++rep_) { PHASE_VARS();
                const bf16* w2d = (const bf16*)((const unsigned char*)(ws + WS_W2) + (size_t)fi * DM * DFF);
                pg8::Gemm g{(const bf16*)(ws + WS_H), w2d, DFF / 2, DFF / 2, DFF / 2, WSC8_E8M0, HSC8_E8M0}; pg8::StaticOrder S; S.init(64, 4, F.G, bx);
                pg8::EpiResid<false> E{nullptr, XR, MODl + 5 * DM};
                pg8::gemm_phase<pg8::EpiResid<false>, pg8::StaticOrder, GALIGN, GSP2, true>(F.lds + RING_OFF, g, S, E, F.wave);
                if (want_ctx) {
                    pg8::Gemm g2{(const bf16*)(ws + WS_H), w2d, 128, DFF / 2, DFF / 2, WSC8_E8M0, HSC8_E8M0}; pg8::SplitKOrder S2{11, 128, F.G, bx, 64};
                    pg8::EpiPartial E2{(float*)(ws + WS_PART), MODl + 2 * 6144 + 5 * DM};
                    pg8::gemm_phase<pg8::EpiPartial, pg8::SplitKOrder, GALIGN, GSP2, true>(F.lds + RING_OFF, g2, S2, E2, F.wave);
                }
                SEAM();
            }
        }
    }
    if (((PHMASK >> 11) & 1) && IN(PH_FINAL)) {
        unsigned char* const ws = KWS(); MK_FRAME();
        RowIO io{KIN(I_X), KIN(I_CTX), (bf16*)(ws + WS_XR), 0, 0};
        norm_rows<true, false, true>(F, args, M_LAT, io, KIN(I_FING), nullptr, 0, 0, (const float*)(ws + WS_MOD) + (size_t)3 * 3 * 6144, nullptr, nullptr, KOUT());
    }
#undef IN
#undef SEAM
#undef PHASE_VARS
#undef MK_FRAME
}

#ifndef SINGLE_LAUNCH
#define SINGLE_LAUNCH 0
#endif
extern "C" void kernel_launch(void* const* d_in, const int* in_sizes, int n_in, void* d_out, int out_size, void* d_ws, size_t ws_size, hipStream_t stream) {
    static int grid = 0;
    if (grid == 0) {
        if (n_in != 27 || out_size != M_LAT * DM || ws_size < WS_END) { fprintf(stderr, "kernel_launch: unexpected shapes (n_in %d, out %d, ws %zu < %zu)\n", n_in, out_size, ws_size, (size_t)WS_END); grid = -1; return; }
        int dev = 0, cus = 0, per_cu = 0;
        if (hipGetDevice(&dev) != hipSuccess || hipDeviceGetAttribute(&cus, hipDeviceAttributeMultiprocessorCount, dev) != hipSuccess) { grid = -1; return; }
        if (hipFuncSetAttribute((const void*)fwd, hipFuncAttributeMaxDynamicSharedMemorySize, LDS_BYTES) != hipSuccess) { grid = -1; return; }
        if (hipOccupancyMaxActiveBlocksPerMultiprocessor(&per_cu, (const void*)fwd, NWAVES * 64, LDS_BYTES) != hipSuccess || per_cu < 1) { fprintf(stderr, "kernel_launch: occupancy query says %d\n", per_cu); }
        (void)hipGetLastError();
        grid = cus;
    }
    if (grid < 0) return;
    if (hipMemsetAsync((char*)d_ws + WS_CTL, 0, CTL_ZERO_BYTES, stream) != hipSuccess) return;
    Args a{};
    for (int i = 0; i < 27; ++i) a.in[i] = (const float*)d_in[i];
    a.out = (float*)d_out; a.ws = (unsigned char*)d_ws; a.pad = 0;
#if SINGLE_LAUNCH
    a.ph_lo = 0; a.ph_hi = PH_COUNT; a.single = 1;
    hipLaunchKernelGGL(fwd, dim3(grid), dim3(NWAVES * 64), LDS_BYTES, stream, a);
#else
    a.single = 0;
    for (int ph = 0; ph < PH_COUNT; ++ph) {
        if (ph >= 1 && ph < PH_FINAL) { const int l = (ph - 1) / PH_PER_LAYER, k = (ph - 1) % PH_PER_LAYER; if (k == 7 && !(l & 1)) continue; }
        a.ph_lo = ph; a.ph_hi = ph + 1;
        hipLaunchKernelGGL(fwd, dim3(grid), dim3(NWAVES * 64), LDS_BYTES, stream, a);
    }
#endif
}
```
